# Optimizing an MI355X kernel written in HIP

```python
import math
import jax, jax.numpy as jnp
from jax import lax
import numpy as np

D_MODEL = 2048
BATCH = 4
SEQ = 4096
DEPTH = 2

N_MIXERS = 4
GROUP_WIDTH = D_MODEL // N_MIXERS
N_HEADS_GLA = 4
N_HEADS_GDN = 4
N_POOL_GROUPS = 4
N_HEADS_FOX = 4
HEAD_DIM = GROUP_WIDTH // 4
GLA_KEY_DIM = HEAD_DIM // 2
GLA_GATE_RANK = 16
GLA_GATE_TAU = 16.0
GDN_CONV = 4
POOL_WINDOWS = (2, 4, 8, 16)
POOL_GROUP_DIM = GROUP_WIDTH // N_POOL_GROUPS
CHUNK = 64
FOX_BLOCK = 128
D_FF = 256 * int(math.ceil(8 * D_MODEL / 3 / 256))
FFN_CONV = 3
EPS = 1e-6

IN_SPLITS = (
    N_HEADS_GLA * GLA_KEY_DIM,
    N_HEADS_GLA * GLA_KEY_DIM,
    GROUP_WIDTH,
    GROUP_WIDTH,
    GLA_GATE_RANK,
    3 * GROUP_WIDTH,
    GROUP_WIDTH,
    N_HEADS_GDN,
    N_HEADS_GDN,
    GROUP_WIDTH,
    GROUP_WIDTH,
    GROUP_WIDTH,
    GROUP_WIDTH,
    N_HEADS_FOX,
)
IN_WIDTH = sum(IN_SPLITS)
SPLIT_IDX = tuple(sum(IN_SPLITS[:i + 1]) for i in range(len(IN_SPLITS) - 1))

kernel_name = "hybrid_parallel_heads_block"


def rmsnorm(x, w):
    xf = x.astype(jnp.float32)
    y = xf * lax.rsqrt(jnp.mean(xf * xf, axis=-1, keepdims=True) + EPS)
    return (y * w.astype(jnp.float32)).astype(x.dtype)


def l2norm(x):
    return x * lax.rsqrt(jnp.sum(x * x, axis=-1, keepdims=True) + EPS)


def causal_dwconv(x, w):
    width, T = w.shape[0], x.shape[1]
    xp = jnp.pad(x, ((0, 0), (width - 1, 0), (0, 0)))
    return sum(xp[:, j:j + T] * w[j] for j in range(width))


def gla_mixer(q, k, v, g_out, g_lr, w_lr, b_lr, norm_w):
    B, T, _ = q.shape
    H, dk, dv, C = N_HEADS_GLA, GLA_KEY_DIM, HEAD_DIM, CHUNK
    N = T // C
    logg = jax.nn.log_sigmoid(g_lr @ w_lr + b_lr) / GLA_GATE_TAU
    to_c = lambda t, d: jnp.transpose(t.reshape(B, N, C, H, d), (1, 0, 3, 2, 4))
    qc, kc, vc = to_c(q * dk ** -0.5, dk), to_c(k, dk), to_c(v, dv)
    bcum = jnp.cumsum(to_c(logg, dk), axis=3)
    causal = jnp.tril(jnp.ones((C, C), bool))[:, :, None]

    def step(S, inp):
        qi, ki, vi, bi = inp
        diff = bi[:, :, :, None, :] - bi[:, :, None, :, :]
        decay = jnp.exp(jnp.where(causal, diff, -jnp.inf))
        att = jnp.einsum('bhtd,bhsd,bhtsd->bhts', qi, ki, decay)
        o = jnp.einsum('bhts,bhsv->bhtv', att, vi) + jnp.einsum('bhtd,bhdv->bhtv', qi * jnp.exp(bi), S)
        blast = bi[:, :, -1:, :]
        S = S * jnp.exp(blast)[:, :, 0, :, None] + jnp.einsum('bhsd,bhsv->bhdv', ki * jnp.exp(blast - bi), vi)
        return S, o

    S0 = jnp.zeros((B, H, dk, dv), jnp.float32)
    _, o = lax.scan(step, S0, (qc, kc, vc, bcum))
    o = jnp.transpose(o, (1, 0, 3, 2, 4)).reshape(B, T, H, dv)
    o = rmsnorm(o, norm_w) * jax.nn.silu(g_out.reshape(B, T, H, dv))
    return o.reshape(B, T, H * dv)


def gated_deltanet_mixer(qkv, g_out, beta_in, a_in, conv_w, a_log, dt_bias, norm_w):
    B, T, _ = qkv.shape
    H, d, C = N_HEADS_GDN, HEAD_DIM, CHUNK
    N = T // C
    qkv = jax.nn.silu(causal_dwconv(qkv, conv_w))
    q, k, v = jnp.split(qkv, 3, axis=-1)
    q = l2norm(q.reshape(B, T, H, d)) * d ** -0.5
    k = l2norm(k.reshape(B, T, H, d))
    v = v.reshape(B, T, H, d)
    beta = jax.nn.sigmoid(beta_in)
    g = -jnp.exp(a_log) * jax.nn.softplus(a_in + dt_bias)
    to_c = lambda t: jnp.moveaxis(t.reshape(B, N, C, H, -1), 3, 1)
    qc, kc, vc = to_c(q), to_c(k), to_c(v)
    bc = to_c(beta[..., None])
    gcum = jnp.cumsum(to_c(g[..., None])[..., 0], axis=-1)
    incl = jnp.tril(jnp.ones((C, C), bool))
    strict = jnp.tril(jnp.ones((C, C), bool), -1)
    decay = jnp.exp(jnp.where(incl, gcum[..., :, None] - gcum[..., None, :], -jnp.inf))
    kbeta = kc * bc
    lmat = jnp.where(strict, jnp.einsum('bhnid,bhnjd->bhnij', kbeta, kc) * decay, 0.0)
    rhs = jnp.concatenate([vc * bc, kbeta * jnp.exp(gcum)[..., None]], axis=-1)
    sol = lax.linalg.triangular_solve(lmat + jnp.eye(C, dtype=lmat.dtype), rhs,
                                      left_side=True, lower=True, unit_diagonal=True)
    u, w = sol[..., :d], sol[..., d:]
    attn = jnp.einsum('bhnid,bhnjd->bhnij', qc, kc) * decay

    def step(S, inp):
        q_i, k_i, u_i, w_i, a_i, g_i = inp
        v_new = u_i - jnp.einsum('bhck,bhkv->bhcv', w_i, S)
        o = (jnp.einsum('bhck,bhkv->bhcv', q_i * jnp.exp(g_i)[..., None], S)
             + jnp.einsum('bhij,bhjv->bhiv', a_i, v_new))
        g_last = g_i[..., -1:]
        S = S * jnp.exp(g_last)[..., None] + jnp.einsum(
            'bhck,bhcv->bhkv', k_i * jnp.exp(g_last - g_i)[..., None], v_new)
        return S, o

    xs = tuple(jnp.moveaxis(t, 2, 0) for t in (qc, kc, u, w, attn, gcum))
    S0 = jnp.zeros((B, H, d, d), jnp.float32)
    _, o = lax.scan(step, S0, xs)
    o = jnp.moveaxis(jnp.moveaxis(o, 0, 2), 1, 3).reshape(B, T, H, d)
    o = rmsnorm(o, norm_w) * jax.nn.silu(g_out.reshape(B, T, H, d))
    return o.reshape(B, T, H * d)


def pool_mixer(u, w_grp, scale):
    B, T, Cw = u.shape
    cs = jnp.pad(jnp.cumsum(u, axis=1), ((0, 0), (1, 0), (0, 0)))
    pos = jnp.arange(1, T + 1, dtype=jnp.float32)
    outs = []
    for gi, win in enumerate(POOL_WINDOWS):
        sl = slice(gi * POOL_GROUP_DIM, (gi + 1) * POOL_GROUP_DIM)
        csg = cs[:, :, sl]
        lower = jnp.pad(csg[:, :T - win + 1], ((0, 0), (win - 1, 0), (0, 0)))
        mean = (csg[:, 1:] - lower) / jnp.minimum(pos, float(win))[None, :, None]
        outs.append(mean - u[:, :, sl])
    dlt = jnp.stack(outs, axis=2)
    y = jnp.einsum('btgc,gcd->btgd', dlt, w_grp).reshape(B, T, Cw)
    return y * scale


def forgetting_attention(q, k, v, f_in, f_bias):
    B, T, _ = q.shape
    H, d = N_HEADS_FOX, HEAD_DIM
    heads = lambda t: jnp.moveaxis(t.reshape(B, T, H, d), 2, 1)
    q, k, v = heads(q) * d ** -0.5, heads(k), heads(v)
    F = jnp.cumsum(jnp.moveaxis(jax.nn.log_sigmoid(f_in + f_bias), 2, 1), axis=-1)
    outs = []
    for i in range(T // FOX_BLOCK):
        s0, e = i * FOX_BLOCK, (i + 1) * FOX_BLOCK
        logits = (jnp.einsum('bhqd,bhkd->bhqk', q[:, :, s0:e], k[:, :, :e])
                  + F[:, :, s0:e, None] - F[:, :, None, :e])
        mask = jnp.arange(s0, e)[:, None] >= jnp.arange(e)[None, :]
        p = jax.nn.softmax(jnp.where(mask, logits, -jnp.inf), axis=-1)
        outs.append(jnp.einsum('bhqk,bhkd->bhqd', p, v[:, :, :e]))
    o = jnp.concatenate(outs, axis=2)
    return jnp.moveaxis(o, 1, 2).reshape(B, T, H * d)


def conv_ffn(h, w_gate, w_up, conv_w, conv_b, w_down):
    gate = causal_dwconv(h @ w_gate, conv_w) + conv_b
    return (jax.nn.silu(gate) * (h @ w_up)) @ w_down


def setup_inputs(seed: int = 0) -> dict:
    key = jax.random.key(seed)
    ks = iter(jax.random.split(key, 32))
    nrm = lambda shape, s: jax.random.normal(next(ks), shape, jnp.float32) * s
    L, D, F = DEPTH, D_MODEL, D_FF
    x = nrm((BATCH, SEQ, D), 1.0)
    c = nrm((BATCH, D), 1.0)
    w_mod = nrm((L, D, 6 * D), 0.5 * D ** -0.5)
    b_mod = nrm((L, 6 * D), 0.02)
    norm_mix = 1.0 + nrm((L, D), 0.1)
    norm_ffn = 1.0 + nrm((L, D), 0.1)
    w_in = nrm((L, D, IN_WIDTH), D ** -0.5)
    gla_w_lr = nrm((L, GLA_GATE_RANK, N_HEADS_GLA * GLA_KEY_DIM), GLA_GATE_RANK ** -0.5)
    gla_b_lr = nrm((L, N_HEADS_GLA * GLA_KEY_DIM), 0.1)
    gla_norm = 1.0 + nrm((L, HEAD_DIM), 0.1)
    gdn_conv = nrm((L, GDN_CONV, 3 * GROUP_WIDTH), GDN_CONV ** -0.5)
    gdn_a_log = jnp.log(jax.random.uniform(next(ks), (L, N_HEADS_GDN), jnp.float32, 1.0, 16.0))
    dt = jnp.exp(jax.random.uniform(next(ks), (L, N_HEADS_GDN), jnp.float32, math.log(1e-3), math.log(1e-1)))
    gdn_dt_bias = dt + jnp.log(-jnp.expm1(-dt))
    gdn_norm = 1.0 + nrm((L, HEAD_DIM), 0.1)
    pool_w = nrm((L, N_POOL_GROUPS, POOL_GROUP_DIM, POOL_GROUP_DIM), POOL_GROUP_DIM ** -0.5)
    pool_scale = 1.0 + nrm((L, GROUP_WIDTH), 0.1)
    fox_f_bias = 2.0 + nrm((L, N_HEADS_FOX), 0.5)
    w_out = nrm((L, D, D), D ** -0.5)
    ffn_w_gate = nrm((L, D, F), D ** -0.5)
    ffn_w_up = nrm((L, D, F), D ** -0.5)
    ffn_conv_w = nrm((L, FFN_CONV, F), FFN_CONV ** -0.5)
    ffn_conv_b = nrm((L, F), 0.02)
    ffn_w_down = nrm((L, F, D), F ** -0.5)
    norm_final = 1.0 + nrm((D,), 0.1)
    return {"x": x, "c": c, "w_mod": w_mod, "b_mod": b_mod, "norm_mix": norm_mix, "norm_ffn": norm_ffn,
            "w_in": w_in, "gla_w_lr": gla_w_lr, "gla_b_lr": gla_b_lr, "gla_norm": gla_norm,
            "gdn_conv": gdn_conv, "gdn_a_log": gdn_a_log, "gdn_dt_bias": gdn_dt_bias, "gdn_norm": gdn_norm,
            "pool_w": pool_w, "pool_scale": pool_scale, "fox_f_bias": fox_f_bias, "w_out": w_out,
            "ffn_w_gate": ffn_w_gate, "ffn_w_up": ffn_w_up, "ffn_conv_w": ffn_conv_w,
            "ffn_conv_b": ffn_conv_b, "ffn_w_down": ffn_w_down, "norm_final": norm_final}


def reference(x, c, w_mod, b_mod, norm_mix, norm_ffn, w_in, gla_w_lr, gla_b_lr, gla_norm,
              gdn_conv, gdn_a_log, gdn_dt_bias, gdn_norm, pool_w, pool_scale, fox_f_bias, w_out,
              ffn_w_gate, ffn_w_up, ffn_conv_w, ffn_conv_b, ffn_w_down, norm_final):
    B, T, D = x.shape
    f32 = lambda t: t.astype(jnp.float32)
    cond = jax.nn.silu(c)
    for l in range(DEPTH):
        mod = (cond @ w_mod[l] + b_mod[l]).reshape(B, 6, D)
        sh1, sc1, g1, sh2, sc2, g2 = [mod[:, i, None, :] for i in range(6)]

        h = rmsnorm(x, norm_mix[l]) * (1.0 + sc1) + sh1
        proj = f32(h @ w_in[l])
        (gla_q, gla_k, gla_v, gla_g, gla_lr, gdn_qkv, gdn_g, gdn_b, gdn_a,
         pool_u, fox_q, fox_k, fox_v, fox_f) = jnp.split(proj, SPLIT_IDX, axis=-1)
        y_a = gla_mixer(gla_q, gla_k, gla_v, gla_g, gla_lr, f32(gla_w_lr[l]), f32(gla_b_lr[l]), gla_norm[l])
        y_b = gated_deltanet_mixer(gdn_qkv, gdn_g, gdn_b, gdn_a, f32(gdn_conv[l]), f32(gdn_a_log[l]),
                                   f32(gdn_dt_bias[l]), gdn_norm[l])
        y_c = pool_mixer(pool_u, f32(pool_w[l]), f32(pool_scale[l]))
        y_d = forgetting_attention(fox_q, fox_k, fox_v, fox_f, f32(fox_f_bias[l]))
        y = jnp.concatenate([y_a, y_b, y_c, y_d], axis=-1).astype(x.dtype) @ w_out[l]
        x = x + g1 * y

        h = rmsnorm(x, norm_ffn[l]) * (1.0 + sc2) + sh2
        x = x + g2 * conv_ffn(h, ffn_w_gate[l], ffn_w_up[l], ffn_conv_w[l], ffn_conv_b[l], ffn_w_down[l])
    return rmsnorm(x, norm_final)
```

```cpp
#include <hip/hip_runtime.h>
#include <hip/hip_cooperative_groups.h>
#include <cstdio>
#include <cstdint>
namespace cg = cooperative_groups;
#ifndef PG8_WGM
#define PG8_WGM 8
#endif
__device__ __forceinline__ int fresh_tid() { int t = threadIdx.x; asm volatile("" : "+v"(t)); return t; }
__device__ __forceinline__ int fresh_bid() { int t = blockIdx.x; asm volatile("" : "+s"(t)); return t; }
namespace pg8 {
#define PG8_LAS __attribute__((address_space(3)))
typedef unsigned short bf16_t;
typedef short bf16x8 __attribute__((ext_vector_type(8)));
typedef float f32x4 __attribute__((ext_vector_type(4)));
typedef unsigned u32x4 __attribute__((ext_vector_type(4)));
constexpr int BM = 256, BK = 64, HALF = 128, HTB = HALF * BK * 2  , STAGE_BYTES = 8 * HTB, NXCD = 8, WGM = PG8_WGM;

__host__ __device__ __forceinline__ int lds_byte(int r, int c) { const int st = (r >> 4) * 2 + (c >> 5), rr = r & 15, cc = c & 31, ob = rr * 64 + cc * 2; return st * 1024 + (ob ^ (((ob >> 9) & 1) << 5)); }
__host__ __device__ __forceinline__ void stage_rc(int b, int& R, int& C) { const int st = b / 1024, sb = b % 1024, swz = sb ^ (((sb >> 9) & 1) << 5); R = (st >> 1) * 16 + swz / 64; C = (st & 1) * 32 + (swz % 64) / 2; }
__host__ __device__ __forceinline__ int perm32(int rho) { const int n = rho >> 4, i = rho & 15; return 8 * (i >> 2) + 4 * n + (i & 3); }

struct Unit { int pm, pn; };
struct Gemm { const bf16_t* A; const bf16_t* Bt; int M, N, K; };

struct StaticOrder {
    int nM, nN, nwg, G, c, wgm;
    __host__ __device__ void init(int M, int N, int G_, int c_, int wgm_ = WGM) { nM = M / BM; nN = N / BM; nwg = nM * nN; G = G_; c = c_; wgm = wgm_; }
    __host__ __device__ bool next(int i, Unit& u) const {
        const long L = (long)i * G + c; if (L >= nwg) return false;
        int wgid = (int)L; { const int q = nwg / NXCD, r = nwg % NXCD, xcd = wgid % NXCD, off = wgid / NXCD; wgid = (xcd < r ? xcd * (q + 1) : r * (q + 1) + (xcd - r) * q) + off; }
        const int nig = wgm * nN, gid = wgid / nig, fm = gid * wgm, gsz = (nM - fm) < wgm ? (nM - fm) : wgm;
        u.pm = fm + ((wgid % nig) % gsz); u.pn = (wgid % nig) / gsz; return true;
    }
    __device__ __forceinline__ void a_ready(const Unit&) const {}
    __device__ __forceinline__ void done(const Unit&) const {}
};

__device__ __forceinline__ unsigned cvt_pk_bf16(float lo, float hi) { unsigned r; asm volatile("v_cvt_pk_bf16_f32 %0, %1, %2" : "=v"(r) : "v"(lo), "v"(hi)); return r; }
typedef unsigned u32x4 __attribute__((ext_vector_type(4)));
struct EpiStoreBf16 {
    static constexpr bool PERM = true, AFTER_DRAIN = false;
    bf16_t* O; int ldc;
    __device__ __forceinline__ void operator()(const f32x4 (&acc)[2][2][4][2], const Unit& u, int wr, int wc, int fr, int fq) const {
        const int row0 = u.pm * BM + wr * 64 + fr; const int col0 = u.pn * BM + wc * 32 + 8 * fq;
#pragma unroll
        for (int ai = 0; ai < 2; ++ai)
#pragma unroll
            for (int m = 0; m < 4; ++m) { bf16_t* rowp = O + (size_t)(row0 + ai * HALF + m * 16) * ldc + col0;
#pragma unroll
                for (int bj = 0; bj < 2; ++bj) { const f32x4 v0 = acc[ai][bj][m][0], v1 = acc[ai][bj][m][1];
                    u32x4 w; w.x = cvt_pk_bf16(v0[0], v0[1]); w.y = cvt_pk_bf16(v0[2], v0[3]); w.z = cvt_pk_bf16(v1[0], v1[1]); w.w = cvt_pk_bf16(v1[2], v1[3]);
                    *(u32x4*)(rowp + bj * HALF) = w; } }
    }
};
struct EpiResid {
    static constexpr bool PERM = false, AFTER_DRAIN = false;
    const float* base; float* out; const float* gate; int ldc; int gpitch; int rows_per_batch;
    __device__ __forceinline__ void operator()(const f32x4 (&acc)[2][2][4][2], const Unit& u, int wr, int wc, int fr, int fq) const {
        const int row0 = u.pm * BM + wr * 64 + fr; const int col0 = u.pn * BM + wc * 32 + 4 * fq;
        const float* g = gate + (size_t)((u.pm * BM) / rows_per_batch) * gpitch + col0;
        f32x4 gv[2][2];
#pragma unroll
        for (int bj = 0; bj < 2; ++bj)
#pragma unroll
            for (int n = 0; n < 2; ++n) gv[bj][n] = *(const f32x4*)(g + bj * HALF + n * 16);
        f32x4 pb[3][4];
#define ER_LOAD(G_, D_) do { const size_t off_ = (size_t)(row0 + ((G_) >> 2) * HALF + ((G_) & 3) * 16) * ldc + col0; \
        _Pragma("unroll") for (int q_ = 0; q_ < 4; ++q_) D_[q_] = *(const f32x4*)(base + off_ + (q_ >> 1) * HALF + (q_ & 1) * 16); } while (0)
        ER_LOAD(0, pb[0]); ER_LOAD(1, pb[1]);
#pragma unroll
        for (int G = 0; G < 8; ++G) {
            if (G + 2 < 8) ER_LOAD(G + 2, pb[(G + 2) % 3]);
            __builtin_amdgcn_sched_barrier(0);
            const int ai = G >> 2, m = G & 3;
            const size_t off = (size_t)(row0 + ai * HALF + m * 16) * ldc + col0;
#pragma unroll
            for (int q = 0; q < 4; ++q) { const int bj = q >> 1, n = q & 1;
                *(f32x4*)(out + off + bj * HALF + n * 16) = pb[G % 3][q] + gv[bj][n] * acc[ai][bj][m][n]; }
            __builtin_amdgcn_sched_barrier(0);
        }
#undef ER_LOAD
    }
};
template <int N> __device__ __forceinline__ float dpp_ror(float v) { return __builtin_bit_cast(float, __builtin_amdgcn_update_dpp(0, __builtin_bit_cast(int, v), 0x120 + N, 0xf, 0xf, false)); }
struct EpiGateUp {
    static constexpr bool PERM = true, AFTER_DRAIN = false;
    bf16_t* ACT; const float* cw; const float* cb; float* GLAST; float* GFIRST; float* UFIRST; PG8_LAS float* XL; int dff;
    __device__ __forceinline__ void operator()(const f32x4 (&acc)[2][2][4][2], const Unit& u, int wr, int wc, int fr, int fq) const {
        const int ch0 = u.pn * 128 + wc * 32 + 8 * fq;
        float w0[8], w1[8], w2[8], bb[8];
#pragma unroll
        for (int n = 0; n < 2; ++n) { const f32x4 a = *(const f32x4*)(cw + ch0 + 4 * n), b = *(const f32x4*)(cw + dff + ch0 + 4 * n), c = *(const f32x4*)(cw + 2 * dff + ch0 + 4 * n), d = *(const f32x4*)(cb + ch0 + 4 * n);
#pragma unroll
            for (int j = 0; j < 4; ++j) { w0[4 * n + j] = a[j]; w1[4 * n + j] = b[j]; w2[4 * n + j] = c[j]; bb[4 * n + j] = d[j]; } }
        if (fr >= 14) {
#pragma unroll
            for (int ai = 0; ai < 2; ++ai)
#pragma unroll
                for (int n = 0; n < 2; ++n) *(PG8_LAS f32x4*)(XL + ((((ai * 2 + wr) * 4 + wc) * 2 + (fr - 14)) * 32 + 8 * fq + 4 * n)) = acc[ai][0][3][n];
            if (wr == 1) {
#pragma unroll
                for (int n = 0; n < 2; ++n) *(f32x4*)(GLAST + (size_t)(u.pm * 2 + (fr - 14)) * dff + ch0 + 4 * n) = acc[1][0][3][n];
            }
        }
        if (wr == 0 && fr < 2) {
#pragma unroll
            for (int n = 0; n < 2; ++n) { *(f32x4*)(GFIRST + (size_t)(u.pm * 2 + fr) * dff + ch0 + 4 * n) = acc[0][0][0][n]; *(f32x4*)(UFIRST + (size_t)(u.pm * 2 + fr) * dff + ch0 + 4 * n) = acc[0][1][0][n]; }
        }
        asm volatile("s_waitcnt lgkmcnt(0)" ::: "memory"); __builtin_amdgcn_s_barrier(); asm volatile("" ::: "memory");
        const int row0 = u.pm * BM + wr * 64 + fr;
#pragma unroll
        for (int ai = 0; ai < 2; ++ai) {
            float pv[8];
            {
                const int sai = (wr == 1) ? ai : 0, swr = (wr == 1) ? 0 : 1;
                const bool have = (wr == 1) || (ai == 1);
                PG8_LAS const float* src = XL + ((((sai * 2 + swr) * 4 + wc) * 2 + ((fr == 15) ? 1 : 0)) * 32 + 8 * fq);
                const f32x4 x0 = *(PG8_LAS const f32x4*)src, x1 = *(PG8_LAS const f32x4*)(src + 4);
#pragma unroll
                for (int j = 0; j < 4; ++j) { pv[j] = have ? x0[j] : 0.f; pv[4 + j] = have ? x1[j] : 0.f; }
            }
            float r1p[8], r2p[8];
#pragma unroll
            for (int e = 0; e < 8; ++e) { r1p[e] = dpp_ror<1>(pv[e]); r2p[e] = dpp_ror<2>(pv[e]); }
#pragma unroll
            for (int m = 0; m < 4; ++m) {
                u32x4 w;
                unsigned pk[4];
#pragma unroll
                for (int n = 0; n < 2; ++n) {
                    float o[4];
#pragma unroll
                    for (int j = 0; j < 4; ++j) {
                        const int e = 4 * n + j;
                        const float g = acc[ai][0][m][n][j], up = acc[ai][1][m][n][j];
                        const float g1s = dpp_ror<1>(g), g2s = dpp_ror<2>(g);
                        const float g1 = (fr >= 1) ? g1s : r1p[e], g2 = (fr >= 2) ? g2s : r2p[e];
                        r1p[e] = g1s; r2p[e] = g2s;
                        const float a = w0[e] * g2 + w1[e] * g1 + w2[e] * g + bb[e];
                        o[j] = a * __builtin_amdgcn_rcpf(1.f + __expf(-a)) * up;
                    }
                    pk[2 * n] = cvt_pk_bf16(o[0], o[1]); pk[2 * n + 1] = cvt_pk_bf16(o[2], o[3]);
                }
                w.x = pk[0]; w.y = pk[1]; w.z = pk[2]; w.w = pk[3];
                *(u32x4*)(ACT + (size_t)(row0 + ai * HALF + m * 16) * dff + ch0) = w;
            }
        }
    }
};
template <class Epi, class Sched, bool ALIGN_EPI = false, bool SP2 = false>
__device__ __forceinline__ void gemm_phase(PG8_LAS unsigned char* lds, const Gemm g, const Sched& S, const Epi& E) {
    const int tid = fresh_tid(), wid = __builtin_amdgcn_readfirstlane(tid >> 6), lane = tid & 63, wr = wid >> 2, wc = wid & 3, fr = lane & 15, fq = lane >> 4;
    const int K = g.K, nt = K / BK;
    unsigned voffA[2], voffB[2];
#pragma unroll
    for (int i = 0; i < 2; ++i) { int R, C; stage_rc(tid * 16 + i * 8192, R, C); const int Rb = Epi::PERM ? ((R & ~31) + perm32(R & 31)) : R;
        voffA[i] = (unsigned)(R * K + C) * 2u; voffB[i] = (unsigned)(Rb * K + C) * 2u; }
    const size_t kstep = (size_t)(BK * 2);
    const size_t hstep = (size_t)HALF * K * 2;
    const size_t tstep = 2 * hstep;
    const unsigned ldsw = (unsigned)wid * 1024u;
    const int aoff = lds_byte(wr * 64 + fr, fq * 8), boff = lds_byte(wc * 32 + fr, fq * 8);
#define PG8_SA(b, h) (((b) * 2 + (h)) * HTB)
#define PG8_SB(b, h) ((4 + (b) * 2 + (h)) * HTB)
#define PG8_STAGE(bufoff, gbase, voff) do { _Pragma("unroll") for (int _i = 0; _i < 2; ++_i) \
        __builtin_amdgcn_global_load_lds((const unsigned*)((const char*)(gbase) + (voff)[_i]), (PG8_LAS unsigned*)(lds + (bufoff) + ldsw + _i * 8192), 16, 0, 0); } while (0)
#define PG8_LDA(dst, b, h) do { _Pragma("unroll") for (int m = 0; m < 4; ++m) _Pragma("unroll") for (int k = 0; k < 2; ++k) dst[m][k] = *(const PG8_LAS bf16x8*)(lds + PG8_SA(b, h) + aoff + m * 2048 + k * 1024); } while (0)
#define PG8_LDB(dst, b, h) do { _Pragma("unroll") for (int n = 0; n < 2; ++n) _Pragma("unroll") for (int k = 0; k < 2; ++k) dst[n][k] = *(const PG8_LAS bf16x8*)(lds + PG8_SB(b, h) + boff + n * 2048 + k * 1024); } while (0)
#define PG8_MMA(ai, bj, At, Bt) do { __builtin_amdgcn_s_setprio(1); _Pragma("unroll") for (int m = 0; m < 4; ++m) _Pragma("unroll") for (int n = 0; n < 2; ++n) _Pragma("unroll") for (int k = 0; k < 2; ++k) \
        acc[ai][bj][m][n] = __builtin_amdgcn_mfma_f32_16x16x32_bf16(Bt[n][k], At[m][k], acc[ai][bj][m][n], 0, 0, 0); __builtin_amdgcn_s_setprio(0); } while (0)
#define PG8_WAIT_V(n) asm volatile("s_waitcnt vmcnt(" #n ")" ::: "memory")
#define PG8_WAIT_L(n) asm volatile("s_waitcnt lgkmcnt(" #n ")" ::: "memory")
#define PG8_BAR __builtin_amdgcn_s_barrier()
#define PG8_SCHED __builtin_amdgcn_sched_barrier(0)
    Unit cur, nxt; int ui = 0;
    if (!S.next(0, cur)) return;
    f32x4 acc[2][2][4][2];
#pragma unroll
    for (int a = 0; a < 2; ++a)
#pragma unroll
        for (int b = 0; b < 2; ++b)
#pragma unroll
            for (int m = 0; m < 4; ++m)
#pragma unroll
                for (int n = 0; n < 2; ++n) acc[a][b][m][n] = (f32x4){0.f, 0.f, 0.f, 0.f};
    bf16x8 At[4][2], B0[2][2], B1[2][2];
    const char* cA = (const char*)g.A + (size_t)cur.pm * tstep; const char* cB = (const char*)g.Bt + (size_t)cur.pn * tstep;
    S.a_ready(cur);
    if constexpr (SP2) {
        PG8_STAGE(PG8_SB(0, 0), cB, voffB); PG8_STAGE(PG8_SB(0, 1), cB + hstep, voffB); PG8_STAGE(PG8_SA(0, 0), cA, voffA); PG8_STAGE(PG8_SA(0, 1), cA + hstep, voffA);
        if (wr == 1) PG8_BAR;
        PG8_WAIT_V(2); PG8_BAR;
        PG8_STAGE(PG8_SB(1, 0), cB + kstep, voffB); PG8_STAGE(PG8_SA(1, 0), cA + kstep, voffA); PG8_STAGE(PG8_SB(1, 1), cB + hstep + kstep, voffB);
        PG8_WAIT_V(6); PG8_BAR;
    } else {
        PG8_STAGE(PG8_SB(0, 0), cB, voffB); PG8_STAGE(PG8_SA(0, 0), cA, voffA); PG8_STAGE(PG8_SB(0, 1), cB + hstep, voffB); PG8_STAGE(PG8_SA(0, 1), cA + hstep, voffA);
        if (wr == 1) PG8_BAR;
        PG8_WAIT_V(4); PG8_BAR;
        PG8_STAGE(PG8_SB(1, 0), cB + kstep, voffB); PG8_STAGE(PG8_SA(1, 0), cA + kstep, voffA); PG8_STAGE(PG8_SB(1, 1), cB + hstep + kstep, voffB);
        PG8_WAIT_V(6); PG8_BAR;
    }
    for (;;) {
        const bool has_next = S.next(ui + 1, nxt);
        const char* nA = has_next ? (const char*)g.A + (size_t)nxt.pm * tstep : cA; const char* nB = has_next ? (const char*)g.Bt + (size_t)nxt.pn * tstep : cB;
        for (int t = 0; t < nt; t += 2) {
            const bool last = (t == nt - 2);
            const char* a1 = cA + (size_t)(t + 1) * kstep;
            const char* a2 = last ? nA : cA + (size_t)(t + 2) * kstep; const char* b2 = last ? nB : cB + (size_t)(t + 2) * kstep;
            const char* a3 = a2 + kstep; const char* b3 = b2 + kstep;
            if (last && has_next) S.a_ready(nxt);
            if constexpr (SP2) {
            PG8_LDB(B0, 0, 0); PG8_LDB(B1, 0, 1); PG8_SCHED; PG8_LDA(At, 0, 0); PG8_STAGE(PG8_SA(1, 1), a1 + hstep, voffA);
            PG8_WAIT_V(8); PG8_WAIT_L(0); PG8_BAR; PG8_MMA(0, 0, At, B0); PG8_MMA(0, 1, At, B1); PG8_BAR; PG8_SCHED;
            PG8_LDA(At, 0, 1); PG8_STAGE(PG8_SB(0, 0), b2, voffB); PG8_STAGE(PG8_SB(0, 1), b2 + hstep, voffB); PG8_STAGE(PG8_SA(0, 0), a2, voffA);
            PG8_WAIT_V(8); PG8_WAIT_L(0); PG8_BAR; PG8_MMA(1, 0, At, B0); PG8_MMA(1, 1, At, B1); PG8_BAR; PG8_SCHED;
            PG8_LDB(B0, 1, 0); PG8_LDB(B1, 1, 1); PG8_SCHED; PG8_LDA(At, 1, 0); PG8_STAGE(PG8_SA(0, 1), a2 + hstep, voffA);
            PG8_WAIT_V(8); PG8_WAIT_L(0); PG8_BAR; PG8_MMA(0, 0, At, B0); PG8_MMA(0, 1, At, B1); PG8_BAR; PG8_SCHED;
            PG8_LDA(At, 1, 1); PG8_STAGE(PG8_SB(1, 0), b3, voffB); PG8_STAGE(PG8_SB(1, 1), b3 + hstep, voffB); PG8_STAGE(PG8_SA(1, 0), a3, voffA);
            PG8_WAIT_V(8); PG8_WAIT_L(0); PG8_BAR; PG8_MMA(1, 0, At, B0); PG8_MMA(1, 1, At, B1); PG8_BAR; PG8_SCHED;
            } else {
            PG8_LDB(B0, 0, 0); PG8_SCHED; PG8_LDA(At, 0, 0); PG8_STAGE(PG8_SA(1, 1), a1 + hstep, voffA);
            PG8_WAIT_L(8); PG8_BAR; PG8_WAIT_L(0); PG8_MMA(0, 0, At, B0); PG8_BAR; PG8_SCHED;
            PG8_LDB(B1, 0, 1); PG8_STAGE(PG8_SB(0, 0), b2, voffB);
            PG8_BAR; PG8_WAIT_L(0); PG8_MMA(0, 1, At, B1); PG8_BAR;
            PG8_LDA(At, 0, 1); PG8_STAGE(PG8_SA(0, 0), a2, voffA);
            PG8_BAR; PG8_WAIT_L(0); PG8_MMA(1, 0, At, B0); PG8_BAR; PG8_SCHED;
            PG8_STAGE(PG8_SB(0, 1), b2 + hstep, voffB);
            PG8_WAIT_V(6); PG8_BAR; PG8_MMA(1, 1, At, B1); PG8_BAR;
            PG8_LDB(B0, 1, 0); PG8_SCHED; PG8_LDA(At, 1, 0); PG8_STAGE(PG8_SA(0, 1), a2 + hstep, voffA);
            PG8_WAIT_L(8); PG8_BAR; PG8_WAIT_L(0); PG8_MMA(0, 0, At, B0); PG8_BAR; PG8_SCHED;
            PG8_LDB(B1, 1, 1); PG8_STAGE(PG8_SB(1, 0), b3, voffB);
            PG8_BAR; PG8_WAIT_L(0); PG8_MMA(0, 1, At, B1); PG8_BAR;
            PG8_LDA(At, 1, 1); PG8_STAGE(PG8_SA(1, 0), a3, voffA);
            PG8_BAR; PG8_WAIT_L(0); PG8_MMA(1, 0, At, B0); PG8_BAR; PG8_SCHED;
            PG8_STAGE(PG8_SB(1, 1), b3 + hstep, voffB);
            PG8_WAIT_V(6); PG8_BAR; PG8_MMA(1, 1, At, B1); PG8_BAR;
            }
        }
        if constexpr (ALIGN_EPI) { if (wr == 0) PG8_BAR; }
        if constexpr (!Epi::AFTER_DRAIN) { E(acc, cur, wr, wc, fr, fq); S.done(cur); }
        if (!has_next) break;
#pragma unroll
        for (int a = 0; a < 2; ++a)
#pragma unroll
            for (int b = 0; b < 2; ++b)
#pragma unroll
                for (int m = 0; m < 4; ++m)
#pragma unroll
                    for (int n = 0; n < 2; ++n) acc[a][b][m][n] = (f32x4){0.f, 0.f, 0.f, 0.f};
        cur = nxt; cA = nA; cB = nB; ++ui;
        if constexpr (ALIGN_EPI) { if (wr == 1) PG8_BAR; }
    }
    PG8_WAIT_V(0);
    if constexpr (!ALIGN_EPI) { if (wr == 0) PG8_BAR; }
    PG8_BAR;
    if constexpr (Epi::AFTER_DRAIN) { E.fused(acc, cur, wr, wc, fr, fq, lds, wid, lane); S.done(cur); }
#undef PG8_SA
#undef PG8_SB
#undef PG8_STAGE
#undef PG8_LDA
#undef PG8_LDB
#undef PG8_MMA
#undef PG8_WAIT_V
#undef PG8_WAIT_L
#undef PG8_BAR
#undef PG8_SCHED
}
}
#define LAS __attribute__((address_space(3)))
#define XB_TMO      128
#define XB_XCNT(j)  (256  + 64 * (j))
#define XB_XSUB(j)  (1280 + 64 * (j))
#define XB_XGEN(j)  (2304 + 64 * (j))
#define XB_TOP      3328
#define XB_TOPGEN   3392
#define XCD_BAR_WORDS 3456
#define XB_SPIN_CAP (1u << 18)

__device__ __forceinline__ unsigned xb_ld(unsigned* p)              { return __hip_atomic_load(p, __ATOMIC_RELAXED, __HIP_MEMORY_SCOPE_AGENT); }
__device__ __forceinline__ unsigned xb_add(unsigned* p, unsigned v) { return __hip_atomic_fetch_add(p, v, __ATOMIC_RELAXED, __HIP_MEMORY_SCOPE_AGENT); }
__device__ __forceinline__ unsigned xb_xcc_id() { return (unsigned)__builtin_amdgcn_s_getreg((3 << 11) | 20) & 0xFu; }
#define XB_SPIN(cond, bar) do { unsigned _sp = 0; while (cond) { __builtin_amdgcn_s_sleep(1); \
    if ((++_sp & 255u) == 0u) { if (xb_ld(&(bar)[XB_TMO])) break; if (_sp > XB_SPIN_CAP) { atomicAdd(&(bar)[XB_TMO], 1u); break; } } } } while (0)

struct XcdBarrier {
    unsigned* bar; unsigned x;
    volatile LAS unsigned* st;
};

__device__ __forceinline__ XcdBarrier xcd_barrier_post(unsigned* bar, volatile LAS unsigned* st) {
    XcdBarrier b; b.bar = bar; b.x = xb_xcc_id(); b.st = st;
    if (threadIdx.x == 0) (void)xb_add(&bar[XB_XCNT(b.x)], 1u);
    return b;
}
__device__ __forceinline__ void xcd_barrier_complete(unsigned* bar, unsigned x, unsigned& nloc, unsigned& nx) {
    const unsigned G = gridDim.x * gridDim.y * gridDim.z;
    unsigned sum, cnt, mine, sp = 0u;
    for (;;) {
        sum = 0u; cnt = 0u; mine = 0u;
#pragma unroll
        for (unsigned j = 0; j < 16; ++j) { const unsigned c = xb_ld(&bar[XB_XCNT(j)]); sum += c; cnt += (c > 0u) ? 1u : 0u; mine = (j == x) ? c : mine; }
        if (sum == G) break;
        __builtin_amdgcn_s_sleep(1);
        if ((++sp & 255u) == 0u) { if (xb_ld(&bar[XB_TMO])) break; if (sp > XB_SPIN_CAP) { atomicAdd(&bar[XB_TMO], 1u); break; } }
    }
    nloc = mine > 0u ? mine : 1u; nx = cnt > 0u ? cnt : 1u;
}

__device__ __forceinline__ void xcd_barrier(const XcdBarrier& b) {
    asm volatile("s_waitcnt vmcnt(0)" ::: "memory");
    __syncthreads();
    if (threadIdx.x == 0) {
        unsigned* bar = b.bar;
        __builtin_amdgcn_s_waitcnt(0);
        unsigned nloc = b.st[0], nx = b.st[1];
        if (nloc == 0u) { xcd_barrier_complete(bar, b.x, nloc, nx); b.st[0] = nloc; b.st[1] = nx; }
        const unsigned old = xb_add(&bar[XB_XSUB(b.x)], 1u);
        const unsigned gen = old / nloc;
        if (old + 1u == (gen + 1u) * nloc) {
            __builtin_amdgcn_fence(__ATOMIC_RELEASE, "agent");
            asm volatile("s_waitcnt vmcnt(0)" ::: "memory");
            const unsigned og = xb_add(&bar[XB_TOP], 1u);
            const unsigned tg = og / nx;
            if (og + 1u == (tg + 1u) * nx) xb_add(&bar[XB_TOPGEN], 1u);
            else XB_SPIN(xb_ld(&bar[XB_TOPGEN]) == tg, bar);
            __builtin_amdgcn_fence(__ATOMIC_ACQUIRE, "agent");
            xb_add(&bar[XB_XGEN(b.x)], 1u);
            asm volatile("s_waitcnt vmcnt(0)" ::: "memory");
        } else {
            XB_SPIN(xb_ld(&bar[XB_XGEN(b.x)]) == gen, bar);
            __builtin_amdgcn_fence(__ATOMIC_ACQUIRE, "agent");
            asm volatile("s_waitcnt vmcnt(0)" ::: "memory");
        }
    }
    __syncthreads();
}

constexpr int NB = 4, T = 4096, M = NB * T, D = 2048, DFF = 5632, INW = 5660, INP = 5888, NL = 2, MODW = 6 * D;
constexpr int C_GLA_Q = 0, C_GLA_K = 256, C_GLA_V = 512, C_GLA_G = 1024, C_GLA_LR = 1536,
              C_GDN_Q = 1552, C_GDN_K = 2064, C_GDN_V = 2576, C_GDN_G = 3088, C_GDN_B = 3600, C_GDN_A = 3604,
              C_POOL = 3608, C_FOX_Q = 4120, C_FOX_K = 4632, C_FOX_V = 5144, C_FOX_F = 5656;
constexpr float EPS = 1e-6f;
constexpr float LOG2E = 1.4426950408889634f;
constexpr size_t MiB = 1u << 20;
constexpr size_t WS_MOD = 1 * MiB, WS_FCUM = 2 * MiB, WS_GLADEC = 3 * MiB, WS_GDNDEC = 4 * MiB, WS_PWT = 5 * MiB;
constexpr size_t WS_WIN = 8 * MiB, WS_WOUT = 31 * MiB, WS_WGU = 39 * MiB, WS_WDN = 83 * MiB;
constexpr size_t WS_H = 105 * MiB, WS_ACT = 169 * MiB, WS_PROJ = 345 * MiB, WS_Y = 529 * MiB, WS_GDN = 593 * MiB, WS_GLA = 665 * MiB, WS_VT = 705 * MiB, WS_END = 721 * MiB;
constexpr size_t WS_SIDE = WS_VT;
constexpr size_t WS_GU = WS_PROJ;
static_assert(WS_GU + (size_t)M * 2 * DFF * 2 <= WS_VT, "GU overlay");
constexpr size_t GDN_ITEM = 73728, GLA_ITEM = 40960;
constexpr int LDS_BYTES = 147456;

typedef unsigned short bf16;
typedef float f32x4 __attribute__((ext_vector_type(4)));
typedef float f32x2 __attribute__((ext_vector_type(2)));
typedef short bf16x8 __attribute__((ext_vector_type(8)));
typedef unsigned u32x4v __attribute__((ext_vector_type(4)));
typedef unsigned u32x2v __attribute__((ext_vector_type(2)));

__device__ __forceinline__ unsigned f2bf(float f) { unsigned u = __builtin_bit_cast(unsigned, f); return (u + 0x7fffu + ((u >> 16) & 1u)) >> 16; }
__device__ __forceinline__ unsigned pk2(float lo, float hi) { unsigned r; asm("v_cvt_pk_bf16_f32 %0, %1, %2" : "=v"(r) : "v"(lo), "v"(hi)); return r; }
__device__ __forceinline__ bf16 bf1(float x) { return (bf16)pk2(x, x); }
__device__ __forceinline__ float bflo(unsigned w) { return __builtin_bit_cast(float, w << 16); }
__device__ __forceinline__ float bfhi(unsigned w) { return __builtin_bit_cast(float, w & 0xffff0000u); }
__device__ __forceinline__ float bf2f(bf16 b) { return __builtin_bit_cast(float, (unsigned)b << 16); }
#define DPPF(x, ctrl, rmask, bound) __builtin_bit_cast(float, __builtin_amdgcn_update_dpp(0, __builtin_bit_cast(int, (x)), (ctrl), (rmask), 0xf, (bound)))
__device__ __forceinline__ float readlane_f(float v, int l) { return __builtin_bit_cast(float, __builtin_amdgcn_readlane(__builtin_bit_cast(int, v), l)); }
__device__ __forceinline__ float wave_sum(float v) {
    v += DPPF(v, 0x128, 0xf, false); v += DPPF(v, 0x124, 0xf, false); v += DPPF(v, 0x122, 0xf, false); v += DPPF(v, 0x121, 0xf, false);
    return (readlane_f(v, 0) + readlane_f(v, 16)) + (readlane_f(v, 32) + readlane_f(v, 48));
}
__device__ __forceinline__ float wave_iscan(float x, int lane) {
    (void)lane;
    x += DPPF(x, 0x111, 0xf, true); x += DPPF(x, 0x112, 0xf, true); x += DPPF(x, 0x114, 0xf, true); x += DPPF(x, 0x118, 0xf, true);
    x += DPPF(x, 0x142, 0xa, false);
    x += DPPF(x, 0x143, 0xc, false);
    return x;
}
__device__ __forceinline__ float sigmoidf_(float x) { return __builtin_amdgcn_rcpf(1.f + __expf(-x)); }
__device__ __forceinline__ float siluf_(float x) { return x * __builtin_amdgcn_rcpf(1.f + __expf(-x)); }
__device__ __forceinline__ float logsigmoidf_(float x) { return fminf(x, 0.f) - __logf(1.f + __expf(-fabsf(x))); }
__device__ __forceinline__ float softplusf_(float x) { return fmaxf(x, 0.f) + __logf(1.f + __expf(-fabsf(x))); }
__device__ __forceinline__ bf16x8 pack8(const f32x4 a, const f32x4 b) {
    u32x4v w; w.x = pk2(a[0], a[1]); w.y = pk2(a[2], a[3]); w.z = pk2(b[0], b[1]); w.w = pk2(b[2], b[3]);
    return __builtin_bit_cast(bf16x8, w);
}
__device__ __forceinline__ bf16x8 afrag_perm(const bf16* rowp, int k0, int fq) {
    const u32x2v lo = *(const u32x2v*)(rowp + k0 + 4 * fq), hi = *(const u32x2v*)(rowp + k0 + 16 + 4 * fq);
    u32x4v w; w.x = lo.x; w.y = lo.y; w.z = hi.x; w.w = hi.y; return __builtin_bit_cast(bf16x8, w);
}
#define LAS3 __attribute__((address_space(3)))
#define LDSBAR() do { asm volatile("s_waitcnt lgkmcnt(0)" ::: "memory"); __builtin_amdgcn_s_barrier(); asm volatile("" ::: "memory"); } while (0)
#define SB() __builtin_amdgcn_sched_barrier(0)
__device__ __forceinline__ float row16_sum(float x) {
    x += __builtin_bit_cast(float, __builtin_amdgcn_update_dpp(0, __builtin_bit_cast(int, x), 0x128, 0xf, 0xf, false));
    x += __builtin_bit_cast(float, __builtin_amdgcn_update_dpp(0, __builtin_bit_cast(int, x), 0x124, 0xf, 0xf, false));
    x += __builtin_bit_cast(float, __builtin_amdgcn_update_dpp(0, __builtin_bit_cast(int, x), 0x122, 0xf, 0xf, false));
    x += __builtin_bit_cast(float, __builtin_amdgcn_update_dpp(0, __builtin_bit_cast(int, x), 0x121, 0xf, 0xf, false));
    return x;
}
__device__ __forceinline__ void lds_put_perm(bf16* rowp, int c0, const u32x4v v) {
    const int blk = c0 & ~31, k = c0 & 31;
    const int plo = (k < 16) ? 2 * k : 2 * k - 28, phi = (k + 4 < 16) ? 2 * (k + 4) : 2 * (k + 4) - 28;
    *(u32x2v*)(rowp + blk + plo) = (u32x2v){v.x, v.y}; *(u32x2v*)(rowp + blk + phi) = (u32x2v){v.z, v.w};
}
__device__ __forceinline__ bf16x8 afrag_lin(const bf16* rowp, int k0, int fq) { return *(const bf16x8*)(rowp + k0 + 8 * fq); }
#define MFMA16(a, b, c) __builtin_amdgcn_mfma_f32_16x16x32_bf16((a), (b), (c), 0, 0, 0)

__device__ __forceinline__ void phase_mod(const float* c, const float* w_mod, const float* b_mod, float* mod, unsigned char* lds) {
    float* sc = (float*)lds;
    float* part = sc + 4 * 2048;
    const int tid = fresh_tid();
    for (int i = tid; i < NB * D; i += 512) sc[i] = siluf_(c[i]);
    __syncthreads();
    for (int chunk = fresh_bid(); chunk < 256; chunk += gridDim.x) {
        const int l = chunk >> 7, col0 = (chunk & 127) * 96;
        if (tid < 384) {
            const int cgi = tid % 24, ks = tid / 24;
            const float* W = w_mod + (size_t)l * D * MODW + col0 + cgi * 4;
            f32x4 a0 = {0.f, 0.f, 0.f, 0.f}, a1 = a0, a2 = a0, a3 = a0;
#pragma unroll 8
            for (int k = ks * 128; k < ks * 128 + 128; ++k) {
                const f32x4 w = *(const f32x4*)(W + (size_t)k * MODW);
                a0 += sc[k] * w; a1 += sc[D + k] * w; a2 += sc[2 * D + k] * w; a3 += sc[3 * D + k] * w;
            }
            float* p = part + (ks * 24 + cgi) * 16;
            *(f32x4*)(p) = a0; *(f32x4*)(p + 4) = a1; *(f32x4*)(p + 8) = a2; *(f32x4*)(p + 12) = a3;
        }
        __syncthreads();
        if (tid < 384) {
            const int cgi = tid >> 4, bj = tid & 15, b = bj >> 2, j = bj & 3;
            float s = 0.f;
#pragma unroll
            for (int ks = 0; ks < 16; ++ks) s += part[(ks * 24 + cgi) * 16 + bj];
            const int col = col0 + cgi * 4 + j;
            mod[(size_t)(l * NB + b) * MODW + col] = s + b_mod[(size_t)l * MODW + col];
        }
        __syncthreads();
    }
}

struct TrDesc { const float* W; bf16* WT; int K, N, nblk, il, r; };
struct LayerW { const float *w_in, *w_out, *w_gate, *w_up, *w_down, *pool_w; };
__device__ __forceinline__ TrDesc tr_resolve(const LayerW& L, unsigned char* wsp, int part, int it) {
    constexpr int I0 = 32 * 184, I1 = 32 * 64, I2 = 32 * 176, I5 = 8;
    TrDesc d; int r = it;
    if (part == 0) {
        if (r < I0) { d.W = L.w_in; d.WT = (bf16*)(wsp + WS_WIN); d.K = D; d.N = INW; d.nblk = 184; d.il = -1; d.r = r; return d; } r -= I0;
        const int g = r / I5; r -= g * I5;
        d.W = L.pool_w + (size_t)g * 128 * 128; d.WT = (bf16*)(wsp + WS_PWT) + (size_t)g * 128 * 128; d.K = 128; d.N = 128; d.nblk = 4; d.il = -1; d.r = r; return d;
    }
    if (r < I1) { d.W = L.w_out; d.WT = (bf16*)(wsp + WS_WOUT); d.K = D; d.N = D; d.nblk = 64; d.il = -1; d.r = r; return d; } r -= I1;
    if (r < I2) { d.W = L.w_gate; d.WT = (bf16*)(wsp + WS_WGU); d.K = D; d.N = DFF; d.nblk = 176; d.il = 0; d.r = r; return d; } r -= I2;
    if (r < I2) { d.W = L.w_up; d.WT = (bf16*)(wsp + WS_WGU); d.K = D; d.N = DFF; d.nblk = 176; d.il = 128; d.r = r; return d; } r -= I2;
    d.W = L.w_down; d.WT = (bf16*)(wsp + WS_WDN); d.K = DFF; d.N = D; d.nblk = 64; d.il = -1; d.r = r; return d;
}
__device__ __forceinline__ void tr_load(const TrDesc& d, int lane, float (&v)[32]) {
    const int kb = d.r / d.nblk, nb = d.r % d.nblk, k0 = 64 * kb, n = 32 * nb + (lane & 31);
    const float* p = d.W + (size_t)(k0 + (lane >> 5)) * d.N + n;
    const bool ok = n < d.N;
#pragma unroll
    for (int i = 0; i < 32; ++i) v[i] = ok ? p[(size_t)(2 * i) * d.N] : 0.f;
}
__device__ __forceinline__ void tr_store(const TrDesc& d, int lane, const float (&v)[32], float* scr) {
    const int kb = d.r / d.nblk, nb = d.r % d.nblk, k0 = 64 * kb, n0 = 32 * nb;
#pragma unroll
    for (int i = 0; i < 32; ++i) scr[(2 * i + (lane >> 5)) * 33 + (lane & 31)] = v[i];
    asm volatile("s_waitcnt lgkmcnt(0)" ::: "memory");
    const int c = lane & 7;
#pragma unroll
    for (int j = 0; j < 4; ++j) { const int nn = (lane >> 3) + 8 * j; const float* s = scr + (8 * c) * 33 + nn;
        u32x4v o; o.x = pk2(s[0 * 33], s[1 * 33]); o.y = pk2(s[2 * 33], s[3 * 33]); o.z = pk2(s[4 * 33], s[5 * 33]); o.w = pk2(s[6 * 33], s[7 * 33]);
        const int row = (d.il < 0) ? (n0 + nn) : (((n0 + nn) >> 7) * 256 + d.il + ((n0 + nn) & 127));
        *(u32x4v*)(d.WT + (size_t)row * d.K + k0 + 8 * c) = o; }
    asm volatile("s_waitcnt lgkmcnt(0)" ::: "memory");
}
__device__ __forceinline__ void phase_transpose(const LayerW& L, unsigned char* wsp, unsigned char* lds, int part, int blk0, int nblk) {
    const int tid_ = fresh_tid(), wave = __builtin_amdgcn_readfirstlane(tid_ >> 6), lane = tid_ & 63;
    float* scr = (float*)lds + wave * (64 * 33);
    const int gw = (fresh_bid() - blk0) * 8 + wave, NGW = nblk * 8;
    constexpr int I0 = 32 * 184, I1 = 32 * 64, I2 = 32 * 176, I4 = 88 * 64, I5 = 8;
    const int NIT = (part == 0) ? I0 + 4 * I5 : I1 + 2 * I2 + I4;
    if (gw < 0 || gw >= NIT) return;
    float va[32], vb[32];
    TrDesc da = tr_resolve(L, wsp, part, gw), db = da;
    tr_load(da, lane, va);
    for (int it = gw; it < NIT; it += 2 * NGW) {
        const bool hb = it + NGW < NIT, ha = it + 2 * NGW < NIT;
        if (hb) { db = tr_resolve(L, wsp, part, it + NGW); tr_load(db, lane, vb); }
        tr_store(da, lane, va, scr);
        if (ha) { da = tr_resolve(L, wsp, part, it + 2 * NGW); tr_load(da, lane, va); }
        if (hb) tr_store(db, lane, vb, scr);
    }
}

__device__ __forceinline__ void phase_norm(const float* x, const float* nw, const float* modl, int shi, int sci, bf16* Hp) {
    const int tid_ = fresh_tid(), wave = __builtin_amdgcn_readfirstlane(tid_ >> 6), lane = tid_ & 63;
    const int gw = fresh_bid() * 8 + wave, NGW = gridDim.x * 8;
#define NORM_LOAD(V, m_) do { const f32x4* xr_ = (const f32x4*)(x + (size_t)(m_) * D) + lane; _Pragma("unroll") for (int j = 0; j < 8; ++j) V[j] = xr_[64 * j]; } while (0)
#define NORM_DO(V, m_) do { float ss = 0.f; \
        _Pragma("unroll") for (int j = 0; j < 8; ++j) ss += (V[j].x * V[j].x + V[j].y * V[j].y) + (V[j].z * V[j].z + V[j].w * V[j].w); \
        const float r = rsqrtf(wave_sum(ss) * (1.f / D) + EPS); \
        const float* mb = modl + (size_t)((m_) / T) * MODW; \
        f32x4 sc_[8], sh_[8]; \
        _Pragma("unroll") for (int j = 0; j < 8; ++j) { const int col = 4 * lane + 256 * j; sc_[j] = *(const f32x4*)(mb + sci * D + col); sh_[j] = *(const f32x4*)(mb + shi * D + col); } \
        SB(); \
        _Pragma("unroll") for (int j = 0; j < 8; ++j) { const int col = 4 * lane + 256 * j; \
            const f32x4 y = V[j] * r * wv[j] * (1.f + sc_[j]) + sh_[j]; \
            u32x2v o; o.x = pk2(y.x, y.y); o.y = pk2(y.z, y.w); \
            *(u32x2v*)(Hp + (size_t)(m_) * D + col) = o; } } while (0)
    if (gw >= M) return;
    f32x4 va[8], vb[8], wv[8];
#pragma unroll
    for (int j = 0; j < 8; ++j) wv[j] = *(const f32x4*)(nw + 4 * lane + 256 * j);
    NORM_LOAD(va, gw);
    for (int m = gw; m < M; m += 2 * NGW) {
        const bool hb = m + NGW < M, ha = m + 2 * NGW < M;
        if (hb) NORM_LOAD(vb, m + NGW);
        NORM_DO(va, m);
        if (ha) NORM_LOAD(va, m + 2 * NGW);
        if (hb) NORM_DO(vb, m + NGW);
    }
#undef NORM_DO
}
__device__ __forceinline__ void phase_final_norm(float* x, const float* nw) {
    const int tid_ = fresh_tid(), wave = __builtin_amdgcn_readfirstlane(tid_ >> 6), lane = tid_ & 63;
    const int gw = fresh_bid() * 8 + wave, NGW = gridDim.x * 8;
#define FNORM_DO(V, m_) do { float ss = 0.f; \
        _Pragma("unroll") for (int j = 0; j < 8; ++j) ss += (V[j].x * V[j].x + V[j].y * V[j].y) + (V[j].z * V[j].z + V[j].w * V[j].w); \
        const float r = rsqrtf(wave_sum(ss) * (1.f / D) + EPS); \
        f32x4* xo_ = (f32x4*)(x + (size_t)(m_) * D) + lane; \
        _Pragma("unroll") for (int j = 0; j < 8; ++j) xo_[64 * j] = V[j] * r * wv[j]; } while (0)
    if (gw >= M) return;
    f32x4 va[8], vb[8], wv[8];
#pragma unroll
    for (int j = 0; j < 8; ++j) wv[j] = *(const f32x4*)(nw + 4 * lane + 256 * j);
    NORM_LOAD(va, gw);
    for (int m = gw; m < M; m += 2 * NGW) {
        const bool hb = m + NGW < M, ha = m + 2 * NGW < M;
        if (hb) NORM_LOAD(vb, m + NGW);
        FNORM_DO(va, m);
        if (ha) NORM_LOAD(va, m + 2 * NGW);
        if (hb) FNORM_DO(vb, m + NGW);
    }
#undef FNORM_DO
#undef NORM_LOAD
}

__device__ __forceinline__ void gdn_prep_item(int item, const bf16* PROJ, const float* conv_w, const float* a_log, const float* dt_bias,
                                              unsigned char* scr_base, float* gdn_dec, unsigned char* lds) {
    const int tid = fresh_tid(), wave = __builtin_amdgcn_readfirstlane(tid >> 6), lane = tid & 63, fr = lane & 15, fq = lane >> 4;
    const int bh = item >> 6, n = item & 63, b = bh >> 2, h = bh & 3, t0 = n * 64;
    const size_t row0 = (size_t)b * T + t0;
    bf16* Kb = (bf16*)lds;
    bf16* Qb = Kb + 64 * 144;
    float* RHS = (float*)(Qb + 64 * 144);
    float* Lm = RHS + 64 * 260;
    float* bs = Lm + 64 * 68;
    float* gc = bs + 64;
    unsigned char* scr = scr_base + (size_t)item * GDN_ITEM;
    bf16* gQG = (bf16*)scr; bf16* gW = (bf16*)(scr + 16384); bf16* gK2T = (bf16*)(scr + 32768); bf16* gUT = (bf16*)(scr + 49152); bf16* gATT = (bf16*)(scr + 65536);
    if (wave == 0) {
        const bf16* pr = PROJ + (row0 + lane) * INP;
        const float a_in = bf2f(pr[C_GDN_A + h]), b_in = bf2f(pr[C_GDN_B + h]);
        const float g = -__expf(a_log[h]) * softplusf_(a_in + dt_bias[h]);
        gc[lane] = wave_iscan(g, lane); bs[lane] = sigmoidf_(b_in);
    }
    unsigned xr[3][11];
#pragma unroll
    for (int p = 0; p < 3; ++p)
#pragma unroll
        for (int i = 0; i < 11; ++i) { const int tt = t0 + 8 * wave + i - 3;
            xr[p][i] = (tt >= 0) ? *(const unsigned*)(PROJ + ((size_t)b * T + tt) * INP + C_GDN_Q + p * 512 + h * 128 + 2 * lane) : 0u; }
    LDSBAR();
#pragma unroll
    for (int p = 0; p < 3; ++p) {
        f32x2 cw[4];
#pragma unroll
        for (int j = 0; j < 4; ++j) cw[j] = *(const f32x2*)(conv_w + j * 1536 + p * 512 + h * 128 + 2 * lane);
#pragma unroll
        for (int i = 0; i < 8; ++i) {
            float y0 = 0.f, y1 = 0.f;
#pragma unroll
            for (int j = 0; j < 4; ++j) { y0 += cw[j].x * bflo(xr[p][i + j]); y1 += cw[j].y * bfhi(xr[p][i + j]); }
            y0 = siluf_(y0); y1 = siluf_(y1);
            const int t = 8 * wave + i;
            if (p == 0) { const float sc = rsqrtf(wave_sum(y0 * y0 + y1 * y1) + EPS) * 0.08838834764831845f;
                *(unsigned*)(Qb + t * 144 + 2 * lane) = pk2(y0 * sc, y1 * sc); }
            else if (p == 1) { const float sc = rsqrtf(wave_sum(y0 * y0 + y1 * y1) + EPS); y0 *= sc; y1 *= sc;
                *(unsigned*)(Kb + t * 144 + 2 * lane) = pk2(y0, y1);
                const float f = bs[t] * __expf(gc[t]);
                *(f32x2*)(RHS + t * 260 + 128 + 2 * lane) = (f32x2){y0 * f, y1 * f}; }
            else { const float f = bs[t]; *(f32x2*)(RHS + t * 260 + 2 * lane) = (f32x2){y0 * f, y1 * f}; }
        }
    }
    LDSBAR();
#pragma unroll
    for (int r = 0; r < 4; ++r) {
        const int tl = wave + 8 * r, isqk = tl >> 4, it = (tl & 15) >> 2, jt = tl & 3;
        f32x4 acc = {0.f, 0.f, 0.f, 0.f};
        if (jt <= it) {
            if (isqk) {
#pragma unroll
                for (int ks = 0; ks < 4; ++ks) acc = MFMA16(*(const bf16x8*)(Kb + (16 * jt + fr) * 144 + 32 * ks + 8 * fq), *(const bf16x8*)(Qb + (16 * it + fr) * 144 + 32 * ks + 8 * fq), acc);
            } else {
#pragma unroll
                for (int ks = 0; ks < 4; ++ks) acc = MFMA16(*(const bf16x8*)(Kb + (16 * it + fr) * 144 + 32 * ks + 8 * fq), *(const bf16x8*)(Kb + (16 * jt + fr) * 144 + 32 * ks + 8 * fq), acc);
            }
        }
        if (isqk) {
            const int i = 16 * it + fr; float o[4];
#pragma unroll
            for (int jj = 0; jj < 4; ++jj) { const int j = 16 * jt + 4 * fq + jj; o[jj] = (j <= i) ? acc[jj] * __expf(fminf(gc[i] - gc[j], 0.f)) : 0.f; }
            u32x2v w; w.x = pk2(o[0], o[1]); w.y = pk2(o[2], o[3]);
            *(u32x2v*)(gATT + i * 64 + 16 * jt + 4 * fq) = w;
        } else {
            const int j = 16 * jt + fr;
#pragma unroll
            for (int jj = 0; jj < 4; ++jj) { const int i = 16 * it + 4 * fq + jj; Lm[i * 68 + j] = (j < i) ? bs[i] * acc[jj] * __expf(fminf(gc[i] - gc[j], 0.f)) : 0.f; }
        }
    }
    LDSBAR();
    if (tid < 256) {
        const int c = tid;
        LAS3 const float* Lb = (LAS3 const float*)Lm; asm volatile("" : "+v"(Lb));
        LAS3 const float* Rb = (LAS3 const float*)RHS + c; asm volatile("" : "+v"(Rb));
        float x[64];
        f32x4 buf[2][16]; float rb[2];
        rb[0] = Rb[0];
#pragma unroll
        for (int i = 0; i < 64; ++i) {
            if (i + 1 < 64) {
                rb[(i + 1) & 1] = Rb[(i + 1) * 260];
#pragma unroll
                for (int j4 = 0; j4 < (i + 4) / 4; ++j4) buf[(i + 1) & 1][j4] = *(LAS3 const f32x4*)(Lb + (i + 1) * 68 + 4 * j4);
            }
            __builtin_amdgcn_sched_barrier(0);
            float s0 = rb[i & 1], s1 = 0.f, s2 = 0.f, s3 = 0.f;
#pragma unroll
            for (int j4 = 0; j4 < (i + 3) / 4; ++j4) {
                const f32x4 l4 = buf[i & 1][j4];
                s0 -= l4.x * x[4 * j4];
                if (4 * j4 + 1 < i) s1 -= l4.y * x[4 * j4 + 1];
                if (4 * j4 + 2 < i) s2 -= l4.z * x[4 * j4 + 2];
                if (4 * j4 + 3 < i) s3 -= l4.w * x[4 * j4 + 3];
            }
            x[i] = (s0 + s1) + (s2 + s3);
            __builtin_amdgcn_sched_barrier(0);
        }
        if (c < 128) {
#pragma unroll
            for (int q = 0; q < 8; ++q) { u32x4v w; w.x = pk2(x[8 * q], x[8 * q + 1]); w.y = pk2(x[8 * q + 2], x[8 * q + 3]); w.z = pk2(x[8 * q + 4], x[8 * q + 5]); w.w = pk2(x[8 * q + 6], x[8 * q + 7]);
                *(u32x4v*)(gUT + c * 64 + 8 * q) = w; }
        } else {
#pragma unroll
            for (int i = 0; i < 64; ++i) gW[i * 128 + (c - 128)] = bf1(x[i]);
        }
    } else {
        const int tt = tid - 256;
        {
            const int i = tt >> 2, d0 = (tt & 3) * 32; const float e = __expf(gc[i]);
#pragma unroll
            for (int q = 0; q < 4; ++q) { const u32x4v v = *(const u32x4v*)(Qb + i * 144 + d0 + 8 * q); u32x4v w;
                w.x = pk2(bflo(v.x) * e, bfhi(v.x) * e); w.y = pk2(bflo(v.y) * e, bfhi(v.y) * e); w.z = pk2(bflo(v.z) * e, bfhi(v.z) * e); w.w = pk2(bflo(v.w) * e, bfhi(v.w) * e);
                *(u32x4v*)(gQG + i * 128 + d0 + 8 * q) = w; }
        }
        {
            const int d = tt & 127, j0 = (tt >> 7) * 32; const float gl = gc[63];
#pragma unroll
            for (int q = 0; q < 4; ++q) { float v[8];
#pragma unroll
                for (int e = 0; e < 8; ++e) { const int j = j0 + 8 * q + e; v[e] = bf2f(Kb[j * 144 + d]) * __expf(gl - gc[j]); }
                u32x4v w; w.x = pk2(v[0], v[1]); w.y = pk2(v[2], v[3]); w.z = pk2(v[4], v[5]); w.w = pk2(v[6], v[7]);
                *(u32x4v*)(gK2T + d * 64 + j0 + 8 * q) = w; }
        }
        if (tt == 0) gdn_dec[item] = __expf(gc[63]);
    }
    LDSBAR();
}

__device__ __forceinline__ void gla_prep_item(int item, const bf16* PROJ, const float* w_lr, const float* b_lr, unsigned char* scr_base, float* gla_dec, unsigned char* lds) {
    const int tid = fresh_tid(), wave = __builtin_amdgcn_readfirstlane(tid >> 6), lane = tid & 63, fr = lane & 15, fq = lane >> 4;
    const int bh = item >> 6, n = item & 63, b = bh >> 2, h = bh & 3, t0 = n * 64;
    const size_t row0 = (size_t)b * T + t0;
    bf16* QGs = (bf16*)lds;
    bf16* KGs = QGs + 64 * 80;
    bf16* Vs = KGs + 64 * 80;
    unsigned char* scr = scr_base + (size_t)item * GLA_ITEM;
    bf16* gQG = (bf16*)scr; bf16* gK2T = (bf16*)(scr + 8192); bf16* gUT = (bf16*)(scr + 16384); bf16* gATT = (bf16*)(scr + 32768);
    {
        const int r = tid >> 3, sg = tid & 7;
        const bf16* src = PROJ + (row0 + r) * INP + C_GLA_V + h * 128 + 16 * sg;
        const u32x4v v0 = *(const u32x4v*)src, v1 = *(const u32x4v*)(src + 8);
        *(u32x4v*)(Vs + r * 136 + 16 * sg) = v0; *(u32x4v*)(Vs + r * 136 + 16 * sg + 8) = v1;
    }
    {
        const bf16* pr = PROJ + (row0 + lane) * INP;
        const u32x4v g0 = *(const u32x4v*)(pr + C_GLA_LR), g1 = *(const u32x4v*)(pr + C_GLA_LR + 8);
        float glr[16];
        glr[0] = bflo(g0.x); glr[1] = bfhi(g0.x); glr[2] = bflo(g0.y); glr[3] = bfhi(g0.y); glr[4] = bflo(g0.z); glr[5] = bfhi(g0.z); glr[6] = bflo(g0.w); glr[7] = bfhi(g0.w);
        glr[8] = bflo(g1.x); glr[9] = bfhi(g1.x); glr[10] = bflo(g1.y); glr[11] = bfhi(g1.y); glr[12] = bflo(g1.z); glr[13] = bfhi(g1.z); glr[14] = bflo(g1.w); glr[15] = bfhi(g1.w);
        const u32x4v qv = *(const u32x4v*)(pr + C_GLA_Q + h * 64 + 8 * wave), kv = *(const u32x4v*)(pr + C_GLA_K + h * 64 + 8 * wave);
        float q[8], k[8];
        q[0] = bflo(qv.x); q[1] = bfhi(qv.x); q[2] = bflo(qv.y); q[3] = bfhi(qv.y); q[4] = bflo(qv.z); q[5] = bfhi(qv.z); q[6] = bflo(qv.w); q[7] = bfhi(qv.w);
        k[0] = bflo(kv.x); k[1] = bfhi(kv.x); k[2] = bflo(kv.y); k[3] = bfhi(kv.y); k[4] = bflo(kv.z); k[5] = bfhi(kv.z); k[6] = bflo(kv.w); k[7] = bfhi(kv.w);
        float qg[8], kg[8], k2[8];
        const int dc0 = h * 64 + 8 * wave;
        const float wlo = w_lr[(lane >> 3) * 256 + dc0 + (lane & 7)], whi = w_lr[((lane >> 3) + 8) * 256 + dc0 + (lane & 7)], blv = b_lr[dc0 + (lane & 7)];
#pragma unroll
        for (int i = 0; i < 8; ++i) {
            float z = readlane_f(blv, i);
#pragma unroll
            for (int r = 0; r < 16; ++r) z += glr[r] * readlane_f(r < 8 ? wlo : whi, (r & 7) * 8 + i);
            const float bc = wave_iscan(logsigmoidf_(z) * (1.f / 16.f), lane);
            const float bl = readlane_f(bc, 63);
            qg[i] = q[i] * 0.125f * __expf(bc); kg[i] = k[i] * __expf(-bc); k2[i] = k[i] * __expf(bl - bc);
            gK2T[(8 * wave + i) * 64 + lane] = bf1(k2[i]);
            if (lane == 63) gla_dec[(size_t)item * 64 + 8 * wave + i] = __expf(bl);
        }
        u32x4v w; w.x = pk2(qg[0], qg[1]); w.y = pk2(qg[2], qg[3]); w.z = pk2(qg[4], qg[5]); w.w = pk2(qg[6], qg[7]);
        *(u32x4v*)(QGs + lane * 80 + 8 * wave) = w; *(u32x4v*)(gQG + lane * 64 + 8 * wave) = w;
        w.x = pk2(kg[0], kg[1]); w.y = pk2(kg[2], kg[3]); w.z = pk2(kg[4], kg[5]); w.w = pk2(kg[6], kg[7]);
        *(u32x4v*)(KGs + lane * 80 + 8 * wave) = w;
    }
    LDSBAR();
    {
        const int v = tid >> 2, ts = (tid & 3) * 16; float x[16];
#pragma unroll
        for (int e = 0; e < 16; ++e) x[e] = bf2f(Vs[(ts + e) * 136 + v]);
        u32x4v w; w.x = pk2(x[0], x[1]); w.y = pk2(x[2], x[3]); w.z = pk2(x[4], x[5]); w.w = pk2(x[6], x[7]);
        *(u32x4v*)(gUT + v * 64 + ts) = w;
        w.x = pk2(x[8], x[9]); w.y = pk2(x[10], x[11]); w.z = pk2(x[12], x[13]); w.w = pk2(x[14], x[15]);
        *(u32x4v*)(gUT + v * 64 + ts + 8) = w;
    }
#pragma unroll
    for (int r = 0; r < 2; ++r) {
        const int tl = wave + 8 * r, it = tl >> 2, jt = tl & 3;
        f32x4 acc = {0.f, 0.f, 0.f, 0.f};
        if (jt <= it) {
#pragma unroll
            for (int ks = 0; ks < 2; ++ks) acc = MFMA16(*(const bf16x8*)(KGs + (16 * jt + fr) * 80 + 32 * ks + 8 * fq), *(const bf16x8*)(QGs + (16 * it + fr) * 80 + 32 * ks + 8 * fq), acc);
        }
        const int i = 16 * it + fr; float o[4];
#pragma unroll
        for (int jj = 0; jj < 4; ++jj) { const int j = 16 * jt + 4 * fq + jj; o[jj] = (j <= i) ? acc[jj] : 0.f; }
        u32x2v w; w.x = pk2(o[0], o[1]); w.y = pk2(o[2], o[3]);
        *(u32x2v*)(gATT + i * 64 + 16 * jt + 4 * fq) = w;
    }
    LDSBAR();
}

__device__ __forceinline__ void pool_item(int item, const bf16* PROJ, const bf16* PWT, const float* pscale, bf16* Y, unsigned char* lds) {
    const int tid = fresh_tid(), wave = __builtin_amdgcn_readfirstlane(tid >> 6), lane = tid & 63, fr = lane & 15, fq = lane >> 4;
    const int g = item & 3, tile = item >> 2, b = tile >> 6, t0 = (tile & 63) * 64, win = 2 << g;
    float* Us = (float*)lds;
    bf16* As = (bf16*)(Us + 79 * 128);
    bf16* Bs = As + 64 * 144;
    {
        u32x4v ur[3], pr[4];
#pragma unroll
        for (int i = 0; i < 3; ++i) { const int p = tid + 512 * i, r = p >> 4, sg = p & 15, tt = t0 + r - 15;
            ur[i] = (u32x4v){0u, 0u, 0u, 0u};
            if (p < 79 * 16 && tt >= 0) ur[i] = *(const u32x4v*)(PROJ + ((size_t)b * T + tt) * INP + C_POOL + g * 128 + 8 * sg); }
#pragma unroll
        for (int i = 0; i < 4; ++i) { const int p = tid + 512 * i, r = p >> 4, sg = p & 15;
            pr[i] = *(const u32x4v*)(PWT + (size_t)g * 128 * 128 + r * 128 + 8 * sg); }
#pragma unroll
        for (int i = 0; i < 3; ++i) { const int p = tid + 512 * i, r = p >> 4, sg = p & 15;
            if (p < 79 * 16) { float* d = Us + r * 128 + 8 * sg; const u32x4v v = ur[i];
                *(f32x4*)d = (f32x4){bflo(v.x), bfhi(v.x), bflo(v.y), bfhi(v.y)}; *(f32x4*)(d + 4) = (f32x4){bflo(v.z), bfhi(v.z), bflo(v.w), bfhi(v.w)}; } }
#pragma unroll
        for (int i = 0; i < 4; ++i) { const int p = tid + 512 * i, r = p >> 4, sg = p & 15; *(u32x4v*)(Bs + r * 144 + 8 * sg) = pr[i]; }
    }
    LDSBAR();
    {
        const int c = tid & 127, tg = tid >> 7;
        float s = 0.f;
        for (int j = 1; j < win; ++j) s += Us[(15 + 16 * tg - j) * 128 + c];
#pragma unroll 4
        for (int e = 0; e < 16; ++e) { const int r = 15 + 16 * tg + e; const float u = Us[r * 128 + c]; s += u;
            const int cnt = min(t0 + 16 * tg + e + 1, win);
            As[(16 * tg + e) * 144 + c] = bf1(s * __builtin_amdgcn_rcpf((float)cnt) - u);
            s -= Us[(r - win + 1) * 128 + c]; }
    }
    LDSBAR();
    {
        f32x4 acc[4];
#pragma unroll
        for (int mt = 0; mt < 4; ++mt) acc[mt] = (f32x4){0.f, 0.f, 0.f, 0.f};
#pragma unroll
        for (int ks = 0; ks < 4; ++ks) { const bf16x8 bw = *(const bf16x8*)(Bs + (16 * wave + fr) * 144 + 32 * ks + 8 * fq);
#pragma unroll
            for (int mt = 0; mt < 4; ++mt) acc[mt] = MFMA16(bw, *(const bf16x8*)(As + (16 * mt + fr) * 144 + 32 * ks + 8 * fq), acc[mt]); }
        const f32x4 sc = *(const f32x4*)(pscale + g * 128 + 16 * wave + 4 * fq);
#pragma unroll
        for (int mt = 0; mt < 4; ++mt) { const f32x4 o = acc[mt] * sc; u32x2v w; w.x = pk2(o.x, o.y); w.y = pk2(o.z, o.w);
            *(u32x2v*)(Y + ((size_t)b * T + t0 + 16 * mt + fr) * D + 1024 + g * 128 + 16 * wave + 4 * fq) = w; }
    }
    LDSBAR();
}

__device__ __forceinline__ void vt_item(int item, const bf16* PROJ, bf16* VT, unsigned char* lds) {
    const int tid = fresh_tid();
    const int bh = item >> 6, n = item & 63, b = bh >> 2, h = bh & 3, t0 = n * 64;
    bf16* Vs = (bf16*)lds;
    {
        const int r = tid >> 3, sg = tid & 7;
        const bf16* src = PROJ + ((size_t)b * T + t0 + r) * INP + C_FOX_V + h * 128 + 16 * sg;
        const u32x4v v0 = *(const u32x4v*)src, v1 = *(const u32x4v*)(src + 8);
        *(u32x4v*)(Vs + r * 136 + 16 * sg) = v0; *(u32x4v*)(Vs + r * 136 + 16 * sg + 8) = v1;
    }
    LDSBAR();
    {
        const int v = tid >> 2, ts = (tid & 3) * 16; float x[16];
#pragma unroll
        for (int e = 0; e < 16; ++e) x[e] = bf2f(Vs[(ts + e) * 136 + v]);
        bf16* dst = VT + ((size_t)bh * 128 + v) * T + t0 + ts;
        u32x4v w; w.x = pk2(x[0], x[1]); w.y = pk2(x[2], x[3]); w.z = pk2(x[4], x[5]); w.w = pk2(x[6], x[7]);
        *(u32x4v*)dst = w;
        w.x = pk2(x[8], x[9]); w.y = pk2(x[10], x[11]); w.z = pk2(x[12], x[13]); w.w = pk2(x[14], x[15]);
        *(u32x4v*)(dst + 8) = w;
    }
    LDSBAR();
}
__device__ __forceinline__ void fcum_item(int b, const bf16* PROJ, const float* f_bias, float* FCUM, unsigned char* lds) {
    const int tid = fresh_tid(), wave = __builtin_amdgcn_readfirstlane(tid >> 6), lane = tid & 63;
    float* wt = (float*)lds;
    const float bb[4] = {f_bias[0], f_bias[1], f_bias[2], f_bias[3]};
    const bf16* base = PROJ + ((size_t)b * T + 8 * tid) * INP + C_FOX_F;
    u32x2v v[8];
#pragma unroll
    for (int e = 0; e < 8; ++e) v[e] = *(const u32x2v*)(base + (size_t)e * INP);
    float ls[8][4]; float run[4] = {0.f, 0.f, 0.f, 0.f};
#pragma unroll
    for (int e = 0; e < 8; ++e) {
        run[0] += logsigmoidf_(bflo(v[e].x) + bb[0]); run[1] += logsigmoidf_(bfhi(v[e].x) + bb[1]); run[2] += logsigmoidf_(bflo(v[e].y) + bb[2]); run[3] += logsigmoidf_(bfhi(v[e].y) + bb[3]);
        ls[e][0] = run[0]; ls[e][1] = run[1]; ls[e][2] = run[2]; ls[e][3] = run[3];
    }
    float off[4];
#pragma unroll
    for (int h = 0; h < 4; ++h) { const float inc = wave_iscan(run[h], lane); off[h] = inc - run[h]; if (lane == 63) wt[wave * 4 + h] = inc; }
    LDSBAR();
#pragma unroll
    for (int h = 0; h < 4; ++h) { float o = off[h];
        for (int w = 0; w < wave; ++w) o += wt[w * 4 + h];
        float* dst = FCUM + ((size_t)b * 4 + h) * T + 8 * tid;
        *(f32x4*)dst = (f32x4){o + ls[0][h], o + ls[1][h], o + ls[2][h], o + ls[3][h]};
        *(f32x4*)(dst + 4) = (f32x4){o + ls[4][h], o + ls[5][h], o + ls[6][h], o + ls[7][h]}; }
    LDSBAR();
}

template <int DK, bool DELTA>
__device__ __forceinline__ void scan_bh(int bh, const unsigned char* scr_base, size_t item_bytes, const float* dec, const bf16* PROJ, int gcol,
                                        const float* norm_w, bf16* Y, int ycol, unsigned char* lds) {
    const int tid = fresh_tid(), wave = __builtin_amdgcn_readfirstlane(tid >> 6), lane = tid & 63, fr = lane & 15, fq = lane >> 4;
    const int b = bh >> 2;
    constexpr int PQ = DK + 16;
    constexpr int NQ = DK / 64;
    constexpr size_t O_QG = 0, O_W = DELTA ? 16384 : 0, O_K2T = DELTA ? 32768 : 8192, O_UT = DELTA ? 49152 : 16384, O_ATT = DELTA ? 65536 : 32768;
    bf16* QGt = (bf16*)lds;
    bf16* Wt = QGt + 64 * PQ;
    bf16* K2Tt = Wt + 64 * PQ;
    bf16* ATTt = K2Tt + DK * 80;
    bf16* UTt = ATTt + 64 * 80;
    bf16* Gt = UTt + 128 * 80;
    float* DECt = (float*)(Gt + 64 * 136);
    float* PART = DECt + DK;
    float* RINV = PART + 512;
    f32x4 S[DK / 16];
#pragma unroll
    for (int kb = 0; kb < DK / 16; ++kb) S[kb] = (f32x4){0.f, 0.f, 0.f, 0.f};
    u32x4v rq[NQ], rw[NQ], rk[NQ], ra, ru[2]; float rdec = 0.f;
#define SCAN_ISSUE(n_) do { const unsigned char* it_ = scr_base + (size_t)(bh * 64 + (n_)) * item_bytes; \
        _Pragma("unroll") for (int i = 0; i < NQ; ++i) { rq[i] = *(const u32x4v*)(it_ + O_QG + (size_t)(tid + 512 * i) * 16); if (DELTA) rw[i] = *(const u32x4v*)(it_ + O_W + (size_t)(tid + 512 * i) * 16); \
            rk[i] = *(const u32x4v*)(it_ + O_K2T + (size_t)(tid + 512 * i) * 16); } \
        ra = *(const u32x4v*)(it_ + O_ATT + (size_t)tid * 16); \
        ru[0] = *(const u32x4v*)(it_ + O_UT + (size_t)tid * 16); ru[1] = *(const u32x4v*)(it_ + O_UT + (size_t)(tid + 512) * 16); \
        if (tid < DK) rdec = DELTA ? dec[bh * 64 + (n_)] : dec[(size_t)(bh * 64 + (n_)) * 64 + tid]; } while (0)
    SCAN_ISSUE(0);
    for (int n = 0; n < 64; ++n) {
        LDSBAR();
#pragma unroll
        for (int i = 0; i < NQ; ++i) { const int p = tid + 512 * i;
            { const int r = p / (DK / 8), cp = p % (DK / 8); lds_put_perm(QGt + r * PQ, 8 * cp, rq[i]); if (DELTA) lds_put_perm(Wt + r * PQ, 8 * cp, rw[i]); }
            { const int r = p >> 3, cp = p & 7; lds_put_perm(K2Tt + r * 80, 8 * cp, rk[i]); } }
        { const int r = tid >> 3, cp = tid & 7; lds_put_perm(ATTt + r * 80, 8 * cp, ra); }
#pragma unroll
        for (int i = 0; i < 2; ++i) { const int p = tid + 512 * i; const int r = p >> 3, cp = p & 7; *(u32x4v*)(UTt + r * 80 + 8 * cp) = ru[i]; }
        if (tid < DK) DECt[tid] = rdec;
        LDSBAR();
        if (n + 1 < 64) SCAN_ISSUE(n + 1);
        const size_t row0 = (size_t)b * T + n * 64;
        bf16x8 Sf[DK / 32];
#pragma unroll
        for (int ks = 0; ks < DK / 32; ++ks) Sf[ks] = pack8(S[2 * ks], S[2 * ks + 1]);
        f32x4 vn[4], o[4];
        bf16x8 f0[8], f1[8];
        u32x2v uu[4];
#pragma unroll
        for (int mt = 0; mt < 4; ++mt) { uu[mt] = *(const u32x2v*)(UTt + (16 * wave + fr) * 80 + 16 * mt + 4 * fq); o[mt] = (f32x4){0.f, 0.f, 0.f, 0.f}; }
        if (DELTA) {
            f32x4 P[4];
#pragma unroll
            for (int mt = 0; mt < 4; ++mt) P[mt] = (f32x4){0.f, 0.f, 0.f, 0.f};
#pragma unroll
            for (int q = 0; q < 8; ++q) f0[q] = afrag_lin(Wt + (16 * (q & 3) + fr) * PQ, 32 * (q >> 2), fq);
            SB();
#pragma unroll
            for (int q = 0; q < 8; ++q) f1[q] = afrag_lin(Wt + (16 * (q & 3) + fr) * PQ, 32 * (2 + (q >> 2)), fq);
            SB();
#pragma unroll
            for (int q = 0; q < 8; ++q) P[q & 3] = MFMA16(f0[q], Sf[q >> 2], P[q & 3]);
            SB();
#pragma unroll
            for (int q = 0; q < 8; ++q) f0[q] = afrag_lin(QGt + (16 * (q & 3) + fr) * PQ, 32 * (q >> 2), fq);
            SB();
#pragma unroll
            for (int q = 0; q < 8; ++q) P[q & 3] = MFMA16(f1[q], Sf[2 + (q >> 2)], P[q & 3]);
            SB();
#pragma unroll
            for (int q = 0; q < 8; ++q) f1[q] = afrag_lin(QGt + (16 * (q & 3) + fr) * PQ, 32 * (2 + (q >> 2)), fq);
            SB();
#pragma unroll
            for (int q = 0; q < 8; ++q) o[q & 3] = MFMA16(f0[q], Sf[q >> 2], o[q & 3]);
            SB();
#pragma unroll
            for (int q = 0; q < 8; ++q) f0[q] = afrag_lin(ATTt + (16 * (q & 3) + fr) * 80, 32 * (q >> 2), fq);
            SB();
#pragma unroll
            for (int q = 0; q < 8; ++q) o[q & 3] = MFMA16(f1[q], Sf[2 + (q >> 2)], o[q & 3]);
#pragma unroll
            for (int mt = 0; mt < 4; ++mt) vn[mt] = (f32x4){bflo(uu[mt].x), bfhi(uu[mt].x), bflo(uu[mt].y), bfhi(uu[mt].y)} - P[mt];
        } else {
#pragma unroll
            for (int q = 0; q < 8; ++q) f1[q] = afrag_lin(QGt + (16 * (q & 3) + fr) * PQ, 32 * (q >> 2), fq);
            SB();
#pragma unroll
            for (int q = 0; q < 8; ++q) f0[q] = afrag_lin(ATTt + (16 * (q & 3) + fr) * 80, 32 * (q >> 2), fq);
            SB();
#pragma unroll
            for (int q = 0; q < 8; ++q) o[q & 3] = MFMA16(f1[q], Sf[q >> 2], o[q & 3]);
#pragma unroll
            for (int mt = 0; mt < 4; ++mt) vn[mt] = (f32x4){bflo(uu[mt].x), bfhi(uu[mt].x), bflo(uu[mt].y), bfhi(uu[mt].y)};
        }
        bf16x8 Vf[2];
        Vf[0] = pack8(vn[0], vn[1]); Vf[1] = pack8(vn[2], vn[3]);
        SB();
        constexpr int NKB = DK / 16, KG = (NKB * 2) / 8;
#pragma unroll
        for (int q = 0; q < 8; ++q) { const int t = q, kb = t % NKB, k2 = t / NKB; f1[q] = afrag_lin(K2Tt + (16 * kb + fr) * 80, 32 * k2, fq); }
        SB();
#pragma unroll
        for (int q = 0; q < 8; ++q) o[q & 3] = MFMA16(f0[q], Vf[q >> 2], o[q & 3]);
#pragma unroll
        for (int kb = 0; kb < NKB; ++kb) S[kb] = S[kb] * *(const f32x4*)(DECt + 16 * kb + 4 * fq);
        SB();
        if (KG == 2) {
#pragma unroll
            for (int q = 0; q < 8; ++q) { const int t = 8 + q, kb = t % NKB, k2 = t / NKB; f0[q] = afrag_lin(K2Tt + (16 * kb + fr) * 80, 32 * k2, fq); }
            SB();
        }
#pragma unroll
        for (int q = 0; q < 8; ++q) { const int t = q, kb = t % NKB, k2 = t / NKB; S[kb] = MFMA16(f1[q], Vf[k2], S[kb]); }
        if (KG == 2) {
            SB();
#pragma unroll
            for (int q = 0; q < 8; ++q) { const int t = 8 + q, kb = t % NKB, k2 = t / NKB; S[kb] = MFMA16(f0[q], Vf[k2], S[kb]); }
        }
#pragma unroll
        for (int mt = 0; mt < 4; ++mt)
#pragma unroll
            for (int j = 0; j < 4; ++j) Y[(row0 + 16 * mt + 4 * fq + j) * D + ycol + 16 * wave + fr] = bf1(o[mt][j]);
    }
#undef SCAN_ISSUE
    __syncthreads();
}

__device__ __forceinline__ void phase_mixnorm(const bf16* PROJ, const float* gla_norm, const float* gdn_norm, bf16* Y) {
    const int tid_ = fresh_tid(), wave = __builtin_amdgcn_readfirstlane(tid_ >> 6), lane = tid_ & 63;
    const int gw = fresh_bid() * 8 + wave, NGW = gridDim.x * 8;
    const int hh = lane >> 3, c16 = (lane & 7) * 16;
    const float* nw = (hh < 4 ? gla_norm : gdn_norm) + c16;
    float nwv[16];
#pragma unroll
    for (int e = 0; e < 16; e += 4) *(f32x4*)(nwv + e) = *(const f32x4*)(nw + e);
    const int gcol = (hh < 4 ? C_GLA_G : C_GDN_G) + (hh & 3) * 128 + c16;
#define MIX_LOAD(m_, Y0, Y1, G0, G1) do { const bf16* yp_ = Y + (size_t)(m_) * D + 16 * lane; const bf16* gp_ = PROJ + (size_t)(m_) * INP + gcol; \
        Y0 = *(const u32x4v*)yp_; Y1 = *(const u32x4v*)(yp_ + 8); G0 = *(const u32x4v*)gp_; G1 = *(const u32x4v*)(gp_ + 8); } while (0)
#define MIX_DO(m_, y0, y1, g0, g1) do { \
        float o[16], g[16]; \
        o[0] = bflo(y0.x); o[1] = bfhi(y0.x); o[2] = bflo(y0.y); o[3] = bfhi(y0.y); o[4] = bflo(y0.z); o[5] = bfhi(y0.z); o[6] = bflo(y0.w); o[7] = bfhi(y0.w); \
        o[8] = bflo(y1.x); o[9] = bfhi(y1.x); o[10] = bflo(y1.y); o[11] = bfhi(y1.y); o[12] = bflo(y1.z); o[13] = bfhi(y1.z); o[14] = bflo(y1.w); o[15] = bfhi(y1.w); \
        g[0] = bflo(g0.x); g[1] = bfhi(g0.x); g[2] = bflo(g0.y); g[3] = bfhi(g0.y); g[4] = bflo(g0.z); g[5] = bfhi(g0.z); g[6] = bflo(g0.w); g[7] = bfhi(g0.w); \
        g[8] = bflo(g1.x); g[9] = bfhi(g1.x); g[10] = bflo(g1.y); g[11] = bfhi(g1.y); g[12] = bflo(g1.z); g[13] = bfhi(g1.z); g[14] = bflo(g1.w); g[15] = bfhi(g1.w); \
        float ss = 0.f; \
        _Pragma("unroll") for (int e = 0; e < 16; ++e) ss += o[e] * o[e]; \
        ss += DPPF(ss, 0xB1, 0xf, false); ss += DPPF(ss, 0x4E, 0xf, false); ss += DPPF(ss, 0x141, 0xf, false);     \
        const float rinv = rsqrtf(ss * (1.f / 128.f) + EPS); \
        float y[16]; \
        _Pragma("unroll") for (int e = 0; e < 16; ++e) y[e] = o[e] * rinv * nwv[e] * siluf_(g[e]); \
        bf16* yp = Y + (size_t)(m_) * D + 16 * lane; \
        u32x4v w; w.x = pk2(y[0], y[1]); w.y = pk2(y[2], y[3]); w.z = pk2(y[4], y[5]); w.w = pk2(y[6], y[7]); \
        *(u32x4v*)yp = w; \
        w.x = pk2(y[8], y[9]); w.y = pk2(y[10], y[11]); w.z = pk2(y[12], y[13]); w.w = pk2(y[14], y[15]); \
        *(u32x4v*)(yp + 8) = w; } while (0)
    if (gw >= M) return;
    u32x4v ay0, ay1, ag0, ag1, by0, by1, bg0, bg1;
    MIX_LOAD(gw, ay0, ay1, ag0, ag1);
    for (int m = gw; m < M; m += 2 * NGW) {
        const bool hb = m + NGW < M, ha = m + 2 * NGW < M;
        if (hb) MIX_LOAD(m + NGW, by0, by1, bg0, bg1);
        MIX_DO(m, ay0, ay1, ag0, ag1);
        if (ha) MIX_LOAD(m + 2 * NGW, ay0, ay1, ag0, ag1);
        if (hb) MIX_DO(m + NGW, by0, by1, bg0, bg1);
    }
#undef MIX_LOAD
#undef MIX_DO
}

__device__ __forceinline__ void fox_item(int idx, const bf16* PROJ, const bf16* VT, const float* FCUM, bf16* Y, unsigned char* lds) {
    const int tid = fresh_tid(), wave = __builtin_amdgcn_readfirstlane(tid >> 6), lane = tid & 63, fr = lane & 15, fq = lane >> 4;
    const int qb = 31 - (idx >> 4), bh = idx & 15, b = bh >> 2, h = bh & 3, q0 = qb * 128;
    constexpr int FOXBUF = 64 * 144 * 2 + 128 * 80 * 2 + 256;
    const int qrow = q0 + 16 * wave + fr;
    bf16x8 Qf[4];
    {
        const bf16* qp = PROJ + ((size_t)b * T + qrow) * INP + C_FOX_Q + h * 128 + 8 * fq;
        const float sc = 0.08838834764831845f * LOG2E;
#pragma unroll
        for (int ks = 0; ks < 4; ++ks) { const u32x4v v = *(const u32x4v*)(qp + 32 * ks); u32x4v w;
            w.x = pk2(bflo(v.x) * sc, bfhi(v.x) * sc); w.y = pk2(bflo(v.y) * sc, bfhi(v.y) * sc); w.z = pk2(bflo(v.z) * sc, bfhi(v.z) * sc); w.w = pk2(bflo(v.w) * sc, bfhi(v.w) * sc);
            Qf[ks] = __builtin_bit_cast(bf16x8, w); }
    }
    const float* Fb = FCUM + (size_t)bh * T;
    const float Fref = Fb[q0];
    const int ntile = (q0 + 128) / 64;
    f32x4 O[8];
#pragma unroll
    for (int dt = 0; dt < 8; ++dt) O[dt] = (f32x4){0.f, 0.f, 0.f, 0.f};
    float mrun = -INFINITY, lsum = 0.f;
    u32x4v rkA[2], rvA[2], rkB[2], rvB[2]; float rfA = 0.f, rfB = 0.f;
#define FOX_ISSUE(kt_, rk, rv, rf) do { const int k0_ = (kt_) * 64; \
        _Pragma("unroll") for (int i = 0; i < 2; ++i) { const int p_ = tid + 512 * i; \
            rk[i] = *(const u32x4v*)(PROJ + ((size_t)b * T + k0_ + (p_ >> 4)) * INP + C_FOX_K + h * 128 + 8 * (p_ & 15)); \
            rv[i] = *(const u32x4v*)(VT + ((size_t)bh * 128 + (p_ >> 3)) * T + k0_ + 8 * (p_ & 7)); } \
        if (tid < 64) rf = (Fref - Fb[k0_ + tid]) * LOG2E; } while (0)
#define FOX_PUT(buf_, rk, rv, rf) do { bf16* Kw_ = (bf16*)(lds + (buf_) * FOXBUF); bf16* Vw_ = Kw_ + 64 * 144; float* Fw_ = (float*)(Vw_ + 128 * 80); \
        _Pragma("unroll") for (int i = 0; i < 2; ++i) { const int p_ = tid + 512 * i; \
            *(u32x4v*)(Kw_ + (p_ >> 4) * 144 + 8 * (p_ & 15)) = rk[i]; lds_put_perm(Vw_ + (p_ >> 3) * 80, 8 * (p_ & 7), rv[i]); } \
        if (tid < 64) Fw_[tid] = rf; } while (0)
#define FOX_STEP(kt_, rk, rv, rf) do { \
        if ((kt_) + 1 < ntile) FOX_PUT(((kt_) + 1) & 1, rk, rv, rf); \
        if ((kt_) + 3 < ntile) FOX_ISSUE((kt_) + 3, rk, rv, rf); \
        const bf16* Kt = (const bf16*)(lds + ((kt_) & 1) * FOXBUF); const bf16* VTt = Kt + 64 * 144; const float* Ft = (const float*)(VTt + 128 * 80); \
        const int k0 = (kt_) * 64; \
        if (k0 <= q0 + 16 * wave + 15) { \
            f32x4 s[4]; bf16x8 fa[8], fb[8]; \
            _Pragma("unroll") for (int q = 0; q < 8; ++q) fa[q] = *(const bf16x8*)(Kt + (16 * (q & 3) + fr) * 144 + 32 * (q >> 2) + 8 * fq); \
            SB(); \
            _Pragma("unroll") for (int q = 0; q < 8; ++q) fb[q] = *(const bf16x8*)(Kt + (16 * (q & 3) + fr) * 144 + 32 * (2 + (q >> 2)) + 8 * fq); \
            _Pragma("unroll") for (int t4 = 0; t4 < 4; ++t4) s[t4] = *(const f32x4*)(Ft + 16 * t4 + 4 * fq); \
            SB(); \
            _Pragma("unroll") for (int q = 0; q < 8; ++q) s[q & 3] = MFMA16(fa[q], Qf[q >> 2], s[q & 3]); \
            SB(); \
            _Pragma("unroll") for (int q = 0; q < 8; ++q) fa[q] = afrag_lin(VTt + (16 * q + fr) * 80, 0, fq); \
            SB(); \
            _Pragma("unroll") for (int q = 0; q < 8; ++q) s[q & 3] = MFMA16(fb[q], Qf[2 + (q >> 2)], s[q & 3]); \
            SB(); \
            _Pragma("unroll") for (int q = 0; q < 8; ++q) fb[q] = afrag_lin(VTt + (16 * q + fr) * 80, 32, fq); \
            SB(); \
            if (k0 + 63 > q0 + 16 * wave) { \
                _Pragma("unroll") for (int t4 = 0; t4 < 4; ++t4) \
                    _Pragma("unroll") for (int j = 0; j < 4; ++j) if (k0 + 16 * t4 + 4 * fq + j > qrow) s[t4][j] = -INFINITY; \
            } \
            float mx = -INFINITY; \
            _Pragma("unroll") for (int t4 = 0; t4 < 4; ++t4) mx = fmaxf(fmaxf(mx, fmaxf(s[t4][0], s[t4][1])), fmaxf(s[t4][2], s[t4][3])); \
            mx = fmaxf(mx, __shfl_xor(mx, 16)); mx = fmaxf(mx, __shfl_xor(mx, 32)); \
            const float mnew = fmaxf(mrun, mx); \
            const float alpha = __builtin_amdgcn_exp2f(mrun - mnew); \
            mrun = mnew; \
            float ps = 0.f; \
            _Pragma("unroll") for (int t4 = 0; t4 < 4; ++t4) \
                _Pragma("unroll") for (int j = 0; j < 4; ++j) { const float p = __builtin_amdgcn_exp2f(s[t4][j] - mnew); s[t4][j] = p; ps += p; } \
            lsum = lsum * alpha + ps; \
            bf16x8 Pf[2]; \
            Pf[0] = pack8(s[0], s[1]); Pf[1] = pack8(s[2], s[3]); \
            _Pragma("unroll") for (int dt = 0; dt < 8; ++dt) O[dt] = O[dt] * alpha; \
            _Pragma("unroll") for (int dt = 0; dt < 8; ++dt) O[dt] = MFMA16(fa[dt], Pf[0], O[dt]); \
            _Pragma("unroll") for (int dt = 0; dt < 8; ++dt) O[dt] = MFMA16(fb[dt], Pf[1], O[dt]); \
        } \
        LDSBAR(); } while (0)
    FOX_ISSUE(0, rkA, rvA, rfA);
    FOX_ISSUE(1, rkB, rvB, rfB);
    FOX_PUT(0, rkA, rvA, rfA);
    if (2 < ntile) FOX_ISSUE(2, rkA, rvA, rfA);
    LDSBAR();
    for (int kt = 0; kt < ntile; kt += 2) {
        FOX_STEP(kt, rkB, rvB, rfB);
        FOX_STEP(kt + 1, rkA, rvA, rfA);
    }
#undef FOX_ISSUE
#undef FOX_STEP
#undef FOX_PUT
    lsum += __shfl_xor(lsum, 16); lsum += __shfl_xor(lsum, 32);
    const float inv = 1.f / lsum;
    bf16* yp = Y + ((size_t)b * T + qrow) * D + 1536 + h * 128 + 4 * fq;
#pragma unroll
    for (int dt = 0; dt < 8; ++dt) { const f32x4 o = O[dt] * inv; u32x2v w; w.x = pk2(o.x, o.y); w.y = pk2(o.z, o.w); *(u32x2v*)(yp + 16 * dt) = w; }
    __syncthreads();
}

__device__ __forceinline__ void phase_act(const bf16* GU, const float* cw, const float* cb, bf16* ACT) {
    const size_t gt = (size_t)fresh_bid() * 512 + fresh_tid(), GT = (size_t)gridDim.x * 512;
    constexpr int NCG = DFF / 8, RUN = 32;
    for (size_t idx = gt; idx < (size_t)NCG * (M / RUN); idx += GT) {
        const int cgp = (int)(idx % NCG), run = (int)(idx / NCG), r0 = run * RUN, c0 = cgp * 8;
        float w0[8], w1[8], w2[8], bb[8];
#pragma unroll
        for (int e = 0; e < 8; e += 4) { *(f32x4*)(w0 + e) = *(const f32x4*)(cw + c0 + e); *(f32x4*)(w1 + e) = *(const f32x4*)(cw + DFF + c0 + e);
            *(f32x4*)(w2 + e) = *(const f32x4*)(cw + 2 * DFF + c0 + e); *(f32x4*)(bb + e) = *(const f32x4*)(cb + c0 + e); }
        u32x4v g2 = {0u, 0u, 0u, 0u}, g1 = g2;
        if ((r0 % T) != 0) { g2 = *(const u32x4v*)(GU + (size_t)(r0 - 2) * (2 * DFF) + c0); g1 = *(const u32x4v*)(GU + (size_t)(r0 - 1) * (2 * DFF) + c0); }
#pragma unroll 4
        for (int r = r0; r < r0 + RUN; ++r) {
            const u32x4v g = *(const u32x4v*)(GU + (size_t)r * (2 * DFF) + c0), u = *(const u32x4v*)(GU + (size_t)r * (2 * DFF) + DFF + c0);
            u32x4v o;
#define ACT2(k, fld) { const float a0 = w0[2 * k] * bflo(g2.fld) + w1[2 * k] * bflo(g1.fld) + w2[2 * k] * bflo(g.fld) + bb[2 * k]; \
                       const float a1 = w0[2 * k + 1] * bfhi(g2.fld) + w1[2 * k + 1] * bfhi(g1.fld) + w2[2 * k + 1] * bfhi(g.fld) + bb[2 * k + 1]; \
                       o.fld = pk2(siluf_(a0) * bflo(u.fld), siluf_(a1) * bfhi(u.fld)); }
            ACT2(0, x) ACT2(1, y) ACT2(2, z) ACT2(3, w)
#undef ACT2
            *(u32x4v*)(ACT + (size_t)r * DFF + c0) = o;
            g2 = g1; g1 = g;
        }
    }
}

__device__ __forceinline__ void phase_actfix(const float* GLAST, const float* GFIRST, const float* UFIRST, const float* cw, const float* cb, bf16* ACTp) {
    const int gt = fresh_bid() * 512 + fresh_tid(), GT = gridDim.x * 512;
    constexpr int NCG = DFF / 8;
    for (int idx = gt; idx < NCG * 2 * (M / 256); idx += GT) {
        const int cgp = idx % NCG, ri = idx / NCG, i = ri & 1, pm = ri >> 1, c0 = cgp * 8;
        const bool first = (pm % (T / 256)) == 0;
        float g[8], u[8], g1[8], g2[8];
#pragma unroll
        for (int e = 0; e < 8; e += 4) {
            *(f32x4*)(g + e) = *(const f32x4*)(GFIRST + (size_t)(pm * 2 + i) * DFF + c0 + e);
            *(f32x4*)(u + e) = *(const f32x4*)(UFIRST + (size_t)(pm * 2 + i) * DFF + c0 + e);
            const f32x4 z = {0.f, 0.f, 0.f, 0.f};
            const f32x4 l1 = first ? z : *(const f32x4*)(GLAST + (size_t)((pm - 1) * 2 + 1) * DFF + c0 + e);
            const f32x4 l0 = first ? z : *(const f32x4*)(GLAST + (size_t)((pm - 1) * 2 + 0) * DFF + c0 + e);
            const f32x4 f0 = *(const f32x4*)(GFIRST + (size_t)(pm * 2 + 0) * DFF + c0 + e);
            *(f32x4*)(g1 + e) = (i == 1) ? f0 : l1;
            *(f32x4*)(g2 + e) = (i == 1) ? l1 : l0;
        }
        float o[8];
#pragma unroll
        for (int e = 0; e < 8; ++e) { const float a = cw[c0 + e] * g2[e] + cw[DFF + c0 + e] * g1[e] + cw[2 * DFF + c0 + e] * g[e] + cb[c0 + e]; o[e] = siluf_(a) * u[e]; }
        u32x4v w; w.x = pk2(o[0], o[1]); w.y = pk2(o[2], o[3]); w.z = pk2(o[4], o[5]); w.w = pk2(o[6], o[7]);
        *(u32x4v*)(ACTp + (size_t)(pm * 256 + i) * DFF + c0) = w;
    }
}

#ifndef GEMM_ALIGN
#define GEMM_ALIGN true
#endif
#ifndef GEMM_SP2
#define GEMM_SP2 true
#endif
#ifndef WGM_IN
#define WGM_IN 4
#endif
#ifndef WGM_OUT
#define WGM_OUT 4
#endif
#ifndef WGM_GU
#define WGM_GU 4
#endif
#ifndef WGM_DN
#define WGM_DN 4
#endif
#ifndef CREP
#define CREP 1
#endif
#ifndef CLO
#define CLO 0
#define CHI 0
#endif
#ifndef SREP
#define SREP 1
#endif
#ifndef FREP
#define FREP 1
#endif
struct Args { const float* in[24]; float* out; unsigned char* ws; };
enum { I_X = 0, I_C, I_WMOD, I_BMOD, I_NMIX, I_NFFN, I_WIN, I_GLAWLR, I_GLABLR, I_GLANORM, I_GDNCONV, I_GDNALOG, I_GDNDT, I_GDNNORM,
       I_POOLW, I_POOLSC, I_FOXB, I_WOUT, I_WGATE, I_WUP, I_FCW, I_FCB, I_WDOWN, I_NFINAL };

typedef const Args __attribute__((address_space(4)))* KArgsP;
__device__ __forceinline__ KArgsP fresh_args() { KArgsP p = (KArgsP)__builtin_amdgcn_kernarg_segment_ptr(); asm volatile("" : "+s"(p)); return p; }
#define KA fresh_args()
#define ws (KA->ws)
#define MOD ((float*)(ws + WS_MOD))
#define FCUM ((float*)(ws + WS_FCUM))
#define GLADEC ((float*)(ws + WS_GLADEC))
#define GDNDEC ((float*)(ws + WS_GDNDEC))
#define PWT ((bf16*)(ws + WS_PWT))
#define H ((bf16*)(ws + WS_H))
#define ACT ((bf16*)(ws + WS_ACT))
#define PROJ ((bf16*)(ws + WS_PROJ))
#define Y ((bf16*)(ws + WS_Y))
#define GU ((bf16*)(ws + WS_GU))
#define VT ((bf16*)(ws + WS_VT))
__global__ void __launch_bounds__(512, 2) mk_fwd(Args a) {
    extern __shared__ __attribute__((aligned(16))) unsigned char lds[];
#ifdef TEST_NOSYNC
    struct { __device__ void sync() const { __syncthreads(); } } grid;
#else
    cg::grid_group grid = cg::this_grid();
#endif
    const int G = gridDim.x;
#define bx fresh_bid()
    {
        volatile LAS unsigned* bst = (volatile LAS unsigned*)((LAS unsigned char*)lds + (LDS_BYTES - 64));
        if (threadIdx.x < 2) bst[threadIdx.x] = 0u;
        __syncthreads();
        (void)xcd_barrier_post((unsigned*)ws, bst);
    }
#define GSYNC() do { XcdBarrier b_; b_.bar = (unsigned*)ws; b_.x = xb_xcc_id(); b_.st = (volatile LAS unsigned*)((LAS unsigned char*)lds + (LDS_BYTES - 64)); xcd_barrier(b_); } while (0)
    PG8_LAS unsigned char* gl = (PG8_LAS unsigned char*)lds;

#ifndef NO_MOD
    phase_mod(KA->in[I_C], KA->in[I_WMOD], KA->in[I_BMOD], MOD, lds);
#endif
    if (KA->out == nullptr) grid.sync();
    GSYNC();
#ifdef TEST_NOLOOP
    for (int l = 0; l < 1; ++l) {
#else
#pragma unroll
    for (int l = 0; l < NL; ++l) {
#endif
        const float* modl = MOD + (size_t)l * NB * MODW;
        const float* xin = (l == 0) ? KA->in[I_X] : KA->out;
        {
            LayerW L{KA->in[I_WIN] + (size_t)l * D * INW, KA->in[I_WOUT] + (size_t)l * D * D, KA->in[I_WGATE] + (size_t)l * D * DFF, KA->in[I_WUP] + (size_t)l * D * DFF,
                     KA->in[I_WDOWN] + (size_t)l * DFF * D, KA->in[I_POOLW] + (size_t)l * 4 * 128 * 128};
#ifndef NO_TR
            phase_transpose(L, ws, lds, 0, 0, G);
#endif
            phase_norm(xin, KA->in[I_NMIX] + (size_t)l * D, modl, 0, 1, H);
        }
        GSYNC();
#ifdef DUP_A
        {
            LayerW L{KA->in[I_WIN] + (size_t)l * D * INW, KA->in[I_WOUT] + (size_t)l * D * D, KA->in[I_WGATE] + (size_t)l * D * DFF, KA->in[I_WUP] + (size_t)l * D * DFF,
                     KA->in[I_WDOWN] + (size_t)l * DFF * D, KA->in[I_POOLW] + (size_t)l * 4 * 128 * 128};
#ifndef NO_TR
            phase_transpose(L, ws, lds, 0, 0, G);
#endif
            phase_norm(xin, KA->in[I_NMIX] + (size_t)l * D, modl, 0, 1, H);
        }
        GSYNC();
#endif
        {
            pg8::Gemm g{H, (const bf16*)(ws + WS_WIN), M, INP, D}; pg8::StaticOrder S; S.init(M, INP, G, bx, WGM_IN);
            pg8::EpiStoreBf16 E{PROJ, INP};
#ifndef NO_GEMM0
            pg8::gemm_phase<pg8::EpiStoreBf16, pg8::StaticOrder, GEMM_ALIGN, GEMM_SP2>(gl, g, S, E);
#endif
        }
        GSYNC();
#ifdef DUP_B
        {
            pg8::Gemm g{H, (const bf16*)(ws + WS_WIN), M, INP, D}; pg8::StaticOrder S; S.init(M, INP, G, bx, WGM_IN);
            pg8::EpiStoreBf16 E{PROJ, INP};
#ifndef NO_GEMM0
            pg8::gemm_phase<pg8::EpiStoreBf16, pg8::StaticOrder, GEMM_ALIGN, GEMM_SP2>(gl, g, S, E);
#endif
        }
        GSYNC();
#endif
        {
            const float* conv_w = KA->in[I_GDNCONV] + (size_t)l * 4 * 1536;
            for (int rep_ = 0; rep_ < CREP; ++rep_)
            for (int it = bx; it < 4100; it += G) {
                if (rep_ > 0 && !(it >= CLO && it < CHI)) continue;
#ifndef NO_GDNP
                if (it < 1024) gdn_prep_item(it, PROJ, conv_w, KA->in[I_GDNALOG] + l * 4, KA->in[I_GDNDT] + l * 4, ws + WS_GDN, GDNDEC, lds);
                else
#endif
#ifndef NO_GLAP
                if (it < 2048) gla_prep_item(it - 1024, PROJ, KA->in[I_GLAWLR] + (size_t)l * 16 * 256, KA->in[I_GLABLR] + (size_t)l * 256, ws + WS_GLA, GLADEC, lds);
                else
#endif
#ifndef NO_POOL
                if (it < 3072) pool_item(it - 2048, PROJ, PWT, KA->in[I_POOLSC] + (size_t)l * 512, Y, lds);
                else
#endif
                if (it < 4096) vt_item(it - 3072, PROJ, VT, lds);
                else fcum_item(it - 4096, PROJ, KA->in[I_FOXB] + l * 4, FCUM, lds);
            }
        }
        GSYNC();
#ifdef DUP_C
        {
            const float* conv_w = KA->in[I_GDNCONV] + (size_t)l * 4 * 1536;
            for (int rep_ = 0; rep_ < CREP; ++rep_)
            for (int it = bx; it < 4100; it += G) {
                if (rep_ > 0 && !(it >= CLO && it < CHI)) continue;
#ifndef NO_GDNP
                if (it < 1024) gdn_prep_item(it, PROJ, conv_w, KA->in[I_GDNALOG] + l * 4, KA->in[I_GDNDT] + l * 4, ws + WS_GDN, GDNDEC, lds);
                else
#endif
#ifndef NO_GLAP
                if (it < 2048) gla_prep_item(it - 1024, PROJ, KA->in[I_GLAWLR] + (size_t)l * 16 * 256, KA->in[I_GLABLR] + (size_t)l * 256, ws + WS_GLA, GLADEC, lds);
                else
#endif
#ifndef NO_POOL
                if (it < 3072) pool_item(it - 2048, PROJ, PWT, KA->in[I_POOLSC] + (size_t)l * 512, Y, lds);
                else
#endif
                if (it < 4096) vt_item(it - 3072, PROJ, VT, lds);
                else fcum_item(it - 4096, PROJ, KA->in[I_FOXB] + l * 4, FCUM, lds);
            }
        }
        GSYNC();
#endif
        {
            for (int rep_ = 0; rep_ < SREP; ++rep_)
            for (int s = bx; s < 32; s += G) {
#ifndef NO_SCAN
                if (s < 16) scan_bh<128, true>(s, ws + WS_GDN, GDN_ITEM, GDNDEC, PROJ, C_GDN_G + (s & 3) * 128, KA->in[I_GDNNORM] + (size_t)l * 128, Y, 512 + (s & 3) * 128, lds);
                else scan_bh<64, false>(s - 16, ws + WS_GLA, GLA_ITEM, GLADEC, PROJ, C_GLA_G + (s & 3) * 128, KA->in[I_GLANORM] + (size_t)l * 128, Y, (s & 3) * 128, lds);
#endif
            }
            const int NA = (G > 32) ? G - 32 : G, ab = (G > 32) ? bx - 32 : bx;
            for (int rep_ = 0; rep_ < FREP; ++rep_)
            if (ab >= 0) for (int r = 0;; ++r) { const int idx = r * NA + ((r & 1) ? NA - 1 - ab : ab); if (r * NA >= 512) break;
#ifndef NO_FOX
 if (idx < 512) fox_item(idx, PROJ, VT, FCUM, Y, lds);
#endif
 }
            {
                LayerW L{KA->in[I_WIN] + (size_t)l * D * INW, KA->in[I_WOUT] + (size_t)l * D * D, KA->in[I_WGATE] + (size_t)l * D * DFF, KA->in[I_WUP] + (size_t)l * D * DFF,
                         KA->in[I_WDOWN] + (size_t)l * DFF * D, KA->in[I_POOLW] + (size_t)l * 4 * 128 * 128};
                if (G > 32) phase_transpose(L, ws, lds, 1, 32, G - 32); else phase_transpose(L, ws, lds, 1, 0, G);
            }
        }
        GSYNC();
#ifdef DUP_D
        {
            for (int rep_ = 0; rep_ < SREP; ++rep_)
            for (int s = bx; s < 32; s += G) {
#ifndef NO_SCAN
                if (s < 16) scan_bh<128, true>(s, ws + WS_GDN, GDN_ITEM, GDNDEC, PROJ, C_GDN_G + (s & 3) * 128, KA->in[I_GDNNORM] + (size_t)l * 128, Y, 512 + (s & 3) * 128, lds);
                else scan_bh<64, false>(s - 16, ws + WS_GLA, GLA_ITEM, GLADEC, PROJ, C_GLA_G + (s & 3) * 128, KA->in[I_GLANORM] + (size_t)l * 128, Y, (s & 3) * 128, lds);
#endif
            }
            const int NA = (G > 32) ? G - 32 : G, ab = (G > 32) ? bx - 32 : bx;
            for (int rep_ = 0; rep_ < FREP; ++rep_)
            if (ab >= 0) for (int r = 0;; ++r) { const int idx = r * NA + ((r & 1) ? NA - 1 - ab : ab); if (r * NA >= 512) break;
#ifndef NO_FOX
 if (idx < 512) fox_item(idx, PROJ, VT, FCUM, Y, lds);
#endif
 }
            {
                LayerW L{KA->in[I_WIN] + (size_t)l * D * INW, KA->in[I_WOUT] + (size_t)l * D * D, KA->in[I_WGATE] + (size_t)l * D * DFF, KA->in[I_WUP] + (size_t)l * D * DFF,
                         KA->in[I_WDOWN] + (size_t)l * DFF * D, KA->in[I_POOLW] + (size_t)l * 4 * 128 * 128};
                if (G > 32) phase_transpose(L, ws, lds, 1, 32, G - 32); else phase_transpose(L, ws, lds, 1, 0, G);
            }
        }
        GSYNC();
#endif
        phase_mixnorm(PROJ, KA->in[I_GLANORM] + (size_t)l * 128, KA->in[I_GDNNORM] + (size_t)l * 128, Y);
        GSYNC();
        {
            pg8::Gemm g{Y, (const bf16*)(ws + WS_WOUT), M, D, D}; pg8::StaticOrder S; S.init(M, D, G, bx, WGM_OUT);
            pg8::EpiResid E{xin, KA->out, modl + 2 * D, D, MODW, T};
#ifndef NO_GEMM1
            pg8::gemm_phase<pg8::EpiResid, pg8::StaticOrder, GEMM_ALIGN, GEMM_SP2>(gl, g, S, E);
#endif
        }
        GSYNC();
#ifdef DUP_E
        if (l == 0) {
        {
            pg8::Gemm g{Y, (const bf16*)(ws + WS_WOUT), M, D, D}; pg8::StaticOrder S; S.init(M, D, G, bx, WGM_OUT);
            pg8::EpiResid E{xin, KA->out, modl + 2 * D, D, MODW, T};
#ifndef NO_GEMM1
            pg8::gemm_phase<pg8::EpiResid, pg8::StaticOrder, GEMM_ALIGN, GEMM_SP2>(gl, g, S, E);
#endif
        }
        GSYNC();
        }
#endif
        phase_norm(KA->out, KA->in[I_NFFN] + (size_t)l * D, modl, 3, 4, H);
        GSYNC();
#ifdef DUP_F
        phase_norm(KA->out, KA->in[I_NFFN] + (size_t)l * D, modl, 3, 4, H);
        GSYNC();
#endif
        {
            pg8::Gemm g{H, (const bf16*)(ws + WS_WGU), M, 2 * DFF, D}; pg8::StaticOrder S; S.init(M, 2 * DFF, G, bx, WGM_GU);
            pg8::EpiGateUp E{ACT, KA->in[I_FCW] + (size_t)l * 3 * DFF, KA->in[I_FCB] + (size_t)l * DFF, (float*)(ws + WS_SIDE), (float*)(ws + WS_SIDE) + (size_t)128 * DFF, (float*)(ws + WS_SIDE) + (size_t)256 * DFF,
                              (PG8_LAS float*)(gl + 131072), DFF};
            pg8::gemm_phase<pg8::EpiGateUp, pg8::StaticOrder, GEMM_ALIGN, GEMM_SP2>(gl, g, S, E);
        }
        GSYNC();
        phase_actfix((const float*)(ws + WS_SIDE), (const float*)(ws + WS_SIDE) + (size_t)128 * DFF, (const float*)(ws + WS_SIDE) + (size_t)256 * DFF,
                     KA->in[I_FCW] + (size_t)l * 3 * DFF, KA->in[I_FCB] + (size_t)l * DFF, ACT);
        GSYNC();
        {
            pg8::Gemm g{ACT, (const bf16*)(ws + WS_WDN), M, D, DFF}; pg8::StaticOrder S; S.init(M, D, G, bx, WGM_DN);
            pg8::EpiResid E{KA->out, KA->out, modl + 5 * D, D, MODW, T};
#ifndef NO_GEMM3
            pg8::gemm_phase<pg8::EpiResid, pg8::StaticOrder, GEMM_ALIGN, GEMM_SP2>(gl, g, S, E);
#endif
        }
        GSYNC();
    }
#ifdef XSYNC
    for (int i_ = 0; i_ < XSYNC; ++i_) GSYNC();
#endif
    phase_final_norm(KA->out, KA->in[I_NFINAL]);
}

#undef KA
#undef ws
#undef MOD
#undef FCUM
#undef GLADEC
#undef GDNDEC
#undef PWT
#undef H
#undef ACT
#undef PROJ
#undef Y
#undef GU
#undef VT
#undef bx
extern "C" void kernel_launch(void* const* d_in, const int* in_sizes, int n_in, void* d_out, int out_size, void* d_ws, size_t ws_size, hipStream_t stream) {
    static int grid = 0;
    if (grid == 0) {
        int dev = 0, cus = 0, per_cu = 0;
        (void)hipGetDevice(&dev);
        (void)hipDeviceGetAttribute(&cus, hipDeviceAttributeMultiprocessorCount, dev);
        (void)hipFuncSetAttribute((const void*)mk_fwd, hipFuncAttributeMaxDynamicSharedMemorySize, LDS_BYTES);
        (void)hipOccupancyMaxActiveBlocksPerMultiprocessor(&per_cu, (const void*)mk_fwd, 512, LDS_BYTES);
        if (per_cu < 1) fprintf(stderr, "kernel_launch: occupancy query reports %d blocks per CU\n", per_cu);
        if (n_in != 24 || out_size != M * D || ws_size < WS_END) { fprintf(stderr, "kernel_launch: unexpected shapes (n_in %d out %d ws %zu)\n", n_in, out_size, ws_size); grid = -1; return; }
        grid = cus > 0 ? cus : 256;
    }
    if (grid < 0) return;
    if (hipMemsetAsync(d_ws, 0, 65536, stream) != hipSuccess) { fprintf(stderr, "kernel_launch: memset of the barrier words failed\n"); return; }
    Args a{};
    for (int i = 0; i < 24; ++i) a.in[i] = (const float*)d_in[i];
    a.out = (float*)d_out; a.ws = (unsigned char*)d_ws;
    void* args[] = {&a};
    hipError_t e = hipLaunchCooperativeKernel((const void*)mk_fwd, dim3(grid), dim3(512), args, LDS_BYTES, stream);
    if (e != hipSuccess) fprintf(stderr, "kernel_launch: cooperative launch failed: %s (grid %d)\n", hipGetErrorString(e), grid);
}
```

```cpp
#include <hip/hip_runtime.h>
#include <hip/hip_cooperative_groups.h>
#include <cstdio>
#include <cstdint>
namespace cg = cooperative_groups;
#ifndef PG8_WGM
#define PG8_WGM 8
#endif
__device__ __forceinline__ int fresh_tid() { int t = threadIdx.x; asm volatile("" : "+v"(t)); return t; }
__device__ __forceinline__ int fresh_bid() { int t = blockIdx.x; asm volatile("" : "+s"(t)); return t; }
namespace pg8 {
#define PG8_LAS __attribute__((address_space(3)))
typedef unsigned short bf16_t;
typedef short bf16x8 __attribute__((ext_vector_type(8)));
typedef float f32x4 __attribute__((ext_vector_type(4)));
typedef unsigned u32x4 __attribute__((ext_vector_type(4)));
constexpr int BM = 256, BK = 64, HALF = 128, HTB = HALF * BK * 2  , STAGE_BYTES = 8 * HTB, NXCD = 8, WGM = PG8_WGM;

__host__ __device__ __forceinline__ int lds_byte(int r, int c) { const int st = (r >> 4) * 2 + (c >> 5), rr = r & 15, cc = c & 31, ob = rr * 64 + cc * 2; return st * 1024 + (ob ^ (((ob >> 9) & 1) << 5)); }
__host__ __device__ __forceinline__ void stage_rc(int b, int& R, int& C) { const int st = b / 1024, sb = b % 1024, swz = sb ^ (((sb >> 9) & 1) << 5); R = (st >> 1) * 16 + swz / 64; C = (st & 1) * 32 + (swz % 64) / 2; }
__host__ __device__ __forceinline__ int perm32(int rho) { const int n = rho >> 4, i = rho & 15; return 8 * (i >> 2) + 4 * n + (i & 3); }

struct Unit { int pm, pn; };
struct Gemm { const bf16_t* A; const bf16_t* Bt; int M, N, K; };

struct StaticOrder {
    int nM, nN, nwg, G, c, wgm;
    __host__ __device__ void init(int M, int N, int G_, int c_, int wgm_ = WGM) { nM = M / BM; nN = N / BM; nwg = nM * nN; G = G_; c = c_; wgm = wgm_; }
    __host__ __device__ bool next(int i, Unit& u) const {
        const long L = (long)i * G + c; if (L >= nwg) return false;
        int wgid = (int)L; { const int q = nwg / NXCD, r = nwg % NXCD, xcd = wgid % NXCD, off = wgid / NXCD; wgid = (xcd < r ? xcd * (q + 1) : r * (q + 1) + (xcd - r) * q) + off; }
        const int nig = wgm * nN, gid = wgid / nig, fm = gid * wgm, gsz = (nM - fm) < wgm ? (nM - fm) : wgm;
        u.pm = fm + ((wgid % nig) % gsz); u.pn = (wgid % nig) / gsz; return true;
    }
    __device__ __forceinline__ void a_ready(const Unit&) const {}
    __device__ __forceinline__ void done(const Unit&) const {}
};

__device__ __forceinline__ unsigned cvt_pk_bf16(float lo, float hi) { unsigned r; asm volatile("v_cvt_pk_bf16_f32 %0, %1, %2" : "=v"(r) : "v"(lo), "v"(hi)); return r; }
typedef unsigned u32x4 __attribute__((ext_vector_type(4)));
struct EpiStoreBf16 {
    static constexpr bool PERM = true, AFTER_DRAIN = false;
    bf16_t* O; int ldc;
    __device__ __forceinline__ void operator()(const f32x4 (&acc)[2][2][4][2], const Unit& u, int wr, int wc, int fr, int fq) const {
        const int row0 = u.pm * BM + wr * 64 + fr; const int col0 = u.pn * BM + wc * 32 + 8 * fq;
#pragma unroll
        for (int ai = 0; ai < 2; ++ai)
#pragma unroll
            for (int m = 0; m < 4; ++m) { bf16_t* rowp = O + (size_t)(row0 + ai * HALF + m * 16) * ldc + col0;
#pragma unroll
                for (int bj = 0; bj < 2; ++bj) { const f32x4 v0 = acc[ai][bj][m][0], v1 = acc[ai][bj][m][1];
                    u32x4 w; w.x = cvt_pk_bf16(v0[0], v0[1]); w.y = cvt_pk_bf16(v0[2], v0[3]); w.z = cvt_pk_bf16(v1[0], v1[1]); w.w = cvt_pk_bf16(v1[2], v1[3]);
                    *(u32x4*)(rowp + bj * HALF) = w; } }
    }
};
struct EpiResid {
    static constexpr bool PERM = false, AFTER_DRAIN = false;
    const float* base; float* out; const float* gate; int ldc; int gpitch; int rows_per_batch;
    __device__ __forceinline__ void operator()(const f32x4 (&acc)[2][2][4][2], const Unit& u, int wr, int wc, int fr, int fq) const {
        const int row0 = u.pm * BM + wr * 64 + fr; const int col0 = u.pn * BM + wc * 32 + 4 * fq;
        const float* g = gate + (size_t)((u.pm * BM) / rows_per_batch) * gpitch + col0;
        f32x4 gv[2][2];
#pragma unroll
        for (int bj = 0; bj < 2; ++bj)
#pragma unroll
            for (int n = 0; n < 2; ++n) gv[bj][n] = *(const f32x4*)(g + bj * HALF + n * 16);
        f32x4 pb[3][4];
#define ER_LOAD(G_, D_) do { const size_t off_ = (size_t)(row0 + ((G_) >> 2) * HALF + ((G_) & 3) * 16) * ldc + col0; \
        _Pragma("unroll") for (int q_ = 0; q_ < 4; ++q_) D_[q_] = *(const f32x4*)(base + off_ + (q_ >> 1) * HALF + (q_ & 1) * 16); } while (0)
        ER_LOAD(0, pb[0]); ER_LOAD(1, pb[1]);
#pragma unroll
        for (int G = 0; G < 8; ++G) {
            if (G + 2 < 8) ER_LOAD(G + 2, pb[(G + 2) % 3]);
            __builtin_amdgcn_sched_barrier(0);
            const int ai = G >> 2, m = G & 3;
            const size_t off = (size_t)(row0 + ai * HALF + m * 16) * ldc + col0;
#pragma unroll
            for (int q = 0; q < 4; ++q) { const int bj = q >> 1, n = q & 1;
                *(f32x4*)(out + off + bj * HALF + n * 16) = pb[G % 3][q] + gv[bj][n] * acc[ai][bj][m][n]; }
            __builtin_amdgcn_sched_barrier(0);
        }
#undef ER_LOAD
    }
};
template <int N> __device__ __forceinline__ float dpp_ror(float v) { return __builtin_bit_cast(float, __builtin_amdgcn_update_dpp(0, __builtin_bit_cast(int, v), 0x120 + N, 0xf, 0xf, false)); }
struct EpiGateUp {
    static constexpr bool PERM = true, AFTER_DRAIN = false;
    bf16_t* ACT; const float* cw; const float* cb; float* GLAST; float* GFIRST; float* UFIRST; PG8_LAS float* XL; int dff;
    __device__ __forceinline__ void operator()(const f32x4 (&acc)[2][2][4][2], const Unit& u, int wr, int wc, int fr, int fq) const {
        const int ch0 = u.pn * 128 + wc * 32 + 8 * fq;
        float w0[8], w1[8], w2[8], bb[8];
#pragma unroll
        for (int n = 0; n < 2; ++n) { const f32x4 a = *(const f32x4*)(cw + ch0 + 4 * n), b = *(const f32x4*)(cw + dff + ch0 + 4 * n), c = *(const f32x4*)(cw + 2 * dff + ch0 + 4 * n), d = *(const f32x4*)(cb + ch0 + 4 * n);
#pragma unroll
            for (int j = 0; j < 4; ++j) { w0[4 * n + j] = a[j]; w1[4 * n + j] = b[j]; w2[4 * n + j] = c[j]; bb[4 * n + j] = d[j]; } }
        if (fr >= 14) {
#pragma unroll
            for (int ai = 0; ai < 2; ++ai)
#pragma unroll
                for (int n = 0; n < 2; ++n) *(PG8_LAS f32x4*)(XL + ((((ai * 2 + wr) * 4 + wc) * 2 + (fr - 14)) * 32 + 8 * fq + 4 * n)) = acc[ai][0][3][n];
            if (wr == 1) {
#pragma unroll
                for (int n = 0; n < 2; ++n) *(f32x4*)(GLAST + (size_t)(u.pm * 2 + (fr - 14)) * dff + ch0 + 4 * n) = acc[1][0][3][n];
            }
        }
        if (wr == 0 && fr < 2) {
#pragma unroll
            for (int n = 0; n < 2; ++n) { *(f32x4*)(GFIRST + (size_t)(u.pm * 2 + fr) * dff + ch0 + 4 * n) = acc[0][0][0][n]; *(f32x4*)(UFIRST + (size_t)(u.pm * 2 + fr) * dff + ch0 + 4 * n) = acc[0][1][0][n]; }
        }
        asm volatile("s_waitcnt lgkmcnt(0)" ::: "memory"); __builtin_amdgcn_s_barrier(); asm volatile("" ::: "memory");
        const int row0 = u.pm * BM + wr * 64 + fr;
#pragma unroll
        for (int ai = 0; ai < 2; ++ai) {
            float pv[8];
            {
                const int sai = (wr == 1) ? ai : 0, swr = (wr == 1) ? 0 : 1;
                const bool have = (wr == 1) || (ai == 1);
                PG8_LAS const float* src = XL + ((((sai * 2 + swr) * 4 + wc) * 2 + ((fr == 15) ? 1 : 0)) * 32 + 8 * fq);
                const f32x4 x0 = *(PG8_LAS const f32x4*)src, x1 = *(PG8_LAS const f32x4*)(src + 4);
#pragma unroll
                for (int j = 0; j < 4; ++j) { pv[j] = have ? x0[j] : 0.f; pv[4 + j] = have ? x1[j] : 0.f; }
            }
            float r1p[8], r2p[8];
#pragma unroll
            for (int e = 0; e < 8; ++e) { r1p[e] = dpp_ror<1>(pv[e]); r2p[e] = dpp_ror<2>(pv[e]); }
#pragma unroll
            for (int m = 0; m < 4; ++m) {
                u32x4 w;
                unsigned pk[4];
#pragma unroll
                for (int n = 0; n < 2; ++n) {
                    float o[4];
#pragma unroll
                    for (int j = 0; j < 4; ++j) {
                        const int e = 4 * n + j;
                        const float g = acc[ai][0][m][n][j], up = acc[ai][1][m][n][j];
                        const float g1s = dpp_ror<1>(g), g2s = dpp_ror<2>(g);
                        const float g1 = (fr >= 1) ? g1s : r1p[e], g2 = (fr >= 2) ? g2s : r2p[e];
                        r1p[e] = g1s; r2p[e] = g2s;
                        const float a = w0[e] * g2 + w1[e] * g1 + w2[e] * g + bb[e];
                        o[j] = a * __builtin_amdgcn_rcpf(1.f + __expf(-a)) * up;
                    }
                    pk[2 * n] = cvt_pk_bf16(o[0], o[1]); pk[2 * n + 1] = cvt_pk_bf16(o[2], o[3]);
                }
                w.x = pk[0]; w.y = pk[1]; w.z = pk[2]; w.w = pk[3];
                *(u32x4*)(ACT + (size_t)(row0 + ai * HALF + m * 16) * dff + ch0) = w;
            }
        }
    }
};
template <class Epi, class Sched, bool ALIGN_EPI = false, bool SP2 = false>
__device__ __forceinline__ void gemm_phase(PG8_LAS unsigned char* lds, const Gemm g, const Sched& S, const Epi& E) {
    const int tid = fresh_tid(), wid = __builtin_amdgcn_readfirstlane(tid >> 6), lane = tid & 63, wr = wid >> 2, wc = wid & 3, fr = lane & 15, fq = lane >> 4;
    const int K = g.K, nt = K / BK;
    unsigned voffA[2], voffB[2];
#pragma unroll
    for (int i = 0; i < 2; ++i) { int R, C; stage_rc(tid * 16 + i * 8192, R, C); const int Rb = Epi::PERM ? ((R & ~31) + perm32(R & 31)) : R;
        voffA[i] = (unsigned)(R * K + C) * 2u; voffB[i] = (unsigned)(Rb * K + C) * 2u; }
    const size_t kstep = (size_t)(BK * 2);
    const size_t hstep = (size_t)HALF * K * 2;
    const size_t tstep = 2 * hstep;
    const unsigned ldsw = (unsigned)wid * 1024u;
    const int aoff = lds_byte(wr * 64 + fr, fq * 8), boff = lds_byte(wc * 32 + fr, fq * 8);
#define PG8_SA(b, h) (((b) * 2 + (h)) * HTB)
#define PG8_SB(b, h) ((4 + (b) * 2 + (h)) * HTB)
#define PG8_STAGE(bufoff, gbase, voff) do { _Pragma("unroll") for (int _i = 0; _i < 2; ++_i) \
        __builtin_amdgcn_global_load_lds((const unsigned*)((const char*)(gbase) + (voff)[_i]), (PG8_LAS unsigned*)(lds + (bufoff) + ldsw + _i * 8192), 16, 0, 0); } while (0)
#define PG8_LDA(dst, b, h) do { _Pragma("unroll") for (int m = 0; m < 4; ++m) _Pragma("unroll") for (int k = 0; k < 2; ++k) dst[m][k] = *(const PG8_LAS bf16x8*)(lds + PG8_SA(b, h) + aoff + m * 2048 + k * 1024); } while (0)
#define PG8_LDB(dst, b, h) do { _Pragma("unroll") for (int n = 0; n < 2; ++n) _Pragma("unroll") for (int k = 0; k < 2; ++k) dst[n][k] = *(const PG8_LAS bf16x8*)(lds + PG8_SB(b, h) + boff + n * 2048 + k * 1024); } while (0)
#define PG8_MMA(ai, bj, At, Bt) do { __builtin_amdgcn_s_setprio(1); _Pragma("unroll") for (int m = 0; m < 4; ++m) _Pragma("unroll") for (int n = 0; n < 2; ++n) _Pragma("unroll") for (int k = 0; k < 2; ++k) \
        acc[ai][bj][m][n] = __builtin_amdgcn_mfma_f32_16x16x32_bf16(Bt[n][k], At[m][k], acc[ai][bj][m][n], 0, 0, 0); __builtin_amdgcn_s_setprio(0); } while (0)
#define PG8_WAIT_V(n) asm volatile("s_waitcnt vmcnt(" #n ")" ::: "memory")
#define PG8_WAIT_L(n) asm volatile("s_waitcnt lgkmcnt(" #n ")" ::: "memory")
#define PG8_BAR __builtin_amdgcn_s_barrier()
#define PG8_SCHED __builtin_amdgcn_sched_barrier(0)
    Unit cur, nxt; int ui = 0;
    if (!S.next(0, cur)) return;
    f32x4 acc[2][2][4][2];
#pragma unroll
    for (int a = 0; a < 2; ++a)
#pragma unroll
        for (int b = 0; b < 2; ++b)
#pragma unroll
            for (int m = 0; m < 4; ++m)
#pragma unroll
                for (int n = 0; n < 2; ++n) acc[a][b][m][n] = (f32x4){0.f, 0.f, 0.f, 0.f};
    bf16x8 At[4][2], B0[2][2], B1[2][2];
    const char* cA = (const char*)g.A + (size_t)cur.pm * tstep; const char* cB = (const char*)g.Bt + (size_t)cur.pn * tstep;
    S.a_ready(cur);
    if constexpr (SP2) {
        PG8_STAGE(PG8_SB(0, 0), cB, voffB); PG8_STAGE(PG8_SB(0, 1), cB + hstep, voffB); PG8_STAGE(PG8_SA(0, 0), cA, voffA); PG8_STAGE(PG8_SA(0, 1), cA + hstep, voffA);
        if (wr == 1) PG8_BAR;
        PG8_WAIT_V(2); PG8_BAR;
        PG8_STAGE(PG8_SB(1, 0), cB + kstep, voffB); PG8_STAGE(PG8_SA(1, 0), cA + kstep, voffA); PG8_STAGE(PG8_SB(1, 1), cB + hstep + kstep, voffB);
        PG8_WAIT_V(6); PG8_BAR;
    } else {
        PG8_STAGE(PG8_SB(0, 0), cB, voffB); PG8_STAGE(PG8_SA(0, 0), cA, voffA); PG8_STAGE(PG8_SB(0, 1), cB + hstep, voffB); PG8_STAGE(PG8_SA(0, 1), cA + hstep, voffA);
        if (wr == 1) PG8_BAR;
        PG8_WAIT_V(4); PG8_BAR;
        PG8_STAGE(PG8_SB(1, 0), cB + kstep, voffB); PG8_STAGE(PG8_SA(1, 0), cA + kstep, voffA); PG8_STAGE(PG8_SB(1, 1), cB + hstep + kstep, voffB);
        PG8_WAIT_V(6); PG8_BAR;
    }
    for (;;) {
        const bool has_next = S.next(ui + 1, nxt);
        const char* nA = has_next ? (const char*)g.A + (size_t)nxt.pm * tstep : cA; const char* nB = has_next ? (const char*)g.Bt + (size_t)nxt.pn * tstep : cB;
        for (int t = 0; t < nt; t += 2) {
            const bool last = (t == nt - 2);
            const char* a1 = cA + (size_t)(t + 1) * kstep;
            const char* a2 = last ? nA : cA + (size_t)(t + 2) * kstep; const char* b2 = last ? nB : cB + (size_t)(t + 2) * kstep;
            const char* a3 = a2 + kstep; const char* b3 = b2 + kstep;
            if (last && has_next) S.a_ready(nxt);
            if constexpr (SP2) {
            PG8_LDB(B0, 0, 0); PG8_LDB(B1, 0, 1); PG8_SCHED; PG8_LDA(At, 0, 0); PG8_STAGE(PG8_SA(1, 1), a1 + hstep, voffA);
            PG8_WAIT_V(8); PG8_WAIT_L(0); PG8_BAR; PG8_MMA(0, 0, At, B0); PG8_MMA(0, 1, At, B1); PG8_BAR; PG8_SCHED;
            PG8_LDA(At, 0, 1); PG8_STAGE(PG8_SB(0, 0), b2, voffB); PG8_STAGE(PG8_SB(0, 1), b2 + hstep, voffB); PG8_STAGE(PG8_SA(0, 0), a2, voffA);
            PG8_WAIT_V(8); PG8_WAIT_L(0); PG8_BAR; PG8_MMA(1, 0, At, B0); PG8_MMA(1, 1, At, B1); PG8_BAR; PG8_SCHED;
            PG8_LDB(B0, 1, 0); PG8_LDB(B1, 1, 1); PG8_SCHED; PG8_LDA(At, 1, 0); PG8_STAGE(PG8_SA(0, 1), a2 + hstep, voffA);
            PG8_WAIT_V(8); PG8_WAIT_L(0); PG8_BAR; PG8_MMA(0, 0, At, B0); PG8_MMA(0, 1, At, B1); PG8_BAR; PG8_SCHED;
            PG8_LDA(At, 1, 1); PG8_STAGE(PG8_SB(1, 0), b3, voffB); PG8_STAGE(PG8_SB(1, 1), b3 + hstep, voffB); PG8_STAGE(PG8_SA(1, 0), a3, voffA);
            PG8_WAIT_V(8); PG8_WAIT_L(0); PG8_BAR; PG8_MMA(1, 0, At, B0); PG8_MMA(1, 1, At, B1); PG8_BAR; PG8_SCHED;
            } else {
            PG8_LDB(B0, 0, 0); PG8_SCHED; PG8_LDA(At, 0, 0); PG8_STAGE(PG8_SA(1, 1), a1 + hstep, voffA);
            PG8_WAIT_L(8); PG8_BAR; PG8_WAIT_L(0); PG8_MMA(0, 0, At, B0); PG8_BAR; PG8_SCHED;
            PG8_LDB(B1, 0, 1); PG8_STAGE(PG8_SB(0, 0), b2, voffB);
            PG8_BAR; PG8_WAIT_L(0); PG8_MMA(0, 1, At, B1); PG8_BAR;
            PG8_LDA(At, 0, 1); PG8_STAGE(PG8_SA(0, 0), a2, voffA);
            PG8_BAR; PG8_WAIT_L(0); PG8_MMA(1, 0, At, B0); PG8_BAR; PG8_SCHED;
            PG8_STAGE(PG8_SB(0, 1), b2 + hstep, voffB);
            PG8_WAIT_V(6); PG8_BAR; PG8_MMA(1, 1, At, B1); PG8_BAR;
            PG8_LDB(B0, 1, 0); PG8_SCHED; PG8_LDA(At, 1, 0); PG8_STAGE(PG8_SA(0, 1), a2 + hstep, voffA);
            PG8_WAIT_L(8); PG8_BAR; PG8_WAIT_L(0); PG8_MMA(0, 0, At, B0); PG8_BAR; PG8_SCHED;
            PG8_LDB(B1, 1, 1); PG8_STAGE(PG8_SB(1, 0), b3, voffB);
            PG8_BAR; PG8_WAIT_L(0); PG8_MMA(0, 1, At, B1); PG8_BAR;
            PG8_LDA(At, 1, 1); PG8_STAGE(PG8_SA(1, 0), a3, voffA);
            PG8_BAR; PG8_WAIT_L(0); PG8_MMA(1, 0, At, B0); PG8_BAR; PG8_SCHED;
            PG8_STAGE(PG8_SB(1, 1), b3 + hstep, voffB);
            PG8_WAIT_V(6); PG8_BAR; PG8_MMA(1, 1, At, B1); PG8_BAR;
            }
        }
        if constexpr (ALIGN_EPI) { if (wr == 0) PG8_BAR; }
        if constexpr (!Epi::AFTER_DRAIN) { E(acc, cur, wr, wc, fr, fq); S.done(cur); }
        if (!has_next) break;
#pragma unroll
        for (int a = 0; a < 2; ++a)
#pragma unroll
            for (int b = 0; b < 2; ++b)
#pragma unroll
                for (int m = 0; m < 4; ++m)
#pragma unroll
                    for (int n = 0; n < 2; ++n) acc[a][b][m][n] = (f32x4){0.f, 0.f, 0.f, 0.f};
        cur = nxt; cA = nA; cB = nB; ++ui;
        if constexpr (ALIGN_EPI) { if (wr == 1) PG8_BAR; }
    }
    PG8_WAIT_V(0);
    if constexpr (!ALIGN_EPI) { if (wr == 0) PG8_BAR; }
    PG8_BAR;
    if constexpr (Epi::AFTER_DRAIN) { E.fused(acc, cur, wr, wc, fr, fq, lds, wid, lane); S.done(cur); }
#undef PG8_SA
#undef PG8_SB
#undef PG8_STAGE
#undef PG8_LDA
#undef PG8_LDB
#undef PG8_MMA
#undef PG8_WAIT_V
#undef PG8_WAIT_L
#undef PG8_BAR
#undef PG8_SCHED
}
}
#define LAS __attribute__((address_space(3)))
#define XB_TMO      128
#define XB_XCNT(j)  (256  + 64 * (j))
#define XB_XSUB(j)  (1280 + 64 * (j))
#define XB_XGEN(j)  (2304 + 64 * (j))
#define XB_TOP      3328
#define XB_TOPGEN   3392
#define XCD_BAR_WORDS 3456
#define XB_SPIN_CAP (1u << 18)

__device__ __forceinline__ unsigned xb_ld(unsigned* p)              { return __hip_atomic_load(p, __ATOMIC_RELAXED, __HIP_MEMORY_SCOPE_AGENT); }
__device__ __forceinline__ unsigned xb_add(unsigned* p, unsigned v) { return __hip_atomic_fetch_add(p, v, __ATOMIC_RELAXED, __HIP_MEMORY_SCOPE_AGENT); }
__device__ __forceinline__ unsigned xb_xcc_id() { return (unsigned)__builtin_amdgcn_s_getreg((3 << 11) | 20) & 0xFu; }
#define XB_SPIN(cond, bar) do { unsigned _sp = 0; while (cond) { __builtin_amdgcn_s_sleep(1); \
    if ((++_sp & 255u) == 0u) { if (xb_ld(&(bar)[XB_TMO])) break; if (_sp > XB_SPIN_CAP) { atomicAdd(&(bar)[XB_TMO], 1u); break; } } } } while (0)

struct XcdBarrier {
    unsigned* bar; unsigned x;
    volatile LAS unsigned* st;
};

__device__ __forceinline__ XcdBarrier xcd_barrier_post(unsigned* bar, volatile LAS unsigned* st) {
    XcdBarrier b; b.bar = bar; b.x = xb_xcc_id(); b.st = st;
    if (threadIdx.x == 0) (void)xb_add(&bar[XB_XCNT(b.x)], 1u);
    return b;
}
__device__ __forceinline__ void xcd_barrier_complete(unsigned* bar, unsigned x, unsigned& nloc, unsigned& nx) {
    const unsigned G = gridDim.x * gridDim.y * gridDim.z;
    unsigned sum, cnt, mine, sp = 0u;
    for (;;) {
        sum = 0u; cnt = 0u; mine = 0u;
#pragma unroll
        for (unsigned j = 0; j < 16; ++j) { const unsigned c = xb_ld(&bar[XB_XCNT(j)]); sum += c; cnt += (c > 0u) ? 1u : 0u; mine = (j == x) ? c : mine; }
        if (sum == G) break;
        __builtin_amdgcn_s_sleep(1);
        if ((++sp & 255u) == 0u) { if (xb_ld(&bar[XB_TMO])) break; if (sp > XB_SPIN_CAP) { atomicAdd(&bar[XB_TMO], 1u); break; } }
    }
    nloc = mine > 0u ? mine : 1u; nx = cnt > 0u ? cnt : 1u;
}

__device__ __forceinline__ void xcd_barrier(const XcdBarrier& b) {
    asm volatile("s_waitcnt vmcnt(0)" ::: "memory");
    __syncthreads();
    if (threadIdx.x == 0) {
        unsigned* bar = b.bar;
        __builtin_amdgcn_s_waitcnt(0);
        unsigned nloc = b.st[0], nx = b.st[1];
        if (nloc == 0u) { xcd_barrier_complete(bar, b.x, nloc, nx); b.st[0] = nloc; b.st[1] = nx; }
        const unsigned old = xb_add(&bar[XB_XSUB(b.x)], 1u);
        const unsigned gen = old / nloc;
        if (old + 1u == (gen + 1u) * nloc) {
            __builtin_amdgcn_fence(__ATOMIC_RELEASE, "agent");
            asm volatile("s_waitcnt vmcnt(0)" ::: "memory");
            const unsigned og = xb_add(&bar[XB_TOP], 1u);
            const unsigned tg = og / nx;
            if (og + 1u == (tg + 1u) * nx) xb_add(&bar[XB_TOPGEN], 1u);
            else XB_SPIN(xb_ld(&bar[XB_TOPGEN]) == tg, bar);
            __builtin_amdgcn_fence(__ATOMIC_ACQUIRE, "agent");
            xb_add(&bar[XB_XGEN(b.x)], 1u);
            asm volatile("s_waitcnt vmcnt(0)" ::: "memory");
        } else {
            XB_SPIN(xb_ld(&bar[XB_XGEN(b.x)]) == gen, bar);
            __builtin_amdgcn_fence(__ATOMIC_ACQUIRE, "agent");
            asm volatile("s_waitcnt vmcnt(0)" ::: "memory");
        }
    }
    __syncthreads();
}

constexpr int NB = 4, T = 4096, M = NB * T, D = 2048, DFF = 5632, INW = 5660, INP = 5888, NL = 2, MODW = 6 * D;
constexpr int C_GLA_Q = 0, C_GLA_K = 256, C_GLA_V = 512, C_GLA_G = 1024, C_GLA_LR = 1536,
              C_GDN_Q = 1552, C_GDN_K = 2064, C_GDN_V = 2576, C_GDN_G = 3088, C_GDN_B = 3600, C_GDN_A = 3604,
              C_POOL = 3608, C_FOX_Q = 4120, C_FOX_K = 4632, C_FOX_V = 5144, C_FOX_F = 5656;
constexpr float EPS = 1e-6f;
constexpr float LOG2E = 1.4426950408889634f;
constexpr size_t MiB = 1u << 20;
constexpr size_t WS_MOD = 1 * MiB, WS_FCUM = 2 * MiB, WS_GLADEC = 3 * MiB, WS_GDNDEC = 4 * MiB, WS_PWT = 5 * MiB;
constexpr size_t WS_WIN = 8 * MiB, WS_WOUT = 31 * MiB, WS_WGU = 39 * MiB, WS_WDN = 83 * MiB;
constexpr size_t WS_H = 105 * MiB, WS_ACT = 169 * MiB, WS_PROJ = 345 * MiB, WS_Y = 529 * MiB, WS_GDN = 593 * MiB, WS_GLA = 665 * MiB, WS_VT = 705 * MiB, WS_END = 721 * MiB;
constexpr size_t WS_SIDE = WS_VT;
constexpr size_t WS_GU = WS_PROJ;
static_assert(WS_GU + (size_t)M * 2 * DFF * 2 <= WS_VT, "GU overlay");
constexpr size_t GDN_ITEM = 73728, GLA_ITEM = 40960;
constexpr int LDS_BYTES = 147456;

typedef unsigned short bf16;
typedef float f32x4 __attribute__((ext_vector_type(4)));
typedef float f32x2 __attribute__((ext_vector_type(2)));
typedef short bf16x8 __attribute__((ext_vector_type(8)));
typedef unsigned u32x4v __attribute__((ext_vector_type(4)));
typedef unsigned u32x2v __attribute__((ext_vector_type(2)));

__device__ __forceinline__ unsigned f2bf(float f) { unsigned u = __builtin_bit_cast(unsigned, f); return (u + 0x7fffu + ((u >> 16) & 1u)) >> 16; }
__device__ __forceinline__ unsigned pk2(float lo, float hi) { unsigned r; asm("v_cvt_pk_bf16_f32 %0, %1, %2" : "=v"(r) : "v"(lo), "v"(hi)); return r; }
__device__ __forceinline__ bf16 bf1(float x) { return (bf16)pk2(x, x); }
__device__ __forceinline__ float bflo(unsigned w) { return __builtin_bit_cast(float, w << 16); }
__device__ __forceinline__ float bfhi(unsigned w) { return __builtin_bit_cast(float, w & 0xffff0000u); }
__device__ __forceinline__ float bf2f(bf16 b) { return __builtin_bit_cast(float, (unsigned)b << 16); }
#define DPPF(x, ctrl, rmask, bound) __builtin_bit_cast(float, __builtin_amdgcn_update_dpp(0, __builtin_bit_cast(int, (x)), (ctrl), (rmask), 0xf, (bound)))
__device__ __forceinline__ float readlane_f(float v, int l) { return __builtin_bit_cast(float, __builtin_amdgcn_readlane(__builtin_bit_cast(int, v), l)); }
__device__ __forceinline__ float wave_sum(float v) {
    v += DPPF(v, 0x128, 0xf, false); v += DPPF(v, 0x124, 0xf, false); v += DPPF(v, 0x122, 0xf, false); v += DPPF(v, 0x121, 0xf, false);
    return (readlane_f(v, 0) + readlane_f(v, 16)) + (readlane_f(v, 32) + readlane_f(v, 48));
}
__device__ __forceinline__ float wave_iscan(float x, int lane) {
    (void)lane;
    x += DPPF(x, 0x111, 0xf, true); x += DPPF(x, 0x112, 0xf, true); x += DPPF(x, 0x114, 0xf, true); x += DPPF(x, 0x118, 0xf, true);
    x += DPPF(x, 0x142, 0xa, false);
    x += DPPF(x, 0x143, 0xc, false);
    return x;
}
__device__ __forceinline__ float sigmoidf_(float x) { return __builtin_amdgcn_rcpf(1.f + __expf(-x)); }
__device__ __forceinline__ float siluf_(float x) { return x * __builtin_amdgcn_rcpf(1.f + __expf(-x)); }
__device__ __forceinline__ float logsigmoidf_(float x) { return fminf(x, 0.f) - __logf(1.f + __expf(-fabsf(x))); }
__device__ __forceinline__ float softplusf_(float x) { return fmaxf(x, 0.f) + __logf(1.f + __expf(-fabsf(x))); }
__device__ __forceinline__ bf16x8 pack8(const f32x4 a, const f32x4 b) {
    u32x4v w; w.x = pk2(a[0], a[1]); w.y = pk2(a[2], a[3]); w.z = pk2(b[0], b[1]); w.w = pk2(b[2], b[3]);
    return __builtin_bit_cast(bf16x8, w);
}
__device__ __forceinline__ bf16x8 afrag_perm(const bf16* rowp, int k0, int fq) {
    const u32x2v lo = *(const u32x2v*)(rowp + k0 + 4 * fq), hi = *(const u32x2v*)(rowp + k0 + 16 + 4 * fq);
    u32x4v w; w.x = lo.x; w.y = lo.y; w.z = hi.x; w.w = hi.y; return __builtin_bit_cast(bf16x8, w);
}
#define LAS3 __attribute__((address_space(3)))
#define LDSBAR() do { asm volatile("s_waitcnt lgkmcnt(0)" ::: "memory"); __builtin_amdgcn_s_barrier(); asm volatile("" ::: "memory"); } while (0)
#define SB() __builtin_amdgcn_sched_barrier(0)
__device__ __forceinline__ float row16_sum(float x) {
    x += __builtin_bit_cast(float, __builtin_amdgcn_update_dpp(0, __builtin_bit_cast(int, x), 0x128, 0xf, 0xf, false));
    x += __builtin_bit_cast(float, __builtin_amdgcn_update_dpp(0, __builtin_bit_cast(int, x), 0x124, 0xf, 0xf, false));
    x += __builtin_bit_cast(float, __builtin_amdgcn_update_dpp(0, __builtin_bit_cast(int, x), 0x122, 0xf, 0xf, false));
    x += __builtin_bit_cast(float, __builtin_amdgcn_update_dpp(0, __builtin_bit_cast(int, x), 0x121, 0xf, 0xf, false));
    return x;
}
__device__ __forceinline__ void lds_put_perm(bf16* rowp, int c0, const u32x4v v) {
    const int blk = c0 & ~31, k = c0 & 31;
    const int plo = (k < 16) ? 2 * k : 2 * k - 28, phi = (k + 4 < 16) ? 2 * (k + 4) : 2 * (k + 4) - 28;
    *(u32x2v*)(rowp + blk + plo) = (u32x2v){v.x, v.y}; *(u32x2v*)(rowp + blk + phi) = (u32x2v){v.z, v.w};
}
__device__ __forceinline__ bf16x8 afrag_lin(const bf16* rowp, int k0, int fq) { return *(const bf16x8*)(rowp + k0 + 8 * fq); }
#define MFMA16(a, b, c) __builtin_amdgcn_mfma_f32_16x16x32_bf16((a), (b), (c), 0, 0, 0)

__device__ __forceinline__ void phase_mod(const float* c, const float* w_mod, const float* b_mod, float* mod, unsigned char* lds) {
    float* sc = (float*)lds;
    float* part = sc + 4 * 2048;
    const int tid = fresh_tid();
    for (int i = tid; i < NB * D; i += 512) sc[i] = siluf_(c[i]);
    __syncthreads();
    for (int chunk = fresh_bid(); chunk < 256; chunk += gridDim.x) {
        const int l = chunk >> 7, col0 = (chunk & 127) * 96;
        if (tid < 384) {
            const int cgi = tid % 24, ks = tid / 24;
            const float* W = w_mod + (size_t)l * D * MODW + col0 + cgi * 4;
            f32x4 a0 = {0.f, 0.f, 0.f, 0.f}, a1 = a0, a2 = a0, a3 = a0;
#pragma unroll 8
            for (int k = ks * 128; k < ks * 128 + 128; ++k) {
                const f32x4 w = *(const f32x4*)(W + (size_t)k * MODW);
                a0 += sc[k] * w; a1 += sc[D + k] * w; a2 += sc[2 * D + k] * w; a3 += sc[3 * D + k] * w;
            }
            float* p = part + (ks * 24 + cgi) * 16;
            *(f32x4*)(p) = a0; *(f32x4*)(p + 4) = a1; *(f32x4*)(p + 8) = a2; *(f32x4*)(p + 12) = a3;
        }
        __syncthreads();
        if (tid < 384) {
            const int cgi = tid >> 4, bj = tid & 15, b = bj >> 2, j = bj & 3;
            float s = 0.f;
#pragma unroll
            for (int ks = 0; ks < 16; ++ks) s += part[(ks * 24 + cgi) * 16 + bj];
            const int col = col0 + cgi * 4 + j;
            mod[(size_t)(l * NB + b) * MODW + col] = s + b_mod[(size_t)l * MODW + col];
        }
        __syncthreads();
    }
}

struct TrDesc { const float* W; bf16* WT; int K, N, nblk, il, r; };
struct LayerW { const float *w_in, *w_out, *w_gate, *w_up, *w_down, *pool_w; };
__device__ __forceinline__ TrDesc tr_resolve(const LayerW& L, unsigned char* wsp, int part, int it) {
    constexpr int I0 = 32 * 184, I1 = 32 * 64, I2 = 32 * 176, I5 = 8;
    TrDesc d; int r = it;
    if (part == 0) {
        if (r < I0) { d.W = L.w_in; d.WT = (bf16*)(wsp + WS_WIN); d.K = D; d.N = INW; d.nblk = 184; d.il = -1; d.r = r; return d; } r -= I0;
        const int g = r / I5; r -= g * I5;
        d.W = L.pool_w + (size_t)g * 128 * 128; d.WT = (bf16*)(wsp + WS_PWT) + (size_t)g * 128 * 128; d.K = 128; d.N = 128; d.nblk = 4; d.il = -1; d.r = r; return d;
    }
    if (r < I1) { d.W = L.w_out; d.WT = (bf16*)(wsp + WS_WOUT); d.K = D; d.N = D; d.nblk = 64; d.il = -1; d.r = r; return d; } r -= I1;
    if (r < I2) { d.W = L.w_gate; d.WT = (bf16*)(wsp + WS_WGU); d.K = D; d.N = DFF; d.nblk = 176; d.il = 0; d.r = r; return d; } r -= I2;
    if (r < I2) { d.W = L.w_up; d.WT = (bf16*)(wsp + WS_WGU); d.K = D; d.N = DFF; d.nblk = 176; d.il = 128; d.r = r; return d; } r -= I2;
    d.W = L.w_down; d.WT = (bf16*)(wsp + WS_WDN); d.K = DFF; d.N = D; d.nblk = 64; d.il = -1; d.r = r; return d;
}
__device__ __forceinline__ void tr_load(const TrDesc& d, int lane, float (&v)[32]) {
    const int kb = d.r / d.nblk, nb = d.r % d.nblk, k0 = 64 * kb, n = 32 * nb + (lane & 31);
    const float* p = d.W + (size_t)(k0 + (lane >> 5)) * d.N + n;
    const bool ok = n < d.N;
#pragma unroll
    for (int i = 0; i < 32; ++i) v[i] = ok ? p[(size_t)(2 * i) * d.N] : 0.f;
}
__device__ __forceinline__ void tr_store(const TrDesc& d, int lane, const float (&v)[32], float* scr) {
    const int kb = d.r / d.nblk, nb = d.r % d.nblk, k0 = 64 * kb, n0 = 32 * nb;
#pragma unroll
    for (int i = 0; i < 32; ++i) scr[(2 * i + (lane >> 5)) * 33 + (lane & 31)] = v[i];
    asm volatile("s_waitcnt lgkmcnt(0)" ::: "memory");
    const int c = lane & 7;
#pragma unroll
    for (int j = 0; j < 4; ++j) { const int nn = (lane >> 3) + 8 * j; const float* s = scr + (8 * c) * 33 + nn;
        u32x4v o; o.x = pk2(s[0 * 33], s[1 * 33]); o.y = pk2(s[2 * 33], s[3 * 33]); o.z = pk2(s[4 * 33], s[5 * 33]); o.w = pk2(s[6 * 33], s[7 * 33]);
        const int row = (d.il < 0) ? (n0 + nn) : (((n0 + nn) >> 7) * 256 + d.il + ((n0 + nn) & 127));
        *(u32x4v*)(d.WT + (size_t)row * d.K + k0 + 8 * c) = o; }
    asm volatile("s_waitcnt lgkmcnt(0)" ::: "memory");
}
__device__ __forceinline__ void phase_transpose(const LayerW& L, unsigned char* wsp, unsigned char* lds, int part, int blk0, int nblk) {
    const int tid_ = fresh_tid(), wave = __builtin_amdgcn_readfirstlane(tid_ >> 6), lane = tid_ & 63;
    float* scr = (float*)lds + wave * (64 * 33);
    const int gw = (fresh_bid() - blk0) * 8 + wave, NGW = nblk * 8;
    constexpr int I0 = 32 * 184, I1 = 32 * 64, I2 = 32 * 176, I4 = 88 * 64, I5 = 8;
    const int NIT = (part == 0) ? I0 + 4 * I5 : I1 + 2 * I2 + I4;
    if (gw < 0 || gw >= NIT) return;
    float va[32], vb[32];
    TrDesc da = tr_resolve(L, wsp, part, gw), db = da;
    tr_load(da, lane, va);
    for (int it = gw; it < NIT; it += 2 * NGW) {
        const bool hb = it + NGW < NIT, ha = it + 2 * NGW < NIT;
        if (hb) { db = tr_resolve(L, wsp, part, it + NGW); tr_load(db, lane, vb); }
        tr_store(da, lane, va, scr);
        if (ha) { da = tr_resolve(L, wsp, part, it + 2 * NGW); tr_load(da, lane, va); }
        if (hb) tr_store(db, lane, vb, scr);
    }
}

__device__ __forceinline__ void phase_norm(const float* x, const float* nw, const float* modl, int shi, int sci, bf16* Hp) {
    const int tid_ = fresh_tid(), wave = __builtin_amdgcn_readfirstlane(tid_ >> 6), lane = tid_ & 63;
    const int gw = fresh_bid() * 8 + wave, NGW = gridDim.x * 8;
#define NORM_LOAD(V, m_) do { const f32x4* xr_ = (const f32x4*)(x + (size_t)(m_) * D) + lane; _Pragma("unroll") for (int j = 0; j < 8; ++j) V[j] = xr_[64 * j]; } while (0)
#define NORM_DO(V, m_) do { float ss = 0.f; \
        _Pragma("unroll") for (int j = 0; j < 8; ++j) ss += (V[j].x * V[j].x + V[j].y * V[j].y) + (V[j].z * V[j].z + V[j].w * V[j].w); \
        const float r = rsqrtf(wave_sum(ss) * (1.f / D) + EPS); \
        const float* mb = modl + (size_t)((m_) / T) * MODW; \
        f32x4 sc_[8], sh_[8]; \
        _Pragma("unroll") for (int j = 0; j < 8; ++j) { const int col = 4 * lane + 256 * j; sc_[j] = *(const f32x4*)(mb + sci * D + col); sh_[j] = *(const f32x4*)(mb + shi * D + col); } \
        SB(); \
        _Pragma("unroll") for (int j = 0; j < 8; ++j) { const int col = 4 * lane + 256 * j; \
            const f32x4 y = V[j] * r * wv[j] * (1.f + sc_[j]) + sh_[j]; \
            u32x2v o; o.x = pk2(y.x, y.y); o.y = pk2(y.z, y.w); \
            *(u32x2v*)(Hp + (size_t)(m_) * D + col) = o; } } while (0)
    if (gw >= M) return;
    f32x4 va[8], vb[8], wv[8];
#pragma unroll
    for (int j = 0; j < 8; ++j) wv[j] = *(const f32x4*)(nw + 4 * lane + 256 * j);
    NORM_LOAD(va, gw);
    for (int m = gw; m < M; m += 2 * NGW) {
        const bool hb = m + NGW < M, ha = m + 2 * NGW < M;
        if (hb) NORM_LOAD(vb, m + NGW);
        NORM_DO(va, m);
        if (ha) NORM_LOAD(va, m + 2 * NGW);
        if (hb) NORM_DO(vb, m + NGW);
    }
#undef NORM_DO
}
__device__ __forceinline__ void phase_final_norm(float* x, const float* nw) {
    const int tid_ = fresh_tid(), wave = __builtin_amdgcn_readfirstlane(tid_ >> 6), lane = tid_ & 63;
    const int gw = fresh_bid() * 8 + wave, NGW = gridDim.x * 8;
#define FNORM_DO(V, m_) do { float ss = 0.f; \
        _Pragma("unroll") for (int j = 0; j < 8; ++j) ss += (V[j].x * V[j].x + V[j].y * V[j].y) + (V[j].z * V[j].z + V[j].w * V[j].w); \
        const float r = rsqrtf(wave_sum(ss) * (1.f / D) + EPS); \
        f32x4* xo_ = (f32x4*)(x + (size_t)(m_) * D) + lane; \
        _Pragma("unroll") for (int j = 0; j < 8; ++j) xo_[64 * j] = V[j] * r * wv[j]; } while (0)
    if (gw >= M) return;
    f32x4 va[8], vb[8], wv[8];
#pragma unroll
    for (int j = 0; j < 8; ++j) wv[j] = *(const f32x4*)(nw + 4 * lane + 256 * j);
    NORM_LOAD(va, gw);
    for (int m = gw; m < M; m += 2 * NGW) {
        const bool hb = m + NGW < M, ha = m + 2 * NGW < M;
        if (hb) NORM_LOAD(vb, m + NGW);
        FNORM_DO(va, m);
        if (ha) NORM_LOAD(va, m + 2 * NGW);
        if (hb) FNORM_DO(vb, m + NGW);
    }
#undef FNORM_DO
#undef NORM_LOAD
}

__device__ __forceinline__ void gdn_prep_item(int item, const bf16* PROJ, const float* conv_w, const float* a_log, const float* dt_bias,
                                              unsigned char* scr_base, float* gdn_dec, unsigned char* lds) {
    const int tid = fresh_tid(), wave = __builtin_amdgcn_readfirstlane(tid >> 6), lane = tid & 63, fr = lane & 15, fq = lane >> 4;
    const int bh = item >> 6, n = item & 63, b = bh >> 2, h = bh & 3, t0 = n * 64;
    const size_t row0 = (size_t)b * T + t0;
    bf16* Kb = (bf16*)lds;
    bf16* Qb = Kb + 64 * 144;
    float* RHS = (float*)(Qb + 64 * 144);
    float* Lm = RHS + 64 * 260;
    float* bs = Lm + 64 * 68;
    float* gc = bs + 64;
    unsigned char* scr = scr_base + (size_t)item * GDN_ITEM;
    bf16* gQG = (bf16*)scr; bf16* gW = (bf16*)(scr + 16384); bf16* gK2T = (bf16*)(scr + 32768); bf16* gUT = (bf16*)(scr + 49152); bf16* gATT = (bf16*)(scr + 65536);
    if (wave == 0) {
        const bf16* pr = PROJ + (row0 + lane) * INP;
        const float a_in = bf2f(pr[C_GDN_A + h]), b_in = bf2f(pr[C_GDN_B + h]);
        const float g = -__expf(a_log[h]) * softplusf_(a_in + dt_bias[h]);
        gc[lane] = wave_iscan(g, lane); bs[lane] = sigmoidf_(b_in);
    }
    unsigned xr[3][11];
#pragma unroll
    for (int p = 0; p < 3; ++p)
#pragma unroll
        for (int i = 0; i < 11; ++i) { const int tt = t0 + 8 * wave + i - 3;
            xr[p][i] = (tt >= 0) ? *(const unsigned*)(PROJ + ((size_t)b * T + tt) * INP + C_GDN_Q + p * 512 + h * 128 + 2 * lane) : 0u; }
    LDSBAR();
#pragma unroll
    for (int p = 0; p < 3; ++p) {
        f32x2 cw[4];
#pragma unroll
        for (int j = 0; j < 4; ++j) cw[j] = *(const f32x2*)(conv_w + j * 1536 + p * 512 + h * 128 + 2 * lane);
#pragma unroll
        for (int i = 0; i < 8; ++i) {
            float y0 = 0.f, y1 = 0.f;
#pragma unroll
            for (int j = 0; j < 4; ++j) { y0 += cw[j].x * bflo(xr[p][i + j]); y1 += cw[j].y * bfhi(xr[p][i + j]); }
            y0 = siluf_(y0); y1 = siluf_(y1);
            const int t = 8 * wave + i;
            if (p == 0) { const float sc = rsqrtf(wave_sum(y0 * y0 + y1 * y1) + EPS) * 0.08838834764831845f;
                *(unsigned*)(Qb + t * 144 + 2 * lane) = pk2(y0 * sc, y1 * sc); }
            else if (p == 1) { const float sc = rsqrtf(wave_sum(y0 * y0 + y1 * y1) + EPS); y0 *= sc; y1 *= sc;
                *(unsigned*)(Kb + t * 144 + 2 * lane) = pk2(y0, y1);
                const float f = bs[t] * __expf(gc[t]);
                *(f32x2*)(RHS + t * 260 + 128 + 2 * lane) = (f32x2){y0 * f, y1 * f}; }
            else { const float f = bs[t]; *(f32x2*)(RHS + t * 260 + 2 * lane) = (f32x2){y0 * f, y1 * f}; }
        }
    }
    LDSBAR();
#pragma unroll
    for (int r = 0; r < 4; ++r) {
        const int tl = wave + 8 * r, isqk = tl >> 4, it = (tl & 15) >> 2, jt = tl & 3;
        f32x4 acc = {0.f, 0.f, 0.f, 0.f};
        if (jt <= it) {
            if (isqk) {
#pragma unroll
                for (int ks = 0; ks < 4; ++ks) acc = MFMA16(*(const bf16x8*)(Kb + (16 * jt + fr) * 144 + 32 * ks + 8 * fq), *(const bf16x8*)(Qb + (16 * it + fr) * 144 + 32 * ks + 8 * fq), acc);
            } else {
#pragma unroll
                for (int ks = 0; ks < 4; ++ks) acc = MFMA16(*(const bf16x8*)(Kb + (16 * it + fr) * 144 + 32 * ks + 8 * fq), *(const bf16x8*)(Kb + (16 * jt + fr) * 144 + 32 * ks + 8 * fq), acc);
            }
        }
        if (isqk) {
            const int i = 16 * it + fr; float o[4];
#pragma unroll
            for (int jj = 0; jj < 4; ++jj) { const int j = 16 * jt + 4 * fq + jj; o[jj] = (j <= i) ? acc[jj] * __expf(fminf(gc[i] - gc[j], 0.f)) : 0.f; }
            u32x2v w; w.x = pk2(o[0], o[1]); w.y = pk2(o[2], o[3]);
            *(u32x2v*)(gATT + i * 64 + 16 * jt + 4 * fq) = w;
        } else {
            const int j = 16 * jt + fr;
#pragma unroll
            for (int jj = 0; jj < 4; ++jj) { const int i = 16 * it + 4 * fq + jj; Lm[i * 68 + j] = (j < i) ? bs[i] * acc[jj] * __expf(fminf(gc[i] - gc[j], 0.f)) : 0.f; }
        }
    }
    LDSBAR();
    if (tid < 256) {
        const int c = tid;
        LAS3 const float* Lb = (LAS3 const float*)Lm; asm volatile("" : "+v"(Lb));
        LAS3 const float* Rb = (LAS3 const float*)RHS + c; asm volatile("" : "+v"(Rb));
        float x[64];
        f32x4 buf[2][16]; float rb[2];
        rb[0] = Rb[0];
#pragma unroll
        for (int i = 0; i < 64; ++i) {
            if (i + 1 < 64) {
                rb[(i + 1) & 1] = Rb[(i + 1) * 260];
#pragma unroll
                for (int j4 = 0; j4 < (i + 4) / 4; ++j4) buf[(i + 1) & 1][j4] = *(LAS3 const f32x4*)(Lb + (i + 1) * 68 + 4 * j4);
            }
            __builtin_amdgcn_sched_barrier(0);
            float s0 = rb[i & 1], s1 = 0.f, s2 = 0.f, s3 = 0.f;
#pragma unroll
            for (int j4 = 0; j4 < (i + 3) / 4; ++j4) {
                const f32x4 l4 = buf[i & 1][j4];
                s0 -= l4.x * x[4 * j4];
                if (4 * j4 + 1 < i) s1 -= l4.y * x[4 * j4 + 1];
                if (4 * j4 + 2 < i) s2 -= l4.z * x[4 * j4 + 2];
                if (4 * j4 + 3 < i) s3 -= l4.w * x[4 * j4 + 3];
            }
            x[i] = (s0 + s1) + (s2 + s3);
            __builtin_amdgcn_sched_barrier(0);
        }
        if (c < 128) {
#pragma unroll
            for (int q = 0; q < 8; ++q) { u32x4v w; w.x = pk2(x[8 * q], x[8 * q + 1]); w.y = pk2(x[8 * q + 2], x[8 * q + 3]); w.z = pk2(x[8 * q + 4], x[8 * q + 5]); w.w = pk2(x[8 * q + 6], x[8 * q + 7]);
                *(u32x4v*)(gUT + c * 64 + 8 * q) = w; }
        } else {
#pragma unroll
            for (int i = 0; i < 64; ++i) gW[i * 128 + (c - 128)] = bf1(x[i]);
        }
    } else {
        const int tt = tid - 256;
        {
            const int i = tt >> 2, d0 = (tt & 3) * 32; const float e = __expf(gc[i]);
#pragma unroll
            for (int q = 0; q < 4; ++q) { const u32x4v v = *(const u32x4v*)(Qb + i * 144 + d0 + 8 * q); u32x4v w;
                w.x = pk2(bflo(v.x) * e, bfhi(v.x) * e); w.y = pk2(bflo(v.y) * e, bfhi(v.y) * e); w.z = pk2(bflo(v.z) * e, bfhi(v.z) * e); w.w = pk2(bflo(v.w) * e, bfhi(v.w) * e);
                *(u32x4v*)(gQG + i * 128 + d0 + 8 * q) = w; }
        }
        {
            const int d = tt & 127, j0 = (tt >> 7) * 32; const float gl = gc[63];
#pragma unroll
            for (int q = 0; q < 4; ++q) { float v[8];
#pragma unroll
                for (int e = 0; e < 8; ++e) { const int j = j0 + 8 * q + e; v[e] = bf2f(Kb[j * 144 + d]) * __expf(gl - gc[j]); }
                u32x4v w; w.x = pk2(v[0], v[1]); w.y = pk2(v[2], v[3]); w.z = pk2(v[4], v[5]); w.w = pk2(v[6], v[7]);
                *(u32x4v*)(gK2T + d * 64 + j0 + 8 * q) = w; }
        }
        if (tt == 0) gdn_dec[item] = __expf(gc[63]);
    }
    LDSBAR();
}

__device__ __forceinline__ void gla_prep_item(int item, const bf16* PROJ, const float* w_lr, const float* b_lr, unsigned char* scr_base, float* gla_dec, unsigned char* lds) {
    const int tid = fresh_tid(), wave = __builtin_amdgcn_readfirstlane(tid >> 6), lane = tid & 63, fr = lane & 15, fq = lane >> 4;
    const int bh = item >> 6, n = item & 63, b = bh >> 2, h = bh & 3, t0 = n * 64;
    const size_t row0 = (size_t)b * T + t0;
    bf16* QGs = (bf16*)lds;
    bf16* KGs = QGs + 64 * 80;
    bf16* Vs = KGs + 64 * 80;
    unsigned char* scr = scr_base + (size_t)item * GLA_ITEM;
    bf16* gQG = (bf16*)scr; bf16* gK2T = (bf16*)(scr + 8192); bf16* gUT = (bf16*)(scr + 16384); bf16* gATT = (bf16*)(scr + 32768);
    {
        const int r = tid >> 3, sg = tid & 7;
        const bf16* src = PROJ + (row0 + r) * INP + C_GLA_V + h * 128 + 16 * sg;
        const u32x4v v0 = *(const u32x4v*)src, v1 = *(const u32x4v*)(src + 8);
        *(u32x4v*)(Vs + r * 136 + 16 * sg) = v0; *(u32x4v*)(Vs + r * 136 + 16 * sg + 8) = v1;
    }
    {
        const bf16* pr = PROJ + (row0 + lane) * INP;
        const u32x4v g0 = *(const u32x4v*)(pr + C_GLA_LR), g1 = *(const u32x4v*)(pr + C_GLA_LR + 8);
        float glr[16];
        glr[0] = bflo(g0.x); glr[1] = bfhi(g0.x); glr[2] = bflo(g0.y); glr[3] = bfhi(g0.y); glr[4] = bflo(g0.z); glr[5] = bfhi(g0.z); glr[6] = bflo(g0.w); glr[7] = bfhi(g0.w);
        glr[8] = bflo(g1.x); glr[9] = bfhi(g1.x); glr[10] = bflo(g1.y); glr[11] = bfhi(g1.y); glr[12] = bflo(g1.z); glr[13] = bfhi(g1.z); glr[14] = bflo(g1.w); glr[15] = bfhi(g1.w);
        const u32x4v qv = *(const u32x4v*)(pr + C_GLA_Q + h * 64 + 8 * wave), kv = *(const u32x4v*)(pr + C_GLA_K + h * 64 + 8 * wave);
        float q[8], k[8];
        q[0] = bflo(qv.x); q[1] = bfhi(qv.x); q[2] = bflo(qv.y); q[3] = bfhi(qv.y); q[4] = bflo(qv.z); q[5] = bfhi(qv.z); q[6] = bflo(qv.w); q[7] = bfhi(qv.w);
        k[0] = bflo(kv.x); k[1] = bfhi(kv.x); k[2] = bflo(kv.y); k[3] = bfhi(kv.y); k[4] = bflo(kv.z); k[5] = bfhi(kv.z); k[6] = bflo(kv.w); k[7] = bfhi(kv.w);
        float qg[8], kg[8], k2[8];
        const int dc0 = h * 64 + 8 * wave;
        const float wlo = w_lr[(lane >> 3) * 256 + dc0 + (lane & 7)], whi = w_lr[((lane >> 3) + 8) * 256 + dc0 + (lane & 7)], blv = b_lr[dc0 + (lane & 7)];
#pragma unroll
        for (int i = 0; i < 8; ++i) {
            float z = readlane_f(blv, i);
#pragma unroll
            for (int r = 0; r < 16; ++r) z += glr[r] * readlane_f(r < 8 ? wlo : whi, (r & 7) * 8 + i);
            const float bc = wave_iscan(logsigmoidf_(z) * (1.f / 16.f), lane);
            const float bl = readlane_f(bc, 63);
            qg[i] = q[i] * 0.125f * __expf(bc); kg[i] = k[i] * __expf(-bc); k2[i] = k[i] * __expf(bl - bc);
            gK2T[(8 * wave + i) * 64 + lane] = bf1(k2[i]);
            if (lane == 63) gla_dec[(size_t)item * 64 + 8 * wave + i] = __expf(bl);
        }
        u32x4v w; w.x = pk2(qg[0], qg[1]); w.y = pk2(qg[2], qg[3]); w.z = pk2(qg[4], qg[5]); w.w = pk2(qg[6], qg[7]);
        *(u32x4v*)(QGs + lane * 80 + 8 * wave) = w; *(u32x4v*)(gQG + lane * 64 + 8 * wave) = w;
        w.x = pk2(kg[0], kg[1]); w.y = pk2(kg[2], kg[3]); w.z = pk2(kg[4], kg[5]); w.w = pk2(kg[6], kg[7]);
        *(u32x4v*)(KGs + lane * 80 + 8 * wave) = w;
    }
    LDSBAR();
    {
        const int v = tid >> 2, ts = (tid & 3) * 16; float x[16];
#pragma unroll
        for (int e = 0; e < 16; ++e) x[e] = bf2f(Vs[(ts + e) * 136 + v]);
        u32x4v w; w.x = pk2(x[0], x[1]); w.y = pk2(x[2], x[3]); w.z = pk2(x[4], x[5]); w.w = pk2(x[6], x[7]);
        *(u32x4v*)(gUT + v * 64 + ts) = w;
        w.x = pk2(x[8], x[9]); w.y = pk2(x[10], x[11]); w.z = pk2(x[12], x[13]); w.w = pk2(x[14], x[15]);
        *(u32x4v*)(gUT + v * 64 + ts + 8) = w;
    }
#pragma unroll
    for (int r = 0; r < 2; ++r) {
        const int tl = wave + 8 * r, it = tl >> 2, jt = tl & 3;
        f32x4 acc = {0.f, 0.f, 0.f, 0.f};
        if (jt <= it) {
#pragma unroll
            for (int ks = 0; ks < 2; ++ks) acc = MFMA16(*(const bf16x8*)(KGs + (16 * jt + fr) * 80 + 32 * ks + 8 * fq), *(const bf16x8*)(QGs + (16 * it + fr) * 80 + 32 * ks + 8 * fq), acc);
        }
        const int i = 16 * it + fr; float o[4];
#pragma unroll
        for (int jj = 0; jj < 4; ++jj) { const int j = 16 * jt + 4 * fq + jj; o[jj] = (j <= i) ? acc[jj] : 0.f; }
        u32x2v w; w.x = pk2(o[0], o[1]); w.y = pk2(o[2], o[3]);
        *(u32x2v*)(gATT + i * 64 + 16 * jt + 4 * fq) = w;
    }
    LDSBAR();
}

__device__ __forceinline__ void pool_item(int item, const bf16* PROJ, const bf16* PWT, const float* pscale, bf16* Y, unsigned char* lds) {
    const int tid = fresh_tid(), wave = __builtin_amdgcn_readfirstlane(tid >> 6), lane = tid & 63, fr = lane & 15, fq = lane >> 4;
    const int g = item & 3, tile = item >> 2, b = tile >> 6, t0 = (tile & 63) * 64, win = 2 << g;
    float* Us = (float*)lds;
    bf16* As = (bf16*)(Us + 79 * 128);
    bf16* Bs = As + 64 * 144;
    {
        u32x4v ur[3], pr[4];
#pragma unroll
        for (int i = 0; i < 3; ++i) { const int p = tid + 512 * i, r = p >> 4, sg = p & 15, tt = t0 + r - 15;
            ur[i] = (u32x4v){0u, 0u, 0u, 0u};
            if (p < 79 * 16 && tt >= 0) ur[i] = *(const u32x4v*)(PROJ + ((size_t)b * T + tt) * INP + C_POOL + g * 128 + 8 * sg); }
#pragma unroll
        for (int i = 0; i < 4; ++i) { const int p = tid + 512 * i, r = p >> 4, sg = p & 15;
            pr[i] = *(const u32x4v*)(PWT + (size_t)g * 128 * 128 + r * 128 + 8 * sg); }
#pragma unroll
        for (int i = 0; i < 3; ++i) { const int p = tid + 512 * i, r = p >> 4, sg = p & 15;
            if (p < 79 * 16) { float* d = Us + r * 128 + 8 * sg; const u32x4v v = ur[i];
                *(f32x4*)d = (f32x4){bflo(v.x), bfhi(v.x), bflo(v.y), bfhi(v.y)}; *(f32x4*)(d + 4) = (f32x4){bflo(v.z), bfhi(v.z), bflo(v.w), bfhi(v.w)}; } }
#pragma unroll
        for (int i = 0; i < 4; ++i) { const int p = tid + 512 * i, r = p >> 4, sg = p & 15; *(u32x4v*)(Bs + r * 144 + 8 * sg) = pr[i]; }
    }
    LDSBAR();
    {
        const int c = tid & 127, tg = tid >> 7;
        float s = 0.f;
        for (int j = 1; j < win; ++j) s += Us[(15 + 16 * tg - j) * 128 + c];
#pragma unroll 4
        for (int e = 0; e < 16; ++e) { const int r = 15 + 16 * tg + e; const float u = Us[r * 128 + c]; s += u;
            const int cnt = min(t0 + 16 * tg + e + 1, win);
            As[(16 * tg + e) * 144 + c] = bf1(s * __builtin_amdgcn_rcpf((float)cnt) - u);
            s -= Us[(r - win + 1) * 128 + c]; }
    }
    LDSBAR();
    {
        f32x4 acc[4];
#pragma unroll
        for (int mt = 0; mt < 4; ++mt) acc[mt] = (f32x4){0.f, 0.f, 0.f, 0.f};
#pragma unroll
        for (int ks = 0; ks < 4; ++ks) { const bf16x8 bw = *(const bf16x8*)(Bs + (16 * wave + fr) * 144 + 32 * ks + 8 * fq);
#pragma unroll
            for (int mt = 0; mt < 4; ++mt) acc[mt] = MFMA16(bw, *(const bf16x8*)(As + (16 * mt + fr) * 144 + 32 * ks + 8 * fq), acc[mt]); }
        const f32x4 sc = *(const f32x4*)(pscale + g * 128 + 16 * wave + 4 * fq);
#pragma unroll
        for (int mt = 0; mt < 4; ++mt) { const f32x4 o = acc[mt] * sc; u32x2v w; w.x = pk2(o.x, o.y); w.y = pk2(o.z, o.w);
            *(u32x2v*)(Y + ((size_t)b * T + t0 + 16 * mt + fr) * D + 1024 + g * 128 + 16 * wave + 4 * fq) = w; }
    }
    LDSBAR();
}

__device__ __forceinline__ void vt_item(int item, const bf16* PROJ, bf16* VT, unsigned char* lds) {
    const int tid = fresh_tid();
    const int bh = item >> 6, n = item & 63, b = bh >> 2, h = bh & 3, t0 = n * 64;
    bf16* Vs = (bf16*)lds;
    {
        const int r = tid >> 3, sg = tid & 7;
        const bf16* src = PROJ + ((size_t)b * T + t0 + r) * INP + C_FOX_V + h * 128 + 16 * sg;
        const u32x4v v0 = *(const u32x4v*)src, v1 = *(const u32x4v*)(src + 8);
        *(u32x4v*)(Vs + r * 136 + 16 * sg) = v0; *(u32x4v*)(Vs + r * 136 + 16 * sg + 8) = v1;
    }
    LDSBAR();
    {
        const int v = tid >> 2, ts = (tid & 3) * 16; float x[16];
#pragma unroll
        for (int e = 0; e < 16; ++e) x[e] = bf2f(Vs[(ts + e) * 136 + v]);
        bf16* dst = VT + ((size_t)bh * 128 + v) * T + t0 + ts;
        u32x4v w; w.x = pk2(x[0], x[1]); w.y = pk2(x[2], x[3]); w.z = pk2(x[4], x[5]); w.w = pk2(x[6], x[7]);
        *(u32x4v*)dst = w;
        w.x = pk2(x[8], x[9]); w.y = pk2(x[10], x[11]); w.z = pk2(x[12], x[13]); w.w = pk2(x[14], x[15]);
        *(u32x4v*)(dst + 8) = w;
    }
    LDSBAR();
}
__device__ __forceinline__ void fcum_item(int b, const bf16* PROJ, const float* f_bias, float* FCUM, unsigned char* lds) {
    const int tid = fresh_tid(), wave = __builtin_amdgcn_readfirstlane(tid >> 6), lane = tid & 63;
    float* wt = (float*)lds;
    const float bb[4] = {f_bias[0], f_bias[1], f_bias[2], f_bias[3]};
    const bf16* base = PROJ + ((size_t)b * T + 8 * tid) * INP + C_FOX_F;
    u32x2v v[8];
#pragma unroll
    for (int e = 0; e < 8; ++e) v[e] = *(const u32x2v*)(base + (size_t)e * INP);
    float ls[8][4]; float run[4] = {0.f, 0.f, 0.f, 0.f};
#pragma unroll
    for (int e = 0; e < 8; ++e) {
        run[0] += logsigmoidf_(bflo(v[e].x) + bb[0]); run[1] += logsigmoidf_(bfhi(v[e].x) + bb[1]); run[2] += logsigmoidf_(bflo(v[e].y) + bb[2]); run[3] += logsigmoidf_(bfhi(v[e].y) + bb[3]);
        ls[e][0] = run[0]; ls[e][1] = run[1]; ls[e][2] = run[2]; ls[e][3] = run[3];
    }
    float off[4];
#pragma unroll
    for (int h = 0; h < 4; ++h) { const float inc = wave_iscan(run[h], lane); off[h] = inc - run[h]; if (lane == 63) wt[wave * 4 + h] = inc; }
    LDSBAR();
#pragma unroll
    for (int h = 0; h < 4; ++h) { float o = off[h];
        for (int w = 0; w < wave; ++w) o += wt[w * 4 + h];
        float* dst = FCUM + ((size_t)b * 4 + h) * T + 8 * tid;
        *(f32x4*)dst = (f32x4){o + ls[0][h], o + ls[1][h], o + ls[2][h], o + ls[3][h]};
        *(f32x4*)(dst + 4) = (f32x4){o + ls[4][h], o + ls[5][h], o + ls[6][h], o + ls[7][h]}; }
    LDSBAR();
}

template <int DK, bool DELTA>
__device__ __forceinline__ void scan_bh(int bh, const unsigned char* scr_base, size_t item_bytes, const float* dec, const bf16* PROJ, int gcol,
                                        const float* norm_w, bf16* Y, int ycol, unsigned char* lds) {
    const int tid = fresh_tid(), wave = __builtin_amdgcn_readfirstlane(tid >> 6), lane = tid & 63, fr = lane & 15, fq = lane >> 4;
    const int b = bh >> 2;
    constexpr int PQ = DK + 16;
    constexpr int NQ = DK / 64;
    constexpr size_t O_QG = 0, O_W = DELTA ? 16384 : 0, O_K2T = DELTA ? 32768 : 8192, O_UT = DELTA ? 49152 : 16384, O_ATT = DELTA ? 65536 : 32768;
    bf16* QGt = (bf16*)lds;
    bf16* Wt = QGt + 64 * PQ;
    bf16* K2Tt = Wt + 64 * PQ;
    bf16* ATTt = K2Tt + DK * 80;
    bf16* UTt = ATTt + 64 * 80;
    bf16* Gt = UTt + 128 * 80;
    float* DECt = (float*)(Gt + 64 * 136);
    float* PART = DECt + DK;
    float* RINV = PART + 512;
    f32x4 S[DK / 16];
#pragma unroll
    for (int kb = 0; kb < DK / 16; ++kb) S[kb] = (f32x4){0.f, 0.f, 0.f, 0.f};
    u32x4v rq[NQ], rw[NQ], rk[NQ], ra, ru[2]; float rdec = 0.f;
#define SCAN_ISSUE(n_) do { const unsigned char* it_ = scr_base + (size_t)(bh * 64 + (n_)) * item_bytes; \
        _Pragma("unroll") for (int i = 0; i < NQ; ++i) { rq[i] = *(const u32x4v*)(it_ + O_QG + (size_t)(tid + 512 * i) * 16); if (DELTA) rw[i] = *(const u32x4v*)(it_ + O_W + (size_t)(tid + 512 * i) * 16); \
            rk[i] = *(const u32x4v*)(it_ + O_K2T + (size_t)(tid + 512 * i) * 16); } \
        ra = *(const u32x4v*)(it_ + O_ATT + (size_t)tid * 16); \
        ru[0] = *(const u32x4v*)(it_ + O_UT + (size_t)tid * 16); ru[1] = *(const u32x4v*)(it_ + O_UT + (size_t)(tid + 512) * 16); \
        if (tid < DK) rdec = DELTA ? dec[bh * 64 + (n_)] : dec[(size_t)(bh * 64 + (n_)) * 64 + tid]; } while (0)
    SCAN_ISSUE(0);
    for (int n = 0; n < 64; ++n) {
        LDSBAR();
#pragma unroll
        for (int i = 0; i < NQ; ++i) { const int p = tid + 512 * i;
            { const int r = p / (DK / 8), cp = p % (DK / 8); lds_put_perm(QGt + r * PQ, 8 * cp, rq[i]); if (DELTA) lds_put_perm(Wt + r * PQ, 8 * cp, rw[i]); }
            { const int r = p >> 3, cp = p & 7; lds_put_perm(K2Tt + r * 80, 8 * cp, rk[i]); } }
        { const int r = tid >> 3, cp = tid & 7; lds_put_perm(ATTt + r * 80, 8 * cp, ra); }
#pragma unroll
        for (int i = 0; i < 2; ++i) { const int p = tid + 512 * i; const int r = p >> 3, cp = p & 7; *(u32x4v*)(UTt + r * 80 + 8 * cp) = ru[i]; }
        if (tid < DK) DECt[tid] = rdec;
        LDSBAR();
        if (n + 1 < 64) SCAN_ISSUE(n + 1);
        const size_t row0 = (size_t)b * T + n * 64;
        bf16x8 Sf[DK / 32];
#pragma unroll
        for (int ks = 0; ks < DK / 32; ++ks) Sf[ks] = pack8(S[2 * ks], S[2 * ks + 1]);
        f32x4 vn[4], o[4];
        bf16x8 f0[8], f1[8];
        u32x2v uu[4];
#pragma unroll
        for (int mt = 0; mt < 4; ++mt) { uu[mt] = *(const u32x2v*)(UTt + (16 * wave + fr) * 80 + 16 * mt + 4 * fq); o[mt] = (f32x4){0.f, 0.f, 0.f, 0.f}; }
        if (DELTA) {
            f32x4 P[4];
#pragma unroll
            for (int mt = 0; mt < 4; ++mt) P[mt] = (f32x4){0.f, 0.f, 0.f, 0.f};
#pragma unroll
            for (int q = 0; q < 8; ++q) f0[q] = afrag_lin(Wt + (16 * (q & 3) + fr) * PQ, 32 * (q >> 2), fq);
            SB();
#pragma unroll
            for (int q = 0; q < 8; ++q) f1[q] = afrag_lin(Wt + (16 * (q & 3) + fr) * PQ, 32 * (2 + (q >> 2)), fq);
            SB();
#pragma unroll
            for (int q = 0; q < 8; ++q) P[q & 3] = MFMA16(f0[q], Sf[q >> 2], P[q & 3]);
            SB();
#pragma unroll
            for (int q = 0; q < 8; ++q) f0[q] = afrag_lin(QGt + (16 * (q & 3) + fr) * PQ, 32 * (q >> 2), fq);
            SB();
#pragma unroll
            for (int q = 0; q < 8; ++q) P[q & 3] = MFMA16(f1[q], Sf[2 + (q >> 2)], P[q & 3]);
            SB();
#pragma unroll
            for (int q = 0; q < 8; ++q) f1[q] = afrag_lin(QGt + (16 * (q & 3) + fr) * PQ, 32 * (2 + (q >> 2)), fq);
            SB();
#pragma unroll
            for (int q = 0; q < 8; ++q) o[q & 3] = MFMA16(f0[q], Sf[q >> 2], o[q & 3]);
            SB();
#pragma unroll
            for (int q = 0; q < 8; ++q) f0[q] = afrag_lin(ATTt + (16 * (q & 3) + fr) * 80, 32 * (q >> 2), fq);
            SB();
#pragma unroll
            for (int q = 0; q < 8; ++q) o[q & 3] = MFMA16(f1[q], Sf[2 + (q >> 2)], o[q & 3]);
#pragma unroll
            for (int mt = 0; mt < 4; ++mt) vn[mt] = (f32x4){bflo(uu[mt].x), bfhi(uu[mt].x), bflo(uu[mt].y), bfhi(uu[mt].y)} - P[mt];
        } else {
#pragma unroll
            for (int q = 0; q < 8; ++q) f1[q] = afrag_lin(QGt + (16 * (q & 3) + fr) * PQ, 32 * (q >> 2), fq);
            SB();
#pragma unroll
            for (int q = 0; q < 8; ++q) f0[q] = afrag_lin(ATTt + (16 * (q & 3) + fr) * 80, 32 * (q >> 2), fq);
            SB();
#pragma unroll
            for (int q = 0; q < 8; ++q) o[q & 3] = MFMA16(f1[q], Sf[q >> 2], o[q & 3]);
#pragma unroll
            for (int mt = 0; mt < 4; ++mt) vn[mt] = (f32x4){bflo(uu[mt].x), bfhi(uu[mt].x), bflo(uu[mt].y), bfhi(uu[mt].y)};
        }
        bf16x8 Vf[2];
        Vf[0] = pack8(vn[0], vn[1]); Vf[1] = pack8(vn[2], vn[3]);
        SB();
        constexpr int NKB = DK / 16, KG = (NKB * 2) / 8;
#pragma unroll
        for (int q = 0; q < 8; ++q) { const int t = q, kb = t % NKB, k2 = t / NKB; f1[q] = afrag_lin(K2Tt + (16 * kb + fr) * 80, 32 * k2, fq); }
        SB();
#pragma unroll
        for (int q = 0; q < 8; ++q) o[q & 3] = MFMA16(f0[q], Vf[q >> 2], o[q & 3]);
#pragma unroll
        for (int kb = 0; kb < NKB; ++kb) S[kb] = S[kb] * *(const f32x4*)(DECt + 16 * kb + 4 * fq);
        SB();
        if (KG == 2) {
#pragma unroll
            for (int q = 0; q < 8; ++q) { const int t = 8 + q, kb = t % NKB, k2 = t / NKB; f0[q] = afrag_lin(K2Tt + (16 * kb + fr) * 80, 32 * k2, fq); }
            SB();
        }
#pragma unroll
        for (int q = 0; q < 8; ++q) { const int t = q, kb = t % NKB, k2 = t / NKB; S[kb] = MFMA16(f1[q], Vf[k2], S[kb]); }
        if (KG == 2) {
            SB();
#pragma unroll
            for (int q = 0; q < 8; ++q) { const int t = 8 + q, kb = t % NKB, k2 = t / NKB; S[kb] = MFMA16(f0[q], Vf[k2], S[kb]); }
        }
#pragma unroll
        for (int mt = 0; mt < 4; ++mt)
#pragma unroll
            for (int j = 0; j < 4; ++j) Y[(row0 + 16 * mt + 4 * fq + j) * D + ycol + 16 * wave + fr] = bf1(o[mt][j]);
    }
#undef SCAN_ISSUE
    __syncthreads();
}

__device__ __forceinline__ void phase_mixnorm(const bf16* PROJ, const float* gla_norm, const float* gdn_norm, bf16* Y) {
    const int tid_ = fresh_tid(), wave = __builtin_amdgcn_readfirstlane(tid_ >> 6), lane = tid_ & 63;
    const int gw = fresh_bid() * 8 + wave, NGW = gridDim.x * 8;
    const int hh = lane >> 3, c16 = (lane & 7) * 16;
    const float* nw = (hh < 4 ? gla_norm : gdn_norm) + c16;
    float nwv[16];
#pragma unroll
    for (int e = 0; e < 16; e += 4) *(f32x4*)(nwv + e) = *(const f32x4*)(nw + e);
    const int gcol = (hh < 4 ? C_GLA_G : C_GDN_G) + (hh & 3) * 128 + c16;
#define MIX_LOAD(m_, Y0, Y1, G0, G1) do { const bf16* yp_ = Y + (size_t)(m_) * D + 16 * lane; const bf16* gp_ = PROJ + (size_t)(m_) * INP + gcol; \
        Y0 = *(const u32x4v*)yp_; Y1 = *(const u32x4v*)(yp_ + 8); G0 = *(const u32x4v*)gp_; G1 = *(const u32x4v*)(gp_ + 8); } while (0)
#define MIX_DO(m_, y0, y1, g0, g1) do { \
        float o[16], g[16]; \
        o[0] = bflo(y0.x); o[1] = bfhi(y0.x); o[2] = bflo(y0.y); o[3] = bfhi(y0.y); o[4] = bflo(y0.z); o[5] = bfhi(y0.z); o[6] = bflo(y0.w); o[7] = bfhi(y0.w); \
        o[8] = bflo(y1.x); o[9] = bfhi(y1.x); o[10] = bflo(y1.y); o[11] = bfhi(y1.y); o[12] = bflo(y1.z); o[13] = bfhi(y1.z); o[14] = bflo(y1.w); o[15] = bfhi(y1.w); \
        g[0] = bflo(g0.x); g[1] = bfhi(g0.x); g[2] = bflo(g0.y); g[3] = bfhi(g0.y); g[4] = bflo(g0.z); g[5] = bfhi(g0.z); g[6] = bflo(g0.w); g[7] = bfhi(g0.w); \
        g[8] = bflo(g1.x); g[9] = bfhi(g1.x); g[10] = bflo(g1.y); g[11] = bfhi(g1.y); g[12] = bflo(g1.z); g[13] = bfhi(g1.z); g[14] = bflo(g1.w); g[15] = bfhi(g1.w); \
        float ss = 0.f; \
        _Pragma("unroll") for (int e = 0; e < 16; ++e) ss += o[e] * o[e]; \
        ss += DPPF(ss, 0xB1, 0xf, false); ss += DPPF(ss, 0x4E, 0xf, false); ss += DPPF(ss, 0x141, 0xf, false);     \
        const float rinv = rsqrtf(ss * (1.f / 128.f) + EPS); \
        float y[16]; \
        _Pragma("unroll") for (int e = 0; e < 16; ++e) y[e] = o[e] * rinv * nwv[e] * siluf_(g[e]); \
        bf16* yp = Y + (size_t)(m_) * D + 16 * lane; \
        u32x4v w; w.x = pk2(y[0], y[1]); w.y = pk2(y[2], y[3]); w.z = pk2(y[4], y[5]); w.w = pk2(y[6], y[7]); \
        *(u32x4v*)yp = w; \
        w.x = pk2(y[8], y[9]); w.y = pk2(y[10], y[11]); w.z = pk2(y[12], y[13]); w.w = pk2(y[14], y[15]); \
        *(u32x4v*)(yp + 8) = w; } while (0)
    if (gw >= M) return;
    u32x4v ay0, ay1, ag0, ag1, by0, by1, bg0, bg1;
    MIX_LOAD(gw, ay0, ay1, ag0, ag1);
    for (int m = gw; m < M; m += 2 * NGW) {
        const bool hb = m + NGW < M, ha = m + 2 * NGW < M;
        if (hb) MIX_LOAD(m + NGW, by0, by1, bg0, bg1);
        MIX_DO(m, ay0, ay1, ag0, ag1);
        if (ha) MIX_LOAD(m + 2 * NGW, ay0, ay1, ag0, ag1);
        if (hb) MIX_DO(m + NGW, by0, by1, bg0, bg1);
    }
#undef MIX_LOAD
#undef MIX_DO
}

__device__ __forceinline__ void fox_item(int idx, const bf16* PROJ, const bf16* VT, const float* FCUM, bf16* Y, unsigned char* lds) {
    const int tid = fresh_tid(), wave = __builtin_amdgcn_readfirstlane(tid >> 6), lane = tid & 63, fr = lane & 15, fq = lane >> 4;
    const int qb = 31 - (idx >> 4), bh = idx & 15, b = bh >> 2, h = bh & 3, q0 = qb * 128;
    constexpr int FOXBUF = 64 * 144 * 2 + 128 * 80 * 2 + 256;
    const int qrow = q0 + 16 * wave + fr;
    bf16x8 Qf[4];
    {
        const bf16* qp = PROJ + ((size_t)b * T + qrow) * INP + C_FOX_Q + h * 128 + 8 * fq;
        const float sc = 0.08838834764831845f * LOG2E;
#pragma unroll
        for (int ks = 0; ks < 4; ++ks) { const u32x4v v = *(const u32x4v*)(qp + 32 * ks); u32x4v w;
            w.x = pk2(bflo(v.x) * sc, bfhi(v.x) * sc); w.y = pk2(bflo(v.y) * sc, bfhi(v.y) * sc); w.z = pk2(bflo(v.z) * sc, bfhi(v.z) * sc); w.w = pk2(bflo(v.w) * sc, bfhi(v.w) * sc);
            Qf[ks] = __builtin_bit_cast(bf16x8, w); }
    }
    const float* Fb = FCUM + (size_t)bh * T;
    const float Fref = Fb[q0];
    const int ntile = (q0 + 128) / 64;
    f32x4 O[8];
#pragma unroll
    for (int dt = 0; dt < 8; ++dt) O[dt] = (f32x4){0.f, 0.f, 0.f, 0.f};
    float mrun = -INFINITY, lsum = 0.f;
    u32x4v rkA[2], rvA[2], rkB[2], rvB[2]; float rfA = 0.f, rfB = 0.f;
#define FOX_ISSUE(kt_, rk, rv, rf) do { const int k0_ = (kt_) * 64; \
        _Pragma("unroll") for (int i = 0; i < 2; ++i) { const int p_ = tid + 512 * i; \
            rk[i] = *(const u32x4v*)(PROJ + ((size_t)b * T + k0_ + (p_ >> 4)) * INP + C_FOX_K + h * 128 + 8 * (p_ & 15)); \
            rv[i] = *(const u32x4v*)(VT + ((size_t)bh * 128 + (p_ >> 3)) * T + k0_ + 8 * (p_ & 7)); } \
        if (tid < 64) rf = (Fref - Fb[k0_ + tid]) * LOG2E; } while (0)
#define FOX_PUT(buf_, rk, rv, rf) do { bf16* Kw_ = (bf16*)(lds + (buf_) * FOXBUF); bf16* Vw_ = Kw_ + 64 * 144; float* Fw_ = (float*)(Vw_ + 128 * 80); \
        _Pragma("unroll") for (int i = 0; i < 2; ++i) { const int p_ = tid + 512 * i; \
            *(u32x4v*)(Kw_ + (p_ >> 4) * 144 + 8 * (p_ & 15)) = rk[i]; lds_put_perm(Vw_ + (p_ >> 3) * 80, 8 * (p_ & 7), rv[i]); } \
        if (tid < 64) Fw_[tid] = rf; } while (0)
#define FOX_STEP(kt_, rk, rv, rf) do { \
        if ((kt_) + 1 < ntile) FOX_PUT(((kt_) + 1) & 1, rk, rv, rf); \
        if ((kt_) + 3 < ntile) FOX_ISSUE((kt_) + 3, rk, rv, rf); \
        const bf16* Kt = (const bf16*)(lds + ((kt_) & 1) * FOXBUF); const bf16* VTt = Kt + 64 * 144; const float* Ft = (const float*)(VTt + 128 * 80); \
        const int k0 = (kt_) * 64; \
        if (k0 <= q0 + 16 * wave + 15) { \
            f32x4 s[4]; bf16x8 fa[8], fb[8]; \
            _Pragma("unroll") for (int q = 0; q < 8; ++q) fa[q] = *(const bf16x8*)(Kt + (16 * (q & 3) + fr) * 144 + 32 * (q >> 2) + 8 * fq); \
            SB(); \
            _Pragma("unroll") for (int q = 0; q < 8; ++q) fb[q] = *(const bf16x8*)(Kt + (16 * (q & 3) + fr) * 144 + 32 * (2 + (q >> 2)) + 8 * fq); \
            _Pragma("unroll") for (int t4 = 0; t4 < 4; ++t4) s[t4] = *(const f32x4*)(Ft + 16 * t4 + 4 * fq); \
            SB(); \
            _Pragma("unroll") for (int q = 0; q < 8; ++q) s[q & 3] = MFMA16(fa[q], Qf[q >> 2], s[q & 3]); \
            SB(); \
            _Pragma("unroll") for (int q = 0; q < 8; ++q) fa[q] = afrag_lin(VTt + (16 * q + fr) * 80, 0, fq); \
            SB(); \
            _Pragma("unroll") for (int q = 0; q < 8; ++q) s[q & 3] = MFMA16(fb[q], Qf[2 + (q >> 2)], s[q & 3]); \
            SB(); \
            _Pragma("unroll") for (int q = 0; q < 8; ++q) fb[q] = afrag_lin(VTt + (16 * q + fr) * 80, 32, fq); \
            SB(); \
            if (k0 + 63 > q0 + 16 * wave) { \
                _Pragma("unroll") for (int t4 = 0; t4 < 4; ++t4) \
                    _Pragma("unroll") for (int j = 0; j < 4; ++j) if (k0 + 16 * t4 + 4 * fq + j > qrow) s[t4][j] = -INFINITY; \
            } \
            float mx = -INFINITY; \
            _Pragma("unroll") for (int t4 = 0; t4 < 4; ++t4) mx = fmaxf(fmaxf(mx, fmaxf(s[t4][0], s[t4][1])), fmaxf(s[t4][2], s[t4][3])); \
            mx = fmaxf(mx, __shfl_xor(mx, 16)); mx = fmaxf(mx, __shfl_xor(mx, 32)); \
            const float mnew = fmaxf(mrun, mx); \
            const float alpha = __builtin_amdgcn_exp2f(mrun - mnew); \
            mrun = mnew; \
            float ps = 0.f; \
            _Pragma("unroll") for (int t4 = 0; t4 < 4; ++t4) \
                _Pragma("unroll") for (int j = 0; j < 4; ++j) { const float p = __builtin_amdgcn_exp2f(s[t4][j] - mnew); s[t4][j] = p; ps += p; } \
            lsum = lsum * alpha + ps; \
            bf16x8 Pf[2]; \
            Pf[0] = pack8(s[0], s[1]); Pf[1] = pack8(s[2], s[3]); \
            _Pragma("unroll") for (int dt = 0; dt < 8; ++dt) O[dt] = O[dt] * alpha; \
            _Pragma("unroll") for (int dt = 0; dt < 8; ++dt) O[dt] = MFMA16(fa[dt], Pf[0], O[dt]); \
            _Pragma("unroll") for (int dt = 0; dt < 8; ++dt) O[dt] = MFMA16(fb[dt], Pf[1], O[dt]); \
        } \
        LDSBAR(); } while (0)
    FOX_ISSUE(0, rkA, rvA, rfA);
    FOX_ISSUE(1, rkB, rvB, rfB);
    FOX_PUT(0, rkA, rvA, rfA);
    if (2 < ntile) FOX_ISSUE(2, rkA, rvA, rfA);
    LDSBAR();
    for (int kt = 0; kt < ntile; kt += 2) {
        FOX_STEP(kt, rkB, rvB, rfB);
        FOX_STEP(kt + 1, rkA, rvA, rfA);
    }
#undef FOX_ISSUE
#undef FOX_STEP
#undef FOX_PUT
    lsum += __shfl_xor(lsum, 16); lsum += __shfl_xor(lsum, 32);
    const float inv = 1.f / lsum;
    bf16* yp = Y + ((size_t)b * T + qrow) * D + 1536 + h * 128 + 4 * fq;
#pragma unroll
    for (int dt = 0; dt < 8; ++dt) { const f32x4 o = O[dt] * inv; u32x2v w; w.x = pk2(o.x, o.y); w.y = pk2(o.z, o.w); *(u32x2v*)(yp + 16 * dt) = w; }
    __syncthreads();
}

__device__ __forceinline__ void phase_act(const bf16* GU, const float* cw, const float* cb, bf16* ACT) {
    const size_t gt = (size_t)fresh_bid() * 512 + fresh_tid(), GT = (size_t)gridDim.x * 512;
    constexpr int NCG = DFF / 8, RUN = 32;
    for (size_t idx = gt; idx < (size_t)NCG * (M / RUN); idx += GT) {
        const int cgp = (int)(idx % NCG), run = (int)(idx / NCG), r0 = run * RUN, c0 = cgp * 8;
        float w0[8], w1[8], w2[8], bb[8];
#pragma unroll
        for (int e = 0; e < 8; e += 4) { *(f32x4*)(w0 + e) = *(const f32x4*)(cw + c0 + e); *(f32x4*)(w1 + e) = *(const f32x4*)(cw + DFF + c0 + e);
            *(f32x4*)(w2 + e) = *(const f32x4*)(cw + 2 * DFF + c0 + e); *(f32x4*)(bb + e) = *(const f32x4*)(cb + c0 + e); }
        u32x4v g2 = {0u, 0u, 0u, 0u}, g1 = g2;
        if ((r0 % T) != 0) { g2 = *(const u32x4v*)(GU + (size_t)(r0 - 2) * (2 * DFF) + c0); g1 = *(const u32x4v*)(GU + (size_t)(r0 - 1) * (2 * DFF) + c0); }
#pragma unroll 4
        for (int r = r0; r < r0 + RUN; ++r) {
            const u32x4v g = *(const u32x4v*)(GU + (size_t)r * (2 * DFF) + c0), u = *(const u32x4v*)(GU + (size_t)r * (2 * DFF) + DFF + c0);
            u32x4v o;
#define ACT2(k, fld) { const float a0 = w0[2 * k] * bflo(g2.fld) + w1[2 * k] * bflo(g1.fld) + w2[2 * k] * bflo(g.fld) + bb[2 * k]; \
                       const float a1 = w0[2 * k + 1] * bfhi(g2.fld) + w1[2 * k + 1] * bfhi(g1.fld) + w2[2 * k + 1] * bfhi(g.fld) + bb[2 * k + 1]; \
                       o.fld = pk2(siluf_(a0) * bflo(u.fld), siluf_(a1) * bfhi(u.fld)); }
            ACT2(0, x) ACT2(1, y) ACT2(2, z) ACT2(3, w)
#undef ACT2
            *(u32x4v*)(ACT + (size_t)r * DFF + c0) = o;
            g2 = g1; g1 = g;
        }
    }
}

__device__ __forceinline__ void phase_actfix(const float* GLAST, const float* GFIRST, const float* UFIRST, const float* cw, const float* cb, bf16* ACTp) {
    const int gt = fresh_bid() * 512 + fresh_tid(), GT = gridDim.x * 512;
    constexpr int NCG = DFF / 8;
    for (int idx = gt; idx < NCG * 2 * (M / 256); idx += GT) {
        const int cgp = idx % NCG, ri = idx / NCG, i = ri & 1, pm = ri >> 1, c0 = cgp * 8;
        const bool first = (pm % (T / 256)) == 0;
        float g[8], u[8], g1[8], g2[8];
#pragma unroll
        for (int e = 0; e < 8; e += 4) {
            *(f32x4*)(g + e) = *(const f32x4*)(GFIRST + (size_t)(pm * 2 + i) * DFF + c0 + e);
            *(f32x4*)(u + e) = *(const f32x4*)(UFIRST + (size_t)(pm * 2 + i) * DFF + c0 + e);
            const f32x4 z = {0.f, 0.f, 0.f, 0.f};
            const f32x4 l1 = first ? z : *(const f32x4*)(GLAST + (size_t)((pm - 1) * 2 + 1) * DFF + c0 + e);
            const f32x4 l0 = first ? z : *(const f32x4*)(GLAST + (size_t)((pm - 1) * 2 + 0) * DFF + c0 + e);
            const f32x4 f0 = *(const f32x4*)(GFIRST + (size_t)(pm * 2 + 0) * DFF + c0 + e);
            *(f32x4*)(g1 + e) = (i == 1) ? f0 : l1;
            *(f32x4*)(g2 + e) = (i == 1) ? l1 : l0;
        }
        float o[8];
#pragma unroll
        for (int e = 0; e < 8; ++e) { const float a = cw[c0 + e] * g2[e] + cw[DFF + c0 + e] * g1[e] + cw[2 * DFF + c0 + e] * g[e] + cb[c0 + e]; o[e] = siluf_(a) * u[e]; }
        u32x4v w; w.x = pk2(o[0], o[1]); w.y = pk2(o[2], o[3]); w.z = pk2(o[4], o[5]); w.w = pk2(o[6], o[7]);
        *(u32x4v*)(ACTp + (size_t)(pm * 256 + i) * DFF + c0) = w;
    }
}

__device__ __forceinline__ void actfix_tile(int pm, const float* GLAST, const float* GFIRST, const float* UFIRST, const float* cw, const float* cb, bf16* ACTp) {
    const int tid = fresh_tid();
    constexpr int NCG = DFF / 8;
    const bool first = (pm % (T / 256)) == 0;
    for (int idx = tid; idx < 2 * NCG; idx += 512) {
        const int cgp = idx % NCG, i = idx / NCG, c0 = cgp * 8;
        unsigned pk[4];
#pragma unroll
        for (int h2 = 0; h2 < 2; ++h2) {
            const int c = c0 + 4 * h2;
            const f32x4 z = {0.f, 0.f, 0.f, 0.f};
            const f32x4 g = *(const f32x4*)(GFIRST + (size_t)(pm * 2 + i) * DFF + c), u = *(const f32x4*)(UFIRST + (size_t)(pm * 2 + i) * DFF + c);
            const f32x4 l1 = first ? z : *(const f32x4*)(GLAST + (size_t)((pm - 1) * 2 + 1) * DFF + c);
            const f32x4 l0 = first ? z : *(const f32x4*)(GLAST + (size_t)((pm - 1) * 2 + 0) * DFF + c);
            const f32x4 f0 = *(const f32x4*)(GFIRST + (size_t)(pm * 2 + 0) * DFF + c);
            const f32x4 g1 = (i == 1) ? f0 : l1, g2 = (i == 1) ? l1 : l0;
            const f32x4 w0 = *(const f32x4*)(cw + c), w1 = *(const f32x4*)(cw + DFF + c), w2 = *(const f32x4*)(cw + 2 * DFF + c), bb = *(const f32x4*)(cb + c);
            const f32x4 a = w0 * g2 + w1 * g1 + w2 * g + bb;
            const f32x4 o = {siluf_(a.x) * u.x, siluf_(a.y) * u.y, siluf_(a.z) * u.z, siluf_(a.w) * u.w};
            pk[2 * h2] = pk2(o.x, o.y); pk[2 * h2 + 1] = pk2(o.z, o.w);
        }
        u32x4v w; w.x = pk[0]; w.y = pk[1]; w.z = pk[2]; w.w = pk[3];
        *(u32x4v*)(ACTp + (size_t)(pm * 256 + i) * DFF + c0) = w;
    }
}

#ifndef GEMM_ALIGN
#define GEMM_ALIGN true
#endif
#ifndef GEMM_SP2
#define GEMM_SP2 true
#endif
#ifndef WGM_IN
#define WGM_IN 4
#endif
#ifndef WGM_OUT
#define WGM_OUT 4
#endif
#ifndef WGM_GU
#define WGM_GU 4
#endif
#ifndef WGM_DN
#define WGM_DN 4
#endif
#ifndef CREP
#define CREP 1
#endif
#ifndef CLO
#define CLO 0
#define CHI 0
#endif
#ifndef SREP
#define SREP 1
#endif
#ifndef FREP
#define FREP 1
#endif
struct Args { const float* in[24]; float* out; unsigned char* ws; };
enum { I_X = 0, I_C, I_WMOD, I_BMOD, I_NMIX, I_NFFN, I_WIN, I_GLAWLR, I_GLABLR, I_GLANORM, I_GDNCONV, I_GDNALOG, I_GDNDT, I_GDNNORM,
       I_POOLW, I_POOLSC, I_FOXB, I_WOUT, I_WGATE, I_WUP, I_FCW, I_FCB, I_WDOWN, I_NFINAL };

typedef const Args __attribute__((address_space(4)))* KArgsP;
__device__ __forceinline__ KArgsP fresh_args() { KArgsP p = (KArgsP)__builtin_amdgcn_kernarg_segment_ptr(); asm volatile("" : "+s"(p)); return p; }
#define KA fresh_args()
#define ws (KA->ws)
#define MOD ((float*)(ws + WS_MOD))
#define FCUM ((float*)(ws + WS_FCUM))
#define GLADEC ((float*)(ws + WS_GLADEC))
#define GDNDEC ((float*)(ws + WS_GDNDEC))
#define PWT ((bf16*)(ws + WS_PWT))
#define H ((bf16*)(ws + WS_H))
#define ACT ((bf16*)(ws + WS_ACT))
#define PROJ ((bf16*)(ws + WS_PROJ))
#define Y ((bf16*)(ws + WS_Y))
#define GU ((bf16*)(ws + WS_GU))
#define VT ((bf16*)(ws + WS_VT))
__global__ void __launch_bounds__(512, 2) mk_fwd(Args a) {
    extern __shared__ __attribute__((aligned(16))) unsigned char lds[];
#ifdef TEST_NOSYNC
    struct { __device__ void sync() const { __syncthreads(); } } grid;
#else
    cg::grid_group grid = cg::this_grid();
#endif
    const int G = gridDim.x;
#define bx fresh_bid()
    {
        volatile LAS unsigned* bst = (volatile LAS unsigned*)((LAS unsigned char*)lds + (LDS_BYTES - 64));
        if (threadIdx.x < 2) bst[threadIdx.x] = 0u;
        __syncthreads();
        (void)xcd_barrier_post((unsigned*)ws, bst);
    }
#define GSYNC() do { XcdBarrier b_; b_.bar = (unsigned*)ws; b_.x = xb_xcc_id(); b_.st = (volatile LAS unsigned*)((LAS unsigned char*)lds + (LDS_BYTES - 64)); xcd_barrier(b_); } while (0)
    PG8_LAS unsigned char* gl = (PG8_LAS unsigned char*)lds;

#ifndef NO_MOD
    phase_mod(KA->in[I_C], KA->in[I_WMOD], KA->in[I_BMOD], MOD, lds);
#endif
    if (KA->out == nullptr) grid.sync();
    GSYNC();
#ifdef TEST_NOLOOP
    for (int l = 0; l < 1; ++l) {
#else
#pragma unroll
    for (int l = 0; l < NL; ++l) {
#endif
        const float* modl = MOD + (size_t)l * NB * MODW;
        const float* xin = (l == 0) ? KA->in[I_X] : KA->out;
        {
            LayerW L{KA->in[I_WIN] + (size_t)l * D * INW, KA->in[I_WOUT] + (size_t)l * D * D, KA->in[I_WGATE] + (size_t)l * D * DFF, KA->in[I_WUP] + (size_t)l * D * DFF,
                     KA->in[I_WDOWN] + (size_t)l * DFF * D, KA->in[I_POOLW] + (size_t)l * 4 * 128 * 128};
#ifndef NO_TR
            phase_transpose(L, ws, lds, 0, 0, G);
#endif
            phase_norm(xin, KA->in[I_NMIX] + (size_t)l * D, modl, 0, 1, H);
        }
        GSYNC();
#ifdef DUP_A
        {
            LayerW L{KA->in[I_WIN] + (size_t)l * D * INW, KA->in[I_WOUT] + (size_t)l * D * D, KA->in[I_WGATE] + (size_t)l * D * DFF, KA->in[I_WUP] + (size_t)l * D * DFF,
                     KA->in[I_WDOWN] + (size_t)l * DFF * D, KA->in[I_POOLW] + (size_t)l * 4 * 128 * 128};
#ifndef NO_TR
            phase_transpose(L, ws, lds, 0, 0, G);
#endif
            phase_norm(xin, KA->in[I_NMIX] + (size_t)l * D, modl, 0, 1, H);
        }
        GSYNC();
#endif
        {
            pg8::Gemm g{H, (const bf16*)(ws + WS_WIN), M, INP, D}; pg8::StaticOrder S; S.init(M, INP, G, bx, WGM_IN);
            pg8::EpiStoreBf16 E{PROJ, INP};
#ifndef NO_GEMM0
            pg8::gemm_phase<pg8::EpiStoreBf16, pg8::StaticOrder, GEMM_ALIGN, GEMM_SP2>(gl, g, S, E);
#endif
        }
        GSYNC();
#ifdef DUP_B
        {
            pg8::Gemm g{H, (const bf16*)(ws + WS_WIN), M, INP, D}; pg8::StaticOrder S; S.init(M, INP, G, bx, WGM_IN);
            pg8::EpiStoreBf16 E{PROJ, INP};
#ifndef NO_GEMM0
            pg8::gemm_phase<pg8::EpiStoreBf16, pg8::StaticOrder, GEMM_ALIGN, GEMM_SP2>(gl, g, S, E);
#endif
        }
        GSYNC();
#endif
        {
            const float* conv_w = KA->in[I_GDNCONV] + (size_t)l * 4 * 1536;
            for (int rep_ = 0; rep_ < CREP; ++rep_)
            for (int it = bx; it < 4100; it += G) {
                if (rep_ > 0 && !(it >= CLO && it < CHI)) continue;
#ifndef NO_GDNP
                if (it < 1024) gdn_prep_item(it, PROJ, conv_w, KA->in[I_GDNALOG] + l * 4, KA->in[I_GDNDT] + l * 4, ws + WS_GDN, GDNDEC, lds);
                else
#endif
#ifndef NO_GLAP
                if (it < 2048) gla_prep_item(it - 1024, PROJ, KA->in[I_GLAWLR] + (size_t)l * 16 * 256, KA->in[I_GLABLR] + (size_t)l * 256, ws + WS_GLA, GLADEC, lds);
                else
#endif
#ifndef NO_POOL
                if (it < 3072) pool_item(it - 2048, PROJ, PWT, KA->in[I_POOLSC] + (size_t)l * 512, Y, lds);
                else
#endif
                if (it < 4096) vt_item(it - 3072, PROJ, VT, lds);
                else fcum_item(it - 4096, PROJ, KA->in[I_FOXB] + l * 4, FCUM, lds);
            }
        }
        GSYNC();
#ifdef DUP_C
        {
            const float* conv_w = KA->in[I_GDNCONV] + (size_t)l * 4 * 1536;
            for (int rep_ = 0; rep_ < CREP; ++rep_)
            for (int it = bx; it < 4100; it += G) {
                if (rep_ > 0 && !(it >= CLO && it < CHI)) continue;
#ifndef NO_GDNP
                if (it < 1024) gdn_prep_item(it, PROJ, conv_w, KA->in[I_GDNALOG] + l * 4, KA->in[I_GDNDT] + l * 4, ws + WS_GDN, GDNDEC, lds);
                else
#endif
#ifndef NO_GLAP
                if (it < 2048) gla_prep_item(it - 1024, PROJ, KA->in[I_GLAWLR] + (size_t)l * 16 * 256, KA->in[I_GLABLR] + (size_t)l * 256, ws + WS_GLA, GLADEC, lds);
                else
#endif
#ifndef NO_POOL
                if (it < 3072) pool_item(it - 2048, PROJ, PWT, KA->in[I_POOLSC] + (size_t)l * 512, Y, lds);
                else
#endif
                if (it < 4096) vt_item(it - 3072, PROJ, VT, lds);
                else fcum_item(it - 4096, PROJ, KA->in[I_FOXB] + l * 4, FCUM, lds);
            }
        }
        GSYNC();
#endif
        {
            for (int rep_ = 0; rep_ < SREP; ++rep_)
            for (int s = bx; s < 32; s += G) {
#ifndef NO_SCAN
                if (s < 16) scan_bh<128, true>(s, ws + WS_GDN, GDN_ITEM, GDNDEC, PROJ, C_GDN_G + (s & 3) * 128, KA->in[I_GDNNORM] + (size_t)l * 128, Y, 512 + (s & 3) * 128, lds);
                else scan_bh<64, false>(s - 16, ws + WS_GLA, GLA_ITEM, GLADEC, PROJ, C_GLA_G + (s & 3) * 128, KA->in[I_GLANORM] + (size_t)l * 128, Y, (s & 3) * 128, lds);
#endif
            }
            const int NA = (G > 32) ? G - 32 : G, ab = (G > 32) ? bx - 32 : bx;
            for (int rep_ = 0; rep_ < FREP; ++rep_)
            if (ab >= 0 && NA == 224) {
                const int fbh = ab & 15, slot = ab >> 4;
                const int n_it = (slot < 13) ? 2 : 6;
                for (int k = 0; k < n_it; ++k) {
                    const int qbk = (slot < 13) ? ((k == 0) ? 31 - slot : 5 + slot) : ((k == 0) ? 18 : 5 - k);
                    fox_item((31 - qbk) * 16 + fbh, PROJ, VT, FCUM, Y, lds);
                }
            } else
            if (ab >= 0) for (int r = 0;; ++r) { const int idx = r * NA + ((r & 1) ? NA - 1 - ab : ab); if (r * NA >= 512) break;
#ifndef NO_FOX
 if (idx < 512) fox_item(idx, PROJ, VT, FCUM, Y, lds);
#endif
 }
            {
                LayerW L{KA->in[I_WIN] + (size_t)l * D * INW, KA->in[I_WOUT] + (size_t)l * D * D, KA->in[I_WGATE] + (size_t)l * D * DFF, KA->in[I_WUP] + (size_t)l * D * DFF,
                         KA->in[I_WDOWN] + (size_t)l * DFF * D, KA->in[I_POOLW] + (size_t)l * 4 * 128 * 128};
                if (G > 32) phase_transpose(L, ws, lds, 1, 32, G - 32); else phase_transpose(L, ws, lds, 1, 0, G);
            }
        }
        GSYNC();
#ifdef DUP_D
        {
            for (int rep_ = 0; rep_ < SREP; ++rep_)
            for (int s = bx; s < 32; s += G) {
#ifndef NO_SCAN
                if (s < 16) scan_bh<128, true>(s, ws + WS_GDN, GDN_ITEM, GDNDEC, PROJ, C_GDN_G + (s & 3) * 128, KA->in[I_GDNNORM] + (size_t)l * 128, Y, 512 + (s & 3) * 128, lds);
                else scan_bh<64, false>(s - 16, ws + WS_GLA, GLA_ITEM, GLADEC, PROJ, C_GLA_G + (s & 3) * 128, KA->in[I_GLANORM] + (size_t)l * 128, Y, (s & 3) * 128, lds);
#endif
            }
            const int NA = (G > 32) ? G - 32 : G, ab = (G > 32) ? bx - 32 : bx;
            for (int rep_ = 0; rep_ < FREP; ++rep_)
            if (ab >= 0 && NA == 224) {
                const int fbh = ab & 15, slot = ab >> 4;
                const int n_it = (slot < 13) ? 2 : 6;
                for (int k = 0; k < n_it; ++k) {
                    const int qbk = (slot < 13) ? ((k == 0) ? 31 - slot : 5 + slot) : ((k == 0) ? 18 : 5 - k);
                    fox_item((31 - qbk) * 16 + fbh, PROJ, VT, FCUM, Y, lds);
                }
            } else
            if (ab >= 0) for (int r = 0;; ++r) { const int idx = r * NA + ((r & 1) ? NA - 1 - ab : ab); if (r * NA >= 512) break;
#ifndef NO_FOX
 if (idx < 512) fox_item(idx, PROJ, VT, FCUM, Y, lds);
#endif
 }
            {
                LayerW L{KA->in[I_WIN] + (size_t)l * D * INW, KA->in[I_WOUT] + (size_t)l * D * D, KA->in[I_WGATE] + (size_t)l * D * DFF, KA->in[I_WUP] + (size_t)l * D * DFF,
                         KA->in[I_WDOWN] + (size_t)l * DFF * D, KA->in[I_POOLW] + (size_t)l * 4 * 128 * 128};
                if (G > 32) phase_transpose(L, ws, lds, 1, 32, G - 32); else phase_transpose(L, ws, lds, 1, 0, G);
            }
        }
        GSYNC();
#endif
        phase_mixnorm(PROJ, KA->in[I_GLANORM] + (size_t)l * 128, KA->in[I_GDNNORM] + (size_t)l * 128, Y);
        GSYNC();
        {
            pg8::Gemm g{Y, (const bf16*)(ws + WS_WOUT), M, D, D}; pg8::StaticOrder S; S.init(M, D, G, bx, WGM_OUT);
            pg8::EpiResid E{xin, KA->out, modl + 2 * D, D, MODW, T};
#ifndef NO_GEMM1
            pg8::gemm_phase<pg8::EpiResid, pg8::StaticOrder, GEMM_ALIGN, GEMM_SP2>(gl, g, S, E);
#endif
        }
        GSYNC();
#ifdef DUP_E
        if (l == 0) {
        {
            pg8::Gemm g{Y, (const bf16*)(ws + WS_WOUT), M, D, D}; pg8::StaticOrder S; S.init(M, D, G, bx, WGM_OUT);
            pg8::EpiResid E{xin, KA->out, modl + 2 * D, D, MODW, T};
#ifndef NO_GEMM1
            pg8::gemm_phase<pg8::EpiResid, pg8::StaticOrder, GEMM_ALIGN, GEMM_SP2>(gl, g, S, E);
#endif
        }
        GSYNC();
        }
#endif
        phase_norm(KA->out, KA->in[I_NFFN] + (size_t)l * D, modl, 3, 4, H);
        GSYNC();
#ifdef DUP_F
        phase_norm(KA->out, KA->in[I_NFFN] + (size_t)l * D, modl, 3, 4, H);
        GSYNC();
#endif
        {
            pg8::Gemm g{H, (const bf16*)(ws + WS_WGU), M, 2 * DFF, D}; pg8::StaticOrder S; S.init(M, 2 * DFF, G, bx, WGM_GU);
            pg8::EpiGateUp E{ACT, KA->in[I_FCW] + (size_t)l * 3 * DFF, KA->in[I_FCB] + (size_t)l * DFF, (float*)(ws + WS_SIDE), (float*)(ws + WS_SIDE) + (size_t)128 * DFF, (float*)(ws + WS_SIDE) + (size_t)256 * DFF,
                              (PG8_LAS float*)(gl + 131072), DFF};
            pg8::gemm_phase<pg8::EpiGateUp, pg8::StaticOrder, GEMM_ALIGN, GEMM_SP2>(gl, g, S, E);
        }
        GSYNC();
        if (G == 256) {
            const int c_ = bx;
#pragma unroll
            for (int i_ = 0; i_ < (M / 256) * (D / 256) / 256; ++i_) {
                constexpr int nM_ = M / 256, nN_ = D / 256, nwg_ = nM_ * nN_, q_ = nwg_ / 8;
                const int L_ = i_ * 256 + c_, wg_ = (L_ % 8) * q_ + L_ / 8;
                const int nig_ = WGM_DN * nN_, fm_ = (wg_ / nig_) * WGM_DN, gsz_ = (nM_ - fm_) < WGM_DN ? (nM_ - fm_) : WGM_DN;
                const int pm_ = fm_ + ((wg_ % nig_) % gsz_);
                actfix_tile(pm_, (const float*)(ws + WS_SIDE), (const float*)(ws + WS_SIDE) + (size_t)128 * DFF, (const float*)(ws + WS_SIDE) + (size_t)256 * DFF,
                            KA->in[I_FCW] + (size_t)l * 3 * DFF, KA->in[I_FCB] + (size_t)l * DFF, ACT); }
            asm volatile("s_waitcnt vmcnt(0)" ::: "memory"); __syncthreads();
        } else {
            phase_actfix((const float*)(ws + WS_SIDE), (const float*)(ws + WS_SIDE) + (size_t)128 * DFF, (const float*)(ws + WS_SIDE) + (size_t)256 * DFF,
                         KA->in[I_FCW] + (size_t)l * 3 * DFF, KA->in[I_FCB] + (size_t)l * DFF, ACT);
            GSYNC();
        }
        {
            pg8::Gemm g{ACT, (const bf16*)(ws + WS_WDN), M, D, DFF}; pg8::StaticOrder S; S.init(M, D, G, bx, WGM_DN);
            pg8::EpiResid E{KA->out, KA->out, modl + 5 * D, D, MODW, T};
#ifndef NO_GEMM3
            pg8::gemm_phase<pg8::EpiResid, pg8::StaticOrder, GEMM_ALIGN, GEMM_SP2>(gl, g, S, E);
#endif
        }
        GSYNC();
    }
#ifdef XSYNC
    for (int i_ = 0; i_ < XSYNC; ++i_) GSYNC();
#endif
    phase_final_norm(KA->out, KA->in[I_NFINAL]);
}

#undef KA
#undef ws
#undef MOD
#undef FCUM
#undef GLADEC
#undef GDNDEC
#undef PWT
#undef H
#undef ACT
#undef PROJ
#undef Y
#undef GU
#undef VT
#undef bx
extern "C" void kernel_launch(void* const* d_in, const int* in_sizes, int n_in, void* d_out, int out_size, void* d_ws, size_t ws_size, hipStream_t stream) {
    static int grid = 0;
    if (grid == 0) {
        int dev = 0, cus = 0, per_cu = 0;
        (void)hipGetDevice(&dev);
        (void)hipDeviceGetAttribute(&cus, hipDeviceAttributeMultiprocessorCount, dev);
        (void)hipFuncSetAttribute((const void*)mk_fwd, hipFuncAttributeMaxDynamicSharedMemorySize, LDS_BYTES);
        (void)hipOccupancyMaxActiveBlocksPerMultiprocessor(&per_cu, (const void*)mk_fwd, 512, LDS_BYTES);
        if (per_cu < 1) fprintf(stderr, "kernel_launch: occupancy query reports %d blocks per CU\n", per_cu);
        if (n_in != 24 || out_size != M * D || ws_size < WS_END) { fprintf(stderr, "kernel_launch: unexpected shapes (n_in %d out %d ws %zu)\n", n_in, out_size, ws_size); grid = -1; return; }
        grid = cus > 0 ? cus : 256;
    }
    if (grid < 0) return;
    if (hipMemsetAsync(d_ws, 0, 65536, stream) != hipSuccess) { fprintf(stderr, "kernel_launch: memset of the barrier words failed\n"); return; }
    Args a{};
    for (int i = 0; i < 24; ++i) a.in[i] = (const float*)d_in[i];
    a.out = (float*)d_out; a.ws = (unsigned char*)d_ws;
    void* args[] = {&a};
    hipError_t e = hipLaunchCooperativeKernel((const void*)mk_fwd, dim3(grid), dim3(512), args, LDS_BYTES, stream);
    if (e != hipSuccess) fprintf(stderr, "kernel_launch: cooperative launch failed: %s (grid %d)\n", hipGetErrorString(e), grid);
}
```

```cpp
#include <hip/hip_runtime.h>
#include <hip/hip_cooperative_groups.h>
#include <cstdio>
#include <cstdint>
namespace cg = cooperative_groups;
#ifndef PG8_WGM
#define PG8_WGM 8
#endif
__device__ __forceinline__ int fresh_tid() { int t = threadIdx.x; asm volatile("" : "+v"(t)); return t; }
__device__ __forceinline__ int fresh_bid() { int t = blockIdx.x; asm volatile("" : "+s"(t)); return t; }
namespace pg8 {
#define PG8_LAS __attribute__((address_space(3)))
typedef unsigned short bf16_t;
typedef short bf16x8 __attribute__((ext_vector_type(8)));
typedef float f32x4 __attribute__((ext_vector_type(4)));
typedef unsigned u32x4 __attribute__((ext_vector_type(4)));
constexpr int BM = 256, BK = 64, HALF = 128, HTB = HALF * BK * 2  , STAGE_BYTES = 8 * HTB, NXCD = 8, WGM = PG8_WGM;

__host__ __device__ __forceinline__ int lds_byte(int r, int c) { const int st = (r >> 4) * 2 + (c >> 5), rr = r & 15, cc = c & 31, ob = rr * 64 + cc * 2; return st * 1024 + (ob ^ (((ob >> 9) & 1) << 5)); }
__host__ __device__ __forceinline__ void stage_rc(int b, int& R, int& C) { const int st = b / 1024, sb = b % 1024, swz = sb ^ (((sb >> 9) & 1) << 5); R = (st >> 1) * 16 + swz / 64; C = (st & 1) * 32 + (swz % 64) / 2; }
__host__ __device__ __forceinline__ int perm32(int rho) { const int n = rho >> 4, i = rho & 15; return 8 * (i >> 2) + 4 * n + (i & 3); }

struct Unit { int pm, pn; };
struct Gemm { const bf16_t* A; const bf16_t* Bt; int M, N, K; };

struct StaticOrder {
    int nM, nN, nwg, G, c, wgm;
    __host__ __device__ void init(int M, int N, int G_, int c_, int wgm_ = WGM) { nM = M / BM; nN = N / BM; nwg = nM * nN; G = G_; c = c_; wgm = wgm_; }
    __host__ __device__ bool next(int i, Unit& u) const {
        const long L = (long)i * G + c; if (L >= nwg) return false;
        int wgid = (int)L; { const int q = nwg / NXCD, r = nwg % NXCD, xcd = wgid % NXCD, off = wgid / NXCD; wgid = (xcd < r ? xcd * (q + 1) : r * (q + 1) + (xcd - r) * q) + off; }
        const int nig = wgm * nN, gid = wgid / nig, fm = gid * wgm, gsz = (nM - fm) < wgm ? (nM - fm) : wgm;
        u.pm = fm + ((wgid % nig) % gsz); u.pn = (wgid % nig) / gsz; return true;
    }
    __device__ __forceinline__ void a_ready(const Unit&) const {}
    __device__ __forceinline__ void done(const Unit&) const {}
};

__device__ __forceinline__ unsigned cvt_pk_bf16(float lo, float hi) { unsigned r; asm volatile("v_cvt_pk_bf16_f32 %0, %1, %2" : "=v"(r) : "v"(lo), "v"(hi)); return r; }
typedef unsigned u32x4 __attribute__((ext_vector_type(4)));
struct EpiStoreBf16 {
    static constexpr bool PERM = true, AFTER_DRAIN = false;
    bf16_t* O; int ldc;
    __device__ __forceinline__ void operator()(const f32x4 (&acc)[2][2][4][2], const Unit& u, int wr, int wc, int fr, int fq) const {
        const int row0 = u.pm * BM + wr * 64 + fr; const int col0 = u.pn * BM + wc * 32 + 8 * fq;
#pragma unroll
        for (int ai = 0; ai < 2; ++ai)
#pragma unroll
            for (int m = 0; m < 4; ++m) { bf16_t* rowp = O + (size_t)(row0 + ai * HALF + m * 16) * ldc + col0;
#pragma unroll
                for (int bj = 0; bj < 2; ++bj) { const f32x4 v0 = acc[ai][bj][m][0], v1 = acc[ai][bj][m][1];
                    u32x4 w; w.x = cvt_pk_bf16(v0[0], v0[1]); w.y = cvt_pk_bf16(v0[2], v0[3]); w.z = cvt_pk_bf16(v1[0], v1[1]); w.w = cvt_pk_bf16(v1[2], v1[3]);
                    *(u32x4*)(rowp + bj * HALF) = w; } }
    }
};
struct EpiResid {
    static constexpr bool PERM = false, AFTER_DRAIN = false;
    const float* base; float* out; const float* gate; int ldc; int gpitch; int rows_per_batch;
    __device__ __forceinline__ void operator()(const f32x4 (&acc)[2][2][4][2], const Unit& u, int wr, int wc, int fr, int fq) const {
        const int row0 = u.pm * BM + wr * 64 + fr; const int col0 = u.pn * BM + wc * 32 + 4 * fq;
        const float* g = gate + (size_t)((u.pm * BM) / rows_per_batch) * gpitch + col0;
        f32x4 gv[2][2];
#pragma unroll
        for (int bj = 0; bj < 2; ++bj)
#pragma unroll
            for (int n = 0; n < 2; ++n) gv[bj][n] = *(const f32x4*)(g + bj * HALF + n * 16);
        f32x4 pb[3][4];
#define ER_LOAD(G_, D_) do { const size_t off_ = (size_t)(row0 + ((G_) >> 2) * HALF + ((G_) & 3) * 16) * ldc + col0; \
        _Pragma("unroll") for (int q_ = 0; q_ < 4; ++q_) D_[q_] = *(const f32x4*)(base + off_ + (q_ >> 1) * HALF + (q_ & 1) * 16); } while (0)
        ER_LOAD(0, pb[0]); ER_LOAD(1, pb[1]);
#pragma unroll
        for (int G = 0; G < 8; ++G) {
            if (G + 2 < 8) ER_LOAD(G + 2, pb[(G + 2) % 3]);
            __builtin_amdgcn_sched_barrier(0);
            const int ai = G >> 2, m = G & 3;
            const size_t off = (size_t)(row0 + ai * HALF + m * 16) * ldc + col0;
#pragma unroll
            for (int q = 0; q < 4; ++q) { const int bj = q >> 1, n = q & 1;
                *(f32x4*)(out + off + bj * HALF + n * 16) = pb[G % 3][q] + gv[bj][n] * acc[ai][bj][m][n]; }
            __builtin_amdgcn_sched_barrier(0);
        }
#undef ER_LOAD
    }
};
template <int N> __device__ __forceinline__ float dpp_ror(float v) { return __builtin_bit_cast(float, __builtin_amdgcn_update_dpp(0, __builtin_bit_cast(int, v), 0x120 + N, 0xf, 0xf, false)); }
struct EpiGateUp {
    static constexpr bool PERM = true, AFTER_DRAIN = false;
    bf16_t* ACT; const float* cw; const float* cb; float* GLAST; float* GFIRST; float* UFIRST; PG8_LAS float* XL; int dff;
    __device__ __forceinline__ void operator()(const f32x4 (&acc)[2][2][4][2], const Unit& u, int wr, int wc, int fr, int fq) const {
        const int ch0 = u.pn * 128 + wc * 32 + 8 * fq;
        float w0[8], w1[8], w2[8], bb[8];
#pragma unroll
        for (int n = 0; n < 2; ++n) { const f32x4 a = *(const f32x4*)(cw + ch0 + 4 * n), b = *(const f32x4*)(cw + dff + ch0 + 4 * n), c = *(const f32x4*)(cw + 2 * dff + ch0 + 4 * n), d = *(const f32x4*)(cb + ch0 + 4 * n);
#pragma unroll
            for (int j = 0; j < 4; ++j) { w0[4 * n + j] = a[j]; w1[4 * n + j] = b[j]; w2[4 * n + j] = c[j]; bb[4 * n + j] = d[j]; } }
        if (fr >= 14) {
#pragma unroll
            for (int ai = 0; ai < 2; ++ai)
#pragma unroll
                for (int n = 0; n < 2; ++n) *(PG8_LAS f32x4*)(XL + ((((ai * 2 + wr) * 4 + wc) * 2 + (fr - 14)) * 32 + 8 * fq + 4 * n)) = acc[ai][0][3][n];
            if (wr == 1) {
#pragma unroll
                for (int n = 0; n < 2; ++n) *(f32x4*)(GLAST + (size_t)(u.pm * 2 + (fr - 14)) * dff + ch0 + 4 * n) = acc[1][0][3][n];
            }
        }
        if (wr == 0 && fr < 2) {
#pragma unroll
            for (int n = 0; n < 2; ++n) { *(f32x4*)(GFIRST + (size_t)(u.pm * 2 + fr) * dff + ch0 + 4 * n) = acc[0][0][0][n]; *(f32x4*)(UFIRST + (size_t)(u.pm * 2 + fr) * dff + ch0 + 4 * n) = acc[0][1][0][n]; }
        }
        asm volatile("s_waitcnt lgkmcnt(0)" ::: "memory"); __builtin_amdgcn_s_barrier(); asm volatile("" ::: "memory");
        const int row0 = u.pm * BM + wr * 64 + fr;
#pragma unroll
        for (int ai = 0; ai < 2; ++ai) {
            float pv[8];
            {
                const int sai = (wr == 1) ? ai : 0, swr = (wr == 1) ? 0 : 1;
                const bool have = (wr == 1) || (ai == 1);
                PG8_LAS const float* src = XL + ((((sai * 2 + swr) * 4 + wc) * 2 + ((fr == 15) ? 1 : 0)) * 32 + 8 * fq);
                const f32x4 x0 = *(PG8_LAS const f32x4*)src, x1 = *(PG8_LAS const f32x4*)(src + 4);
#pragma unroll
                for (int j = 0; j < 4; ++j) { pv[j] = have ? x0[j] : 0.f; pv[4 + j] = have ? x1[j] : 0.f; }
            }
            float r1p[8], r2p[8];
#pragma unroll
            for (int e = 0; e < 8; ++e) { r1p[e] = dpp_ror<1>(pv[e]); r2p[e] = dpp_ror<2>(pv[e]); }
#pragma unroll
            for (int m = 0; m < 4; ++m) {
                u32x4 w;
                unsigned pk[4];
#pragma unroll
                for (int n = 0; n < 2; ++n) {
                    float o[4];
#pragma unroll
                    for (int j = 0; j < 4; ++j) {
                        const int e = 4 * n + j;
                        const float g = acc[ai][0][m][n][j], up = acc[ai][1][m][n][j];
                        const float g1s = dpp_ror<1>(g), g2s = dpp_ror<2>(g);
                        const float g1 = (fr >= 1) ? g1s : r1p[e], g2 = (fr >= 2) ? g2s : r2p[e];
                        r1p[e] = g1s; r2p[e] = g2s;
                        const float a = w0[e] * g2 + w1[e] * g1 + w2[e] * g + bb[e];
                        o[j] = a * __builtin_amdgcn_rcpf(1.f + __expf(-a)) * up;
                    }
                    pk[2 * n] = cvt_pk_bf16(o[0], o[1]); pk[2 * n + 1] = cvt_pk_bf16(o[2], o[3]);
                }
                w.x = pk[0]; w.y = pk[1]; w.z = pk[2]; w.w = pk[3];
                *(u32x4*)(ACT + (size_t)(row0 + ai * HALF + m * 16) * dff + ch0) = w;
            }
        }
    }
};
template <class Epi, class Sched, bool ALIGN_EPI = false, bool SP2 = false>
__device__ __forceinline__ void gemm_phase(PG8_LAS unsigned char* lds, const Gemm g, const Sched& S, const Epi& E) {
    const int tid = fresh_tid(), wid = __builtin_amdgcn_readfirstlane(tid >> 6), lane = tid & 63, wr = wid >> 2, wc = wid & 3, fr = lane & 15, fq = lane >> 4;
    const int K = g.K, nt = K / BK;
    unsigned voffA[2], voffB[2];
#pragma unroll
    for (int i = 0; i < 2; ++i) { int R, C; stage_rc(tid * 16 + i * 8192, R, C); const int Rb = Epi::PERM ? ((R & ~31) + perm32(R & 31)) : R;
        voffA[i] = (unsigned)(R * K + C) * 2u; voffB[i] = (unsigned)(Rb * K + C) * 2u; }
    const size_t kstep = (size_t)(BK * 2);
    const size_t hstep = (size_t)HALF * K * 2;
    const size_t tstep = 2 * hstep;
    const unsigned ldsw = (unsigned)wid * 1024u;
    const int aoff = lds_byte(wr * 64 + fr, fq * 8), boff = lds_byte(wc * 32 + fr, fq * 8);
#define PG8_SA(b, h) (((b) * 2 + (h)) * HTB)
#define PG8_SB(b, h) ((4 + (b) * 2 + (h)) * HTB)
#define PG8_STAGE(bufoff, gbase, voff) do { _Pragma("unroll") for (int _i = 0; _i < 2; ++_i) \
        __builtin_amdgcn_global_load_lds((const unsigned*)((const char*)(gbase) + (voff)[_i]), (PG8_LAS unsigned*)(lds + (bufoff) + ldsw + _i * 8192), 16, 0, 0); } while (0)
#define PG8_LDA(dst, b, h) do { _Pragma("unroll") for (int m = 0; m < 4; ++m) _Pragma("unroll") for (int k = 0; k < 2; ++k) dst[m][k] = *(const PG8_LAS bf16x8*)(lds + PG8_SA(b, h) + aoff + m * 2048 + k * 1024); } while (0)
#define PG8_LDB(dst, b, h) do { _Pragma("unroll") for (int n = 0; n < 2; ++n) _Pragma("unroll") for (int k = 0; k < 2; ++k) dst[n][k] = *(const PG8_LAS bf16x8*)(lds + PG8_SB(b, h) + boff + n * 2048 + k * 1024); } while (0)
#define PG8_MMA(ai, bj, At, Bt) do { __builtin_amdgcn_s_setprio(1); _Pragma("unroll") for (int m = 0; m < 4; ++m) _Pragma("unroll") for (int n = 0; n < 2; ++n) _Pragma("unroll") for (int k = 0; k < 2; ++k) \
        acc[ai][bj][m][n] = __builtin_amdgcn_mfma_f32_16x16x32_bf16(Bt[n][k], At[m][k], acc[ai][bj][m][n], 0, 0, 0); __builtin_amdgcn_s_setprio(0); } while (0)
#define PG8_WAIT_V(n) asm volatile("s_waitcnt vmcnt(" #n ")" ::: "memory")
#define PG8_WAIT_L(n) asm volatile("s_waitcnt lgkmcnt(" #n ")" ::: "memory")
#define PG8_BAR __builtin_amdgcn_s_barrier()
#define PG8_SCHED __builtin_amdgcn_sched_barrier(0)
    Unit cur, nxt; int ui = 0;
    if (!S.next(0, cur)) return;
    f32x4 acc[2][2][4][2];
#pragma unroll
    for (int a = 0; a < 2; ++a)
#pragma unroll
        for (int b = 0; b < 2; ++b)
#pragma unroll
            for (int m = 0; m < 4; ++m)
#pragma unroll
                for (int n = 0; n < 2; ++n) acc[a][b][m][n] = (f32x4){0.f, 0.f, 0.f, 0.f};
    bf16x8 At[4][2], B0[2][2], B1[2][2];
    const char* cA = (const char*)g.A + (size_t)cur.pm * tstep; const char* cB = (const char*)g.Bt + (size_t)cur.pn * tstep;
    S.a_ready(cur);
    if constexpr (SP2) {
        PG8_STAGE(PG8_SB(0, 0), cB, voffB); PG8_STAGE(PG8_SB(0, 1), cB + hstep, voffB); PG8_STAGE(PG8_SA(0, 0), cA, voffA); PG8_STAGE(PG8_SA(0, 1), cA + hstep, voffA);
        if (wr == 1) PG8_BAR;
        PG8_WAIT_V(2); PG8_BAR;
        PG8_STAGE(PG8_SB(1, 0), cB + kstep, voffB); PG8_STAGE(PG8_SA(1, 0), cA + kstep, voffA); PG8_STAGE(PG8_SB(1, 1), cB + hstep + kstep, voffB);
        PG8_WAIT_V(6); PG8_BAR;
    } else {
        PG8_STAGE(PG8_SB(0, 0), cB, voffB); PG8_STAGE(PG8_SA(0, 0), cA, voffA); PG8_STAGE(PG8_SB(0, 1), cB + hstep, voffB); PG8_STAGE(PG8_SA(0, 1), cA + hstep, voffA);
        if (wr == 1) PG8_BAR;
        PG8_WAIT_V(4); PG8_BAR;
        PG8_STAGE(PG8_SB(1, 0), cB + kstep, voffB); PG8_STAGE(PG8_SA(1, 0), cA + kstep, voffA); PG8_STAGE(PG8_SB(1, 1), cB + hstep + kstep, voffB);
        PG8_WAIT_V(6); PG8_BAR;
    }
    for (;;) {
        const bool has_next = S.next(ui + 1, nxt);
        const char* nA = has_next ? (const char*)g.A + (size_t)nxt.pm * tstep : cA; const char* nB = has_next ? (const char*)g.Bt + (size_t)nxt.pn * tstep : cB;
        for (int t = 0; t < nt; t += 2) {
            const bool last = (t == nt - 2);
            const char* a1 = cA + (size_t)(t + 1) * kstep;
            const char* a2 = last ? nA : cA + (size_t)(t + 2) * kstep; const char* b2 = last ? nB : cB + (size_t)(t + 2) * kstep;
            const char* a3 = a2 + kstep; const char* b3 = b2 + kstep;
            if (last && has_next) S.a_ready(nxt);
            if constexpr (SP2) {
            PG8_LDB(B0, 0, 0); PG8_LDB(B1, 0, 1); PG8_SCHED; PG8_LDA(At, 0, 0); PG8_STAGE(PG8_SA(1, 1), a1 + hstep, voffA);
            PG8_WAIT_V(8); PG8_WAIT_L(0); PG8_BAR; PG8_MMA(0, 0, At, B0); PG8_MMA(0, 1, At, B1); PG8_BAR; PG8_SCHED;
            PG8_LDA(At, 0, 1); PG8_STAGE(PG8_SB(0, 0), b2, voffB); PG8_STAGE(PG8_SB(0, 1), b2 + hstep, voffB); PG8_STAGE(PG8_SA(0, 0), a2, voffA);
            PG8_WAIT_V(8); PG8_WAIT_L(0); PG8_BAR; PG8_MMA(1, 0, At, B0); PG8_MMA(1, 1, At, B1); PG8_BAR; PG8_SCHED;
            PG8_LDB(B0, 1, 0); PG8_LDB(B1, 1, 1); PG8_SCHED; PG8_LDA(At, 1, 0); PG8_STAGE(PG8_SA(0, 1), a2 + hstep, voffA);
            PG8_WAIT_V(8); PG8_WAIT_L(0); PG8_BAR; PG8_MMA(0, 0, At, B0); PG8_MMA(0, 1, At, B1); PG8_BAR; PG8_SCHED;
            PG8_LDA(At, 1, 1); PG8_STAGE(PG8_SB(1, 0), b3, voffB); PG8_STAGE(PG8_SB(1, 1), b3 + hstep, voffB); PG8_STAGE(PG8_SA(1, 0), a3, voffA);
            PG8_WAIT_V(8); PG8_WAIT_L(0); PG8_BAR; PG8_MMA(1, 0, At, B0); PG8_MMA(1, 1, At, B1); PG8_BAR; PG8_SCHED;
            } else {
            PG8_LDB(B0, 0, 0); PG8_SCHED; PG8_LDA(At, 0, 0); PG8_STAGE(PG8_SA(1, 1), a1 + hstep, voffA);
            PG8_WAIT_L(8); PG8_BAR; PG8_WAIT_L(0); PG8_MMA(0, 0, At, B0); PG8_BAR; PG8_SCHED;
            PG8_LDB(B1, 0, 1); PG8_STAGE(PG8_SB(0, 0), b2, voffB);
            PG8_BAR; PG8_WAIT_L(0); PG8_MMA(0, 1, At, B1); PG8_BAR;
            PG8_LDA(At, 0, 1); PG8_STAGE(PG8_SA(0, 0), a2, voffA);
            PG8_BAR; PG8_WAIT_L(0); PG8_MMA(1, 0, At, B0); PG8_BAR; PG8_SCHED;
            PG8_STAGE(PG8_SB(0, 1), b2 + hstep, voffB);
            PG8_WAIT_V(6); PG8_BAR; PG8_MMA(1, 1, At, B1); PG8_BAR;
            PG8_LDB(B0, 1, 0); PG8_SCHED; PG8_LDA(At, 1, 0); PG8_STAGE(PG8_SA(0, 1), a2 + hstep, voffA);
            PG8_WAIT_L(8); PG8_BAR; PG8_WAIT_L(0); PG8_MMA(0, 0, At, B0); PG8_BAR; PG8_SCHED;
            PG8_LDB(B1, 1, 1); PG8_STAGE(PG8_SB(1, 0), b3, voffB);
            PG8_BAR; PG8_WAIT_L(0); PG8_MMA(0, 1, At, B1); PG8_BAR;
            PG8_LDA(At, 1, 1); PG8_STAGE(PG8_SA(1, 0), a3, voffA);
            PG8_BAR; PG8_WAIT_L(0); PG8_MMA(1, 0, At, B0); PG8_BAR; PG8_SCHED;
            PG8_STAGE(PG8_SB(1, 1), b3 + hstep, voffB);
            PG8_WAIT_V(6); PG8_BAR; PG8_MMA(1, 1, At, B1); PG8_BAR;
            }
        }
        if constexpr (ALIGN_EPI) { if (wr == 0) PG8_BAR; }
        if constexpr (!Epi::AFTER_DRAIN) { E(acc, cur, wr, wc, fr, fq); S.done(cur); }
        if (!has_next) break;
#pragma unroll
        for (int a = 0; a < 2; ++a)
#pragma unroll
            for (int b = 0; b < 2; ++b)
#pragma unroll
                for (int m = 0; m < 4; ++m)
#pragma unroll
                    for (int n = 0; n < 2; ++n) acc[a][b][m][n] = (f32x4){0.f, 0.f, 0.f, 0.f};
        cur = nxt; cA = nA; cB = nB; ++ui;
        if constexpr (ALIGN_EPI) { if (wr == 1) PG8_BAR; }
    }
    PG8_WAIT_V(0);
    if constexpr (!ALIGN_EPI) { if (wr == 0) PG8_BAR; }
    PG8_BAR;
    if constexpr (Epi::AFTER_DRAIN) { E.fused(acc, cur, wr, wc, fr, fq, lds, wid, lane); S.done(cur); }
#undef PG8_SA
#undef PG8_SB
#undef PG8_STAGE
#undef PG8_LDA
#undef PG8_LDB
#undef PG8_MMA
#undef PG8_WAIT_V
#undef PG8_WAIT_L
#undef PG8_BAR
#undef PG8_SCHED
}
}
#define LAS __attribute__((address_space(3)))
#define XB_TMO      128
#define XB_XCNT(j)  (256  + 64 * (j))
#define XB_XSUB(j)  (1280 + 64 * (j))
#define XB_XGEN(j)  (2304 + 64 * (j))
#define XB_TOP      3328
#define XB_TOPGEN   3392
#define XCD_BAR_WORDS 3456
#define XB_SPIN_CAP (1u << 18)

__device__ __forceinline__ unsigned xb_ld(unsigned* p)              { return __hip_atomic_load(p, __ATOMIC_RELAXED, __HIP_MEMORY_SCOPE_AGENT); }
__device__ __forceinline__ unsigned xb_add(unsigned* p, unsigned v) { return __hip_atomic_fetch_add(p, v, __ATOMIC_RELAXED, __HIP_MEMORY_SCOPE_AGENT); }
__device__ __forceinline__ unsigned xb_xcc_id() { return (unsigned)__builtin_amdgcn_s_getreg((3 << 11) | 20) & 0xFu; }
#define XB_SPIN(cond, bar) do { unsigned _sp = 0; while (cond) { __builtin_amdgcn_s_sleep(1); \
    if ((++_sp & 255u) == 0u) { if (xb_ld(&(bar)[XB_TMO])) break; if (_sp > XB_SPIN_CAP) { atomicAdd(&(bar)[XB_TMO], 1u); break; } } } } while (0)

struct XcdBarrier {
    unsigned* bar; unsigned x;
    volatile LAS unsigned* st;
};

__device__ __forceinline__ XcdBarrier xcd_barrier_post(unsigned* bar, volatile LAS unsigned* st) {
    XcdBarrier b; b.bar = bar; b.x = xb_xcc_id(); b.st = st;
    if (threadIdx.x == 0) (void)xb_add(&bar[XB_XCNT(b.x)], 1u);
    return b;
}
__device__ __forceinline__ void xcd_barrier_complete(unsigned* bar, unsigned x, unsigned& nloc, unsigned& nx) {
    const unsigned G = gridDim.x * gridDim.y * gridDim.z;
    unsigned sum, cnt, mine, sp = 0u;
    for (;;) {
        sum = 0u; cnt = 0u; mine = 0u;
#pragma unroll
        for (unsigned j = 0; j < 16; ++j) { const unsigned c = xb_ld(&bar[XB_XCNT(j)]); sum += c; cnt += (c > 0u) ? 1u : 0u; mine = (j == x) ? c : mine; }
        if (sum == G) break;
        __builtin_amdgcn_s_sleep(1);
        if ((++sp & 255u) == 0u) { if (xb_ld(&bar[XB_TMO])) break; if (sp > XB_SPIN_CAP) { atomicAdd(&bar[XB_TMO], 1u); break; } }
    }
    nloc = mine > 0u ? mine : 1u; nx = cnt > 0u ? cnt : 1u;
}

__device__ __forceinline__ void xcd_barrier(const XcdBarrier& b) {
    asm volatile("s_waitcnt vmcnt(0)" ::: "memory");
    __syncthreads();
    if (threadIdx.x == 0) {
        unsigned* bar = b.bar;
        __builtin_amdgcn_s_waitcnt(0);
        unsigned nloc = b.st[0], nx = b.st[1];
        if (nloc == 0u) { xcd_barrier_complete(bar, b.x, nloc, nx); b.st[0] = nloc; b.st[1] = nx; }
        const unsigned old = xb_add(&bar[XB_XSUB(b.x)], 1u);
        const unsigned gen = old / nloc;
        if (old + 1u == (gen + 1u) * nloc) {
            __builtin_amdgcn_fence(__ATOMIC_RELEASE, "agent");
            asm volatile("s_waitcnt vmcnt(0)" ::: "memory");
            const unsigned og = xb_add(&bar[XB_TOP], 1u);
            const unsigned tg = og / nx;
            if (og + 1u == (tg + 1u) * nx) xb_add(&bar[XB_TOPGEN], 1u);
            else XB_SPIN(xb_ld(&bar[XB_TOPGEN]) == tg, bar);
            __builtin_amdgcn_fence(__ATOMIC_ACQUIRE, "agent");
            xb_add(&bar[XB_XGEN(b.x)], 1u);
            asm volatile("s_waitcnt vmcnt(0)" ::: "memory");
        } else {
            XB_SPIN(xb_ld(&bar[XB_XGEN(b.x)]) == gen, bar);
            __builtin_amdgcn_fence(__ATOMIC_ACQUIRE, "agent");
            asm volatile("s_waitcnt vmcnt(0)" ::: "memory");
        }
    }
    __syncthreads();
}

constexpr int NB = 4, T = 4096, M = NB * T, D = 2048, DFF = 5632, INW = 5660, INP = 5888, NL = 2, MODW = 6 * D;
constexpr int C_GLA_Q = 0, C_GLA_K = 256, C_GLA_V = 512, C_GLA_G = 1024, C_GLA_LR = 1536,
              C_GDN_Q = 1552, C_GDN_K = 2064, C_GDN_V = 2576, C_GDN_G = 3088, C_GDN_B = 3600, C_GDN_A = 3604,
              C_POOL = 3608, C_FOX_Q = 4120, C_FOX_K = 4632, C_FOX_V = 5144, C_FOX_F = 5656;
constexpr float EPS = 1e-6f;
constexpr float LOG2E = 1.4426950408889634f;
constexpr size_t MiB = 1u << 20;
constexpr size_t WS_MOD = 1 * MiB, WS_FCUM = 2 * MiB, WS_GLADEC = 3 * MiB, WS_GDNDEC = 4 * MiB, WS_PWT = 5 * MiB;
constexpr size_t WS_WIN = 8 * MiB, WS_WOUT = 31 * MiB, WS_WGU = 39 * MiB, WS_WDN = 83 * MiB;
constexpr size_t WS_H = 105 * MiB, WS_ACT = 169 * MiB, WS_PROJ = 345 * MiB, WS_Y = 529 * MiB, WS_GDN = 593 * MiB, WS_GLA = 665 * MiB, WS_VT = 705 * MiB, WS_END = 721 * MiB;
constexpr size_t WS_SIDE = WS_VT;
constexpr size_t WS_GU = WS_PROJ;
static_assert(WS_GU + (size_t)M * 2 * DFF * 2 <= WS_VT, "GU overlay");
constexpr size_t GDN_ITEM = 73728, GLA_ITEM = 40960;
constexpr int LDS_BYTES = 147456;

typedef unsigned short bf16;
typedef float f32x4 __attribute__((ext_vector_type(4)));
typedef float f32x2 __attribute__((ext_vector_type(2)));
typedef short bf16x8 __attribute__((ext_vector_type(8)));
typedef unsigned u32x4v __attribute__((ext_vector_type(4)));
typedef unsigned u32x2v __attribute__((ext_vector_type(2)));

__device__ __forceinline__ unsigned f2bf(float f) { unsigned u = __builtin_bit_cast(unsigned, f); return (u + 0x7fffu + ((u >> 16) & 1u)) >> 16; }
__device__ __forceinline__ unsigned pk2(float lo, float hi) { unsigned r; asm("v_cvt_pk_bf16_f32 %0, %1, %2" : "=v"(r) : "v"(lo), "v"(hi)); return r; }
__device__ __forceinline__ bf16 bf1(float x) { return (bf16)pk2(x, x); }
__device__ __forceinline__ float bflo(unsigned w) { return __builtin_bit_cast(float, w << 16); }
__device__ __forceinline__ float bfhi(unsigned w) { return __builtin_bit_cast(float, w & 0xffff0000u); }
__device__ __forceinline__ float bf2f(bf16 b) { return __builtin_bit_cast(float, (unsigned)b << 16); }
#define DPPF(x, ctrl, rmask, bound) __builtin_bit_cast(float, __builtin_amdgcn_update_dpp(0, __builtin_bit_cast(int, (x)), (ctrl), (rmask), 0xf, (bound)))
__device__ __forceinline__ float readlane_f(float v, int l) { return __builtin_bit_cast(float, __builtin_amdgcn_readlane(__builtin_bit_cast(int, v), l)); }
__device__ __forceinline__ float wave_sum(float v) {
    v += DPPF(v, 0x128, 0xf, false); v += DPPF(v, 0x124, 0xf, false); v += DPPF(v, 0x122, 0xf, false); v += DPPF(v, 0x121, 0xf, false);
    return (readlane_f(v, 0) + readlane_f(v, 16)) + (readlane_f(v, 32) + readlane_f(v, 48));
}
__device__ __forceinline__ float wave_iscan(float x, int lane) {
    (void)lane;
    x += DPPF(x, 0x111, 0xf, true); x += DPPF(x, 0x112, 0xf, true); x += DPPF(x, 0x114, 0xf, true); x += DPPF(x, 0x118, 0xf, true);
    x += DPPF(x, 0x142, 0xa, false);
    x += DPPF(x, 0x143, 0xc, false);
    return x;
}
__device__ __forceinline__ float sigmoidf_(float x) { return __builtin_amdgcn_rcpf(1.f + __expf(-x)); }
__device__ __forceinline__ float siluf_(float x) { return x * __builtin_amdgcn_rcpf(1.f + __expf(-x)); }
__device__ __forceinline__ float logsigmoidf_(float x) { return fminf(x, 0.f) - __logf(1.f + __expf(-fabsf(x))); }
__device__ __forceinline__ float softplusf_(float x) { return fmaxf(x, 0.f) + __logf(1.f + __expf(-fabsf(x))); }
__device__ __forceinline__ bf16x8 pack8(const f32x4 a, const f32x4 b) {
    u32x4v w; w.x = pk2(a[0], a[1]); w.y = pk2(a[2], a[3]); w.z = pk2(b[0], b[1]); w.w = pk2(b[2], b[3]);
    return __builtin_bit_cast(bf16x8, w);
}
__device__ __forceinline__ bf16x8 afrag_perm(const bf16* rowp, int k0, int fq) {
    const u32x2v lo = *(const u32x2v*)(rowp + k0 + 4 * fq), hi = *(const u32x2v*)(rowp + k0 + 16 + 4 * fq);
    u32x4v w; w.x = lo.x; w.y = lo.y; w.z = hi.x; w.w = hi.y; return __builtin_bit_cast(bf16x8, w);
}
#define LAS3 __attribute__((address_space(3)))
#define LDSBAR() do { asm volatile("s_waitcnt lgkmcnt(0)" ::: "memory"); __builtin_amdgcn_s_barrier(); asm volatile("" ::: "memory"); } while (0)
#define SB() __builtin_amdgcn_sched_barrier(0)
__device__ __forceinline__ float row16_sum(float x) {
    x += __builtin_bit_cast(float, __builtin_amdgcn_update_dpp(0, __builtin_bit_cast(int, x), 0x128, 0xf, 0xf, false));
    x += __builtin_bit_cast(float, __builtin_amdgcn_update_dpp(0, __builtin_bit_cast(int, x), 0x124, 0xf, 0xf, false));
    x += __builtin_bit_cast(float, __builtin_amdgcn_update_dpp(0, __builtin_bit_cast(int, x), 0x122, 0xf, 0xf, false));
    x += __builtin_bit_cast(float, __builtin_amdgcn_update_dpp(0, __builtin_bit_cast(int, x), 0x121, 0xf, 0xf, false));
    return x;
}
__device__ __forceinline__ void lds_put_perm(bf16* rowp, int c0, const u32x4v v) {
    const int blk = c0 & ~31, k = c0 & 31;
    const int plo = (k < 16) ? 2 * k : 2 * k - 28, phi = (k + 4 < 16) ? 2 * (k + 4) : 2 * (k + 4) - 28;
    *(u32x2v*)(rowp + blk + plo) = (u32x2v){v.x, v.y}; *(u32x2v*)(rowp + blk + phi) = (u32x2v){v.z, v.w};
}
__device__ __forceinline__ bf16x8 afrag_lin(const bf16* rowp, int k0, int fq) { return *(const bf16x8*)(rowp + k0 + 8 * fq); }
#define MFMA16(a, b, c) __builtin_amdgcn_mfma_f32_16x16x32_bf16((a), (b), (c), 0, 0, 0)

__device__ __forceinline__ void phase_mod(const float* c, const float* w_mod, const float* b_mod, float* mod, unsigned char* lds) {
    float* sc = (float*)lds;
    float* part = sc + 4 * 2048;
    const int tid = fresh_tid();
    for (int i = tid; i < NB * D; i += 512) sc[i] = siluf_(c[i]);
    __syncthreads();
    for (int chunk = fresh_bid(); chunk < 256; chunk += gridDim.x) {
        const int l = chunk >> 7, col0 = (chunk & 127) * 96;
        if (tid < 384) {
            const int cgi = tid % 24, ks = tid / 24;
            const float* W = w_mod + (size_t)l * D * MODW + col0 + cgi * 4;
            f32x4 a0 = {0.f, 0.f, 0.f, 0.f}, a1 = a0, a2 = a0, a3 = a0;
#pragma unroll 8
            for (int k = ks * 128; k < ks * 128 + 128; ++k) {
                const f32x4 w = *(const f32x4*)(W + (size_t)k * MODW);
                a0 += sc[k] * w; a1 += sc[D + k] * w; a2 += sc[2 * D + k] * w; a3 += sc[3 * D + k] * w;
            }
            float* p = part + (ks * 24 + cgi) * 16;
            *(f32x4*)(p) = a0; *(f32x4*)(p + 4) = a1; *(f32x4*)(p + 8) = a2; *(f32x4*)(p + 12) = a3;
        }
        __syncthreads();
        if (tid < 384) {
            const int cgi = tid >> 4, bj = tid & 15, b = bj >> 2, j = bj & 3;
            float s = 0.f;
#pragma unroll
            for (int ks = 0; ks < 16; ++ks) s += part[(ks * 24 + cgi) * 16 + bj];
            const int col = col0 + cgi * 4 + j;
            mod[(size_t)(l * NB + b) * MODW + col] = s + b_mod[(size_t)l * MODW + col];
        }
        __syncthreads();
    }
}

struct TrDesc { const float* W; bf16* WT; int K, N, nblk, il, r; };
struct LayerW { const float *w_in, *w_out, *w_gate, *w_up, *w_down, *pool_w; };
__device__ __forceinline__ TrDesc tr_resolve(const LayerW& L, unsigned char* wsp, int part, int it) {
    constexpr int I0 = 32 * 184, I1 = 32 * 64, I2 = 32 * 176, I5 = 8;
    TrDesc d; int r = it;
    if (part == 0) {
        if (r < I0) { d.W = L.w_in; d.WT = (bf16*)(wsp + WS_WIN); d.K = D; d.N = INW; d.nblk = 184; d.il = -1; d.r = r; return d; } r -= I0;
        const int g = r / I5; r -= g * I5;
        d.W = L.pool_w + (size_t)g * 128 * 128; d.WT = (bf16*)(wsp + WS_PWT) + (size_t)g * 128 * 128; d.K = 128; d.N = 128; d.nblk = 4; d.il = -1; d.r = r; return d;
    }
    if (r < I1) { d.W = L.w_out; d.WT = (bf16*)(wsp + WS_WOUT); d.K = D; d.N = D; d.nblk = 64; d.il = -1; d.r = r; return d; } r -= I1;
    if (r < I2) { d.W = L.w_gate; d.WT = (bf16*)(wsp + WS_WGU); d.K = D; d.N = DFF; d.nblk = 176; d.il = 0; d.r = r; return d; } r -= I2;
    if (r < I2) { d.W = L.w_up; d.WT = (bf16*)(wsp + WS_WGU); d.K = D; d.N = DFF; d.nblk = 176; d.il = 128; d.r = r; return d; } r -= I2;
    d.W = L.w_down; d.WT = (bf16*)(wsp + WS_WDN); d.K = DFF; d.N = D; d.nblk = 64; d.il = -1; d.r = r; return d;
}
__device__ __forceinline__ void tr_load(const TrDesc& d, int lane, float (&v)[32]) {
    const int kb = d.r / d.nblk, nb = d.r % d.nblk, k0 = 64 * kb, n = 32 * nb + (lane & 31);
    const float* p = d.W + (size_t)(k0 + (lane >> 5)) * d.N + n;
    const bool ok = n < d.N;
#pragma unroll
    for (int i = 0; i < 32; ++i) v[i] = ok ? p[(size_t)(2 * i) * d.N] : 0.f;
}
__device__ __forceinline__ void tr_store(const TrDesc& d, int lane, const float (&v)[32], float* scr) {
    const int kb = d.r / d.nblk, nb = d.r % d.nblk, k0 = 64 * kb, n0 = 32 * nb;
#pragma unroll
    for (int i = 0; i < 32; ++i) scr[(2 * i + (lane >> 5)) * 33 + (lane & 31)] = v[i];
    asm volatile("s_waitcnt lgkmcnt(0)" ::: "memory");
    const int c = lane & 7;
#pragma unroll
    for (int j = 0; j < 4; ++j) { const int nn = (lane >> 3) + 8 * j; const float* s = scr + (8 * c) * 33 + nn;
        u32x4v o; o.x = pk2(s[0 * 33], s[1 * 33]); o.y = pk2(s[2 * 33], s[3 * 33]); o.z = pk2(s[4 * 33], s[5 * 33]); o.w = pk2(s[6 * 33], s[7 * 33]);
        const int row = (d.il < 0) ? (n0 + nn) : (((n0 + nn) >> 7) * 256 + d.il + ((n0 + nn) & 127));
        *(u32x4v*)(d.WT + (size_t)row * d.K + k0 + 8 * c) = o; }
    asm volatile("s_waitcnt lgkmcnt(0)" ::: "memory");
}
__device__ __forceinline__ void phase_transpose(const LayerW& L, unsigned char* wsp, unsigned char* lds, int part, int blk0, int nblk) {
    const int tid_ = fresh_tid(), wave = __builtin_amdgcn_readfirstlane(tid_ >> 6), lane = tid_ & 63;
    float* scr = (float*)lds + wave * (64 * 33);
    const int gw = (fresh_bid() - blk0) * 8 + wave, NGW = nblk * 8;
    constexpr int I0 = 32 * 184, I1 = 32 * 64, I2 = 32 * 176, I4 = 88 * 64, I5 = 8;
    const int NIT = (part == 0) ? I0 + 4 * I5 : I1 + 2 * I2 + I4;
    if (gw < 0 || gw >= NIT) return;
    float va[32], vb[32];
    TrDesc da = tr_resolve(L, wsp, part, gw), db = da;
    tr_load(da, lane, va);
    for (int it = gw; it < NIT; it += 2 * NGW) {
        const bool hb = it + NGW < NIT, ha = it + 2 * NGW < NIT;
        if (hb) { db = tr_resolve(L, wsp, part, it + NGW); tr_load(db, lane, vb); }
        tr_store(da, lane, va, scr);
        if (ha) { da = tr_resolve(L, wsp, part, it + 2 * NGW); tr_load(da, lane, va); }
        if (hb) tr_store(db, lane, vb, scr);
    }
}

__device__ __forceinline__ void phase_norm(const float* x, const float* nw, const float* modl, int shi, int sci, bf16* Hp) {
    const int tid_ = fresh_tid(), wave = __builtin_amdgcn_readfirstlane(tid_ >> 6), lane = tid_ & 63;
    const int gw = fresh_bid() * 8 + wave, NGW = gridDim.x * 8;
#define NORM_LOAD(V, m_) do { const f32x4* xr_ = (const f32x4*)(x + (size_t)(m_) * D) + lane; _Pragma("unroll") for (int j = 0; j < 8; ++j) V[j] = xr_[64 * j]; } while (0)
#define NORM_DO(V, m_) do { float ss = 0.f; \
        _Pragma("unroll") for (int j = 0; j < 8; ++j) ss += (V[j].x * V[j].x + V[j].y * V[j].y) + (V[j].z * V[j].z + V[j].w * V[j].w); \
        const float r = rsqrtf(wave_sum(ss) * (1.f / D) + EPS); \
        const float* mb = modl + (size_t)((m_) / T) * MODW; \
        f32x4 sc_[8], sh_[8]; \
        _Pragma("unroll") for (int j = 0; j < 8; ++j) { const int col = 4 * lane + 256 * j; sc_[j] = *(const f32x4*)(mb + sci * D + col); sh_[j] = *(const f32x4*)(mb + shi * D + col); } \
        SB(); \
        _Pragma("unroll") for (int j = 0; j < 8; ++j) { const int col = 4 * lane + 256 * j; \
            const f32x4 y = V[j] * r * wv[j] * (1.f + sc_[j]) + sh_[j]; \
            u32x2v o; o.x = pk2(y.x, y.y); o.y = pk2(y.z, y.w); \
            *(u32x2v*)(Hp + (size_t)(m_) * D + col) = o; } } while (0)
    if (gw >= M) return;
    f32x4 va[8], vb[8], wv[8];
#pragma unroll
    for (int j = 0; j < 8; ++j) wv[j] = *(const f32x4*)(nw + 4 * lane + 256 * j);
    NORM_LOAD(va, gw);
    for (int m = gw; m < M; m += 2 * NGW) {
        const bool hb = m + NGW < M, ha = m + 2 * NGW < M;
        if (hb) NORM_LOAD(vb, m + NGW);
        NORM_DO(va, m);
        if (ha) NORM_LOAD(va, m + 2 * NGW);
        if (hb) NORM_DO(vb, m + NGW);
    }
#undef NORM_DO
}
__device__ __forceinline__ void phase_final_norm(float* x, const float* nw) {
    const int tid_ = fresh_tid(), wave = __builtin_amdgcn_readfirstlane(tid_ >> 6), lane = tid_ & 63;
    const int gw = fresh_bid() * 8 + wave, NGW = gridDim.x * 8;
#define FNORM_DO(V, m_) do { float ss = 0.f; \
        _Pragma("unroll") for (int j = 0; j < 8; ++j) ss += (V[j].x * V[j].x + V[j].y * V[j].y) + (V[j].z * V[j].z + V[j].w * V[j].w); \
        const float r = rsqrtf(wave_sum(ss) * (1.f / D) + EPS); \
        f32x4* xo_ = (f32x4*)(x + (size_t)(m_) * D) + lane; \
        _Pragma("unroll") for (int j = 0; j < 8; ++j) xo_[64 * j] = V[j] * r * wv[j]; } while (0)
    if (gw >= M) return;
    f32x4 va[8], vb[8], wv[8];
#pragma unroll
    for (int j = 0; j < 8; ++j) wv[j] = *(const f32x4*)(nw + 4 * lane + 256 * j);
    NORM_LOAD(va, gw);
    for (int m = gw; m < M; m += 2 * NGW) {
        const bool hb = m + NGW < M, ha = m + 2 * NGW < M;
        if (hb) NORM_LOAD(vb, m + NGW);
        FNORM_DO(va, m);
        if (ha) NORM_LOAD(va, m + 2 * NGW);
        if (hb) FNORM_DO(vb, m + NGW);
    }
#undef FNORM_DO
#undef NORM_LOAD
}

__device__ __forceinline__ void gdn_prep_item(int item, const bf16* PROJ, const float* conv_w, const float* a_log, const float* dt_bias,
                                              unsigned char* scr_base, float* gdn_dec, unsigned char* lds) {
    const int tid = fresh_tid(), wave = __builtin_amdgcn_readfirstlane(tid >> 6), lane = tid & 63, fr = lane & 15, fq = lane >> 4;
    const int bh = item >> 6, n = item & 63, b = bh >> 2, h = bh & 3, t0 = n * 64;
    const size_t row0 = (size_t)b * T + t0;
    bf16* Kb = (bf16*)lds;
    bf16* Qb = Kb + 64 * 144;
    float* RHS = (float*)(Qb + 64 * 144);
    float* Lm = RHS + 64 * 260;
    float* bs = Lm + 64 * 68;
    float* gc = bs + 64;
    unsigned char* scr = scr_base + (size_t)item * GDN_ITEM;
    bf16* gQG = (bf16*)scr; bf16* gW = (bf16*)(scr + 16384); bf16* gK2T = (bf16*)(scr + 32768); bf16* gUT = (bf16*)(scr + 49152); bf16* gATT = (bf16*)(scr + 65536);
    if (wave == 0) {
        const bf16* pr = PROJ + (row0 + lane) * INP;
        const float a_in = bf2f(pr[C_GDN_A + h]), b_in = bf2f(pr[C_GDN_B + h]);
        const float g = -__expf(a_log[h]) * softplusf_(a_in + dt_bias[h]);
        gc[lane] = wave_iscan(g, lane); bs[lane] = sigmoidf_(b_in);
    }
    unsigned xr[3][11];
#pragma unroll
    for (int p = 0; p < 3; ++p)
#pragma unroll
        for (int i = 0; i < 11; ++i) { const int tt = t0 + 8 * wave + i - 3;
            xr[p][i] = (tt >= 0) ? *(const unsigned*)(PROJ + ((size_t)b * T + tt) * INP + C_GDN_Q + p * 512 + h * 128 + 2 * lane) : 0u; }
    LDSBAR();
#pragma unroll
    for (int p = 0; p < 3; ++p) {
        f32x2 cw[4];
#pragma unroll
        for (int j = 0; j < 4; ++j) cw[j] = *(const f32x2*)(conv_w + j * 1536 + p * 512 + h * 128 + 2 * lane);
#pragma unroll
        for (int i = 0; i < 8; ++i) {
            float y0 = 0.f, y1 = 0.f;
#pragma unroll
            for (int j = 0; j < 4; ++j) { y0 += cw[j].x * bflo(xr[p][i + j]); y1 += cw[j].y * bfhi(xr[p][i + j]); }
            y0 = siluf_(y0); y1 = siluf_(y1);
            const int t = 8 * wave + i;
            if (p == 0) { const float sc = rsqrtf(wave_sum(y0 * y0 + y1 * y1) + EPS) * 0.08838834764831845f;
                *(unsigned*)(Qb + t * 144 + 2 * lane) = pk2(y0 * sc, y1 * sc); }
            else if (p == 1) { const float sc = rsqrtf(wave_sum(y0 * y0 + y1 * y1) + EPS); y0 *= sc; y1 *= sc;
                *(unsigned*)(Kb + t * 144 + 2 * lane) = pk2(y0, y1);
                const float f = bs[t] * __expf(gc[t]);
                *(f32x2*)(RHS + t * 260 + 128 + 2 * lane) = (f32x2){y0 * f, y1 * f}; }
            else { const float f = bs[t]; *(f32x2*)(RHS + t * 260 + 2 * lane) = (f32x2){y0 * f, y1 * f}; }
        }
    }
    LDSBAR();
#pragma unroll
    for (int r = 0; r < 4; ++r) {
        const int tl = wave + 8 * r, isqk = tl >> 4, it = (tl & 15) >> 2, jt = tl & 3;
        f32x4 acc = {0.f, 0.f, 0.f, 0.f};
        if (jt <= it) {
            if (isqk) {
#pragma unroll
                for (int ks = 0; ks < 4; ++ks) acc = MFMA16(*(const bf16x8*)(Kb + (16 * jt + fr) * 144 + 32 * ks + 8 * fq), *(const bf16x8*)(Qb + (16 * it + fr) * 144 + 32 * ks + 8 * fq), acc);
            } else {
#pragma unroll
                for (int ks = 0; ks < 4; ++ks) acc = MFMA16(*(const bf16x8*)(Kb + (16 * it + fr) * 144 + 32 * ks + 8 * fq), *(const bf16x8*)(Kb + (16 * jt + fr) * 144 + 32 * ks + 8 * fq), acc);
            }
        }
        if (isqk) {
            const int i = 16 * it + fr; float o[4];
#pragma unroll
            for (int jj = 0; jj < 4; ++jj) { const int j = 16 * jt + 4 * fq + jj; o[jj] = (j <= i) ? acc[jj] * __expf(fminf(gc[i] - gc[j], 0.f)) : 0.f; }
            u32x2v w; w.x = pk2(o[0], o[1]); w.y = pk2(o[2], o[3]);
            *(u32x2v*)(gATT + i * 64 + 16 * jt + 4 * fq) = w;
        } else {
            const int j = 16 * jt + fr;
#pragma unroll
            for (int jj = 0; jj < 4; ++jj) { const int i = 16 * it + 4 * fq + jj; Lm[i * 68 + j] = (j < i) ? bs[i] * acc[jj] * __expf(fminf(gc[i] - gc[j], 0.f)) : 0.f; }
        }
    }
    LDSBAR();
    if (tid < 256) {
        const int c = tid;
        LAS3 const float* Lb = (LAS3 const float*)Lm; asm volatile("" : "+v"(Lb));
        LAS3 const float* Rb = (LAS3 const float*)RHS + c; asm volatile("" : "+v"(Rb));
        float x[64];
        f32x4 buf[2][16]; float rb[2];
        rb[0] = Rb[0];
#pragma unroll
        for (int i = 0; i < 64; ++i) {
            if (i + 1 < 64) {
                rb[(i + 1) & 1] = Rb[(i + 1) * 260];
#pragma unroll
                for (int j4 = 0; j4 < (i + 4) / 4; ++j4) buf[(i + 1) & 1][j4] = *(LAS3 const f32x4*)(Lb + (i + 1) * 68 + 4 * j4);
            }
            __builtin_amdgcn_sched_barrier(0);
            float s0 = rb[i & 1], s1 = 0.f, s2 = 0.f, s3 = 0.f;
#pragma unroll
            for (int j4 = 0; j4 < (i + 3) / 4; ++j4) {
                const f32x4 l4 = buf[i & 1][j4];
                s0 -= l4.x * x[4 * j4];
                if (4 * j4 + 1 < i) s1 -= l4.y * x[4 * j4 + 1];
                if (4 * j4 + 2 < i) s2 -= l4.z * x[4 * j4 + 2];
                if (4 * j4 + 3 < i) s3 -= l4.w * x[4 * j4 + 3];
            }
            x[i] = (s0 + s1) + (s2 + s3);
            __builtin_amdgcn_sched_barrier(0);
        }
        if (c < 128) {
#pragma unroll
            for (int q = 0; q < 8; ++q) { u32x4v w; w.x = pk2(x[8 * q], x[8 * q + 1]); w.y = pk2(x[8 * q + 2], x[8 * q + 3]); w.z = pk2(x[8 * q + 4], x[8 * q + 5]); w.w = pk2(x[8 * q + 6], x[8 * q + 7]);
                *(u32x4v*)(gUT + c * 64 + 8 * q) = w; }
        } else {
#pragma unroll
            for (int i = 0; i < 64; ++i) gW[i * 128 + (c - 128)] = bf1(x[i]);
        }
    } else {
        const int tt = tid - 256;
        {
            const int i = tt >> 2, d0 = (tt & 3) * 32; const float e = __expf(gc[i]);
#pragma unroll
            for (int q = 0; q < 4; ++q) { const u32x4v v = *(const u32x4v*)(Qb + i * 144 + d0 + 8 * q); u32x4v w;
                w.x = pk2(bflo(v.x) * e, bfhi(v.x) * e); w.y = pk2(bflo(v.y) * e, bfhi(v.y) * e); w.z = pk2(bflo(v.z) * e, bfhi(v.z) * e); w.w = pk2(bflo(v.w) * e, bfhi(v.w) * e);
                *(u32x4v*)(gQG + i * 128 + d0 + 8 * q) = w; }
        }
        {
            const int d = tt & 127, j0 = (tt >> 7) * 32; const float gl = gc[63];
#pragma unroll
            for (int q = 0; q < 4; ++q) { float v[8];
#pragma unroll
                for (int e = 0; e < 8; ++e) { const int j = j0 + 8 * q + e; v[e] = bf2f(Kb[j * 144 + d]) * __expf(gl - gc[j]); }
                u32x4v w; w.x = pk2(v[0], v[1]); w.y = pk2(v[2], v[3]); w.z = pk2(v[4], v[5]); w.w = pk2(v[6], v[7]);
                *(u32x4v*)(gK2T + d * 64 + j0 + 8 * q) = w; }
        }
        if (tt == 0) gdn_dec[item] = __expf(gc[63]);
    }
    LDSBAR();
}

__device__ __forceinline__ void gla_prep_item(int item, const bf16* PROJ, const float* w_lr, const float* b_lr, unsigned char* scr_base, float* gla_dec, unsigned char* lds) {
    const int tid = fresh_tid(), wave = __builtin_amdgcn_readfirstlane(tid >> 6), lane = tid & 63, fr = lane & 15, fq = lane >> 4;
    const int bh = item >> 6, n = item & 63, b = bh >> 2, h = bh & 3, t0 = n * 64;
    const size_t row0 = (size_t)b * T + t0;
    bf16* QGs = (bf16*)lds;
    bf16* KGs = QGs + 64 * 80;
    bf16* Vs = KGs + 64 * 80;
    unsigned char* scr = scr_base + (size_t)item * GLA_ITEM;
    bf16* gQG = (bf16*)scr; bf16* gK2T = (bf16*)(scr + 8192); bf16* gUT = (bf16*)(scr + 16384); bf16* gATT = (bf16*)(scr + 32768);
    {
        const int r = tid >> 3, sg = tid & 7;
        const bf16* src = PROJ + (row0 + r) * INP + C_GLA_V + h * 128 + 16 * sg;
        const u32x4v v0 = *(const u32x4v*)src, v1 = *(const u32x4v*)(src + 8);
        *(u32x4v*)(Vs + r * 136 + 16 * sg) = v0; *(u32x4v*)(Vs + r * 136 + 16 * sg + 8) = v1;
    }
    {
        const bf16* pr = PROJ + (row0 + lane) * INP;
        const u32x4v g0 = *(const u32x4v*)(pr + C_GLA_LR), g1 = *(const u32x4v*)(pr + C_GLA_LR + 8);
        float glr[16];
        glr[0] = bflo(g0.x); glr[1] = bfhi(g0.x); glr[2] = bflo(g0.y); glr[3] = bfhi(g0.y); glr[4] = bflo(g0.z); glr[5] = bfhi(g0.z); glr[6] = bflo(g0.w); glr[7] = bfhi(g0.w);
        glr[8] = bflo(g1.x); glr[9] = bfhi(g1.x); glr[10] = bflo(g1.y); glr[11] = bfhi(g1.y); glr[12] = bflo(g1.z); glr[13] = bfhi(g1.z); glr[14] = bflo(g1.w); glr[15] = bfhi(g1.w);
        const u32x4v qv = *(const u32x4v*)(pr + C_GLA_Q + h * 64 + 8 * wave), kv = *(const u32x4v*)(pr + C_GLA_K + h * 64 + 8 * wave);
        float q[8], k[8];
        q[0] = bflo(qv.x); q[1] = bfhi(qv.x); q[2] = bflo(qv.y); q[3] = bfhi(qv.y); q[4] = bflo(qv.z); q[5] = bfhi(qv.z); q[6] = bflo(qv.w); q[7] = bfhi(qv.w);
        k[0] = bflo(kv.x); k[1] = bfhi(kv.x); k[2] = bflo(kv.y); k[3] = bfhi(kv.y); k[4] = bflo(kv.z); k[5] = bfhi(kv.z); k[6] = bflo(kv.w); k[7] = bfhi(kv.w);
        float qg[8], kg[8], k2[8];
        const int dc0 = h * 64 + 8 * wave;
        const float wlo = w_lr[(lane >> 3) * 256 + dc0 + (lane & 7)], whi = w_lr[((lane >> 3) + 8) * 256 + dc0 + (lane & 7)], blv = b_lr[dc0 + (lane & 7)];
#pragma unroll
        for (int i = 0; i < 8; ++i) {
            float z = readlane_f(blv, i);
#pragma unroll
            for (int r = 0; r < 16; ++r) z += glr[r] * readlane_f(r < 8 ? wlo : whi, (r & 7) * 8 + i);
            const float bc = wave_iscan(logsigmoidf_(z) * (1.f / 16.f), lane);
            const float bl = readlane_f(bc, 63);
            qg[i] = q[i] * 0.125f * __expf(bc); kg[i] = k[i] * __expf(-bc); k2[i] = k[i] * __expf(bl - bc);
            gK2T[(8 * wave + i) * 64 + lane] = bf1(k2[i]);
            if (lane == 63) gla_dec[(size_t)item * 64 + 8 * wave + i] = __expf(bl);
        }
        u32x4v w; w.x = pk2(qg[0], qg[1]); w.y = pk2(qg[2], qg[3]); w.z = pk2(qg[4], qg[5]); w.w = pk2(qg[6], qg[7]);
        *(u32x4v*)(QGs + lane * 80 + 8 * wave) = w; *(u32x4v*)(gQG + lane * 64 + 8 * wave) = w;
        w.x = pk2(kg[0], kg[1]); w.y = pk2(kg[2], kg[3]); w.z = pk2(kg[4], kg[5]); w.w = pk2(kg[6], kg[7]);
        *(u32x4v*)(KGs + lane * 80 + 8 * wave) = w;
    }
    LDSBAR();
    {
        const int v = tid >> 2, ts = (tid & 3) * 16; float x[16];
#pragma unroll
        for (int e = 0; e < 16; ++e) x[e] = bf2f(Vs[(ts + e) * 136 + v]);
        u32x4v w; w.x = pk2(x[0], x[1]); w.y = pk2(x[2], x[3]); w.z = pk2(x[4], x[5]); w.w = pk2(x[6], x[7]);
        *(u32x4v*)(gUT + v * 64 + ts) = w;
        w.x = pk2(x[8], x[9]); w.y = pk2(x[10], x[11]); w.z = pk2(x[12], x[13]); w.w = pk2(x[14], x[15]);
        *(u32x4v*)(gUT + v * 64 + ts + 8) = w;
    }
#pragma unroll
    for (int r = 0; r < 2; ++r) {
        const int tl = wave + 8 * r, it = tl >> 2, jt = tl & 3;
        f32x4 acc = {0.f, 0.f, 0.f, 0.f};
        if (jt <= it) {
#pragma unroll
            for (int ks = 0; ks < 2; ++ks) acc = MFMA16(*(const bf16x8*)(KGs + (16 * jt + fr) * 80 + 32 * ks + 8 * fq), *(const bf16x8*)(QGs + (16 * it + fr) * 80 + 32 * ks + 8 * fq), acc);
        }
        const int i = 16 * it + fr; float o[4];
#pragma unroll
        for (int jj = 0; jj < 4; ++jj) { const int j = 16 * jt + 4 * fq + jj; o[jj] = (j <= i) ? acc[jj] : 0.f; }
        u32x2v w; w.x = pk2(o[0], o[1]); w.y = pk2(o[2], o[3]);
        *(u32x2v*)(gATT + i * 64 + 16 * jt + 4 * fq) = w;
    }
    LDSBAR();
}

__device__ __forceinline__ void pool_item(int item, const bf16* PROJ, const bf16* PWT, const float* pscale, bf16* Y, unsigned char* lds) {
    const int tid = fresh_tid(), wave = __builtin_amdgcn_readfirstlane(tid >> 6), lane = tid & 63, fr = lane & 15, fq = lane >> 4;
    const int g = item & 3, tile = item >> 2, b = tile >> 6, t0 = (tile & 63) * 64, win = 2 << g;
    float* Us = (float*)lds;
    bf16* As = (bf16*)(Us + 79 * 128);
    bf16* Bs = As + 64 * 144;
    {
        u32x4v ur[3], pr[4];
#pragma unroll
        for (int i = 0; i < 3; ++i) { const int p = tid + 512 * i, r = p >> 4, sg = p & 15, tt = t0 + r - 15;
            ur[i] = (u32x4v){0u, 0u, 0u, 0u};
            if (p < 79 * 16 && tt >= 0) ur[i] = *(const u32x4v*)(PROJ + ((size_t)b * T + tt) * INP + C_POOL + g * 128 + 8 * sg); }
#pragma unroll
        for (int i = 0; i < 4; ++i) { const int p = tid + 512 * i, r = p >> 4, sg = p & 15;
            pr[i] = *(const u32x4v*)(PWT + (size_t)g * 128 * 128 + r * 128 + 8 * sg); }
#pragma unroll
        for (int i = 0; i < 3; ++i) { const int p = tid + 512 * i, r = p >> 4, sg = p & 15;
            if (p < 79 * 16) { float* d = Us + r * 128 + 8 * sg; const u32x4v v = ur[i];
                *(f32x4*)d = (f32x4){bflo(v.x), bfhi(v.x), bflo(v.y), bfhi(v.y)}; *(f32x4*)(d + 4) = (f32x4){bflo(v.z), bfhi(v.z), bflo(v.w), bfhi(v.w)}; } }
#pragma unroll
        for (int i = 0; i < 4; ++i) { const int p = tid + 512 * i, r = p >> 4, sg = p & 15; *(u32x4v*)(Bs + r * 144 + 8 * sg) = pr[i]; }
    }
    LDSBAR();
    {
        const int c = tid & 127, tg = tid >> 7;
        float s = 0.f;
        for (int j = 1; j < win; ++j) s += Us[(15 + 16 * tg - j) * 128 + c];
#pragma unroll 4
        for (int e = 0; e < 16; ++e) { const int r = 15 + 16 * tg + e; const float u = Us[r * 128 + c]; s += u;
            const int cnt = min(t0 + 16 * tg + e + 1, win);
            As[(16 * tg + e) * 144 + c] = bf1(s * __builtin_amdgcn_rcpf((float)cnt) - u);
            s -= Us[(r - win + 1) * 128 + c]; }
    }
    LDSBAR();
    {
        f32x4 acc[4];
#pragma unroll
        for (int mt = 0; mt < 4; ++mt) acc[mt] = (f32x4){0.f, 0.f, 0.f, 0.f};
#pragma unroll
        for (int ks = 0; ks < 4; ++ks) { const bf16x8 bw = *(const bf16x8*)(Bs + (16 * wave + fr) * 144 + 32 * ks + 8 * fq);
#pragma unroll
            for (int mt = 0; mt < 4; ++mt) acc[mt] = MFMA16(bw, *(const bf16x8*)(As + (16 * mt + fr) * 144 + 32 * ks + 8 * fq), acc[mt]); }
        const f32x4 sc = *(const f32x4*)(pscale + g * 128 + 16 * wave + 4 * fq);
#pragma unroll
        for (int mt = 0; mt < 4; ++mt) { const f32x4 o = acc[mt] * sc; u32x2v w; w.x = pk2(o.x, o.y); w.y = pk2(o.z, o.w);
            *(u32x2v*)(Y + ((size_t)b * T + t0 + 16 * mt + fr) * D + 1024 + g * 128 + 16 * wave + 4 * fq) = w; }
    }
    LDSBAR();
}

__device__ __forceinline__ void vt_item(int item, const bf16* PROJ, bf16* VT, unsigned char* lds) {
    const int tid = fresh_tid();
    const int bh = item >> 6, n = item & 63, b = bh >> 2, h = bh & 3, t0 = n * 64;
    bf16* Vs = (bf16*)lds;
    {
        const int r = tid >> 3, sg = tid & 7;
        const bf16* src = PROJ + ((size_t)b * T + t0 + r) * INP + C_FOX_V + h * 128 + 16 * sg;
        const u32x4v v0 = *(const u32x4v*)src, v1 = *(const u32x4v*)(src + 8);
        *(u32x4v*)(Vs + r * 136 + 16 * sg) = v0; *(u32x4v*)(Vs + r * 136 + 16 * sg + 8) = v1;
    }
    LDSBAR();
    {
        const int v = tid >> 2, ts = (tid & 3) * 16; float x[16];
#pragma unroll
        for (int e = 0; e < 16; ++e) x[e] = bf2f(Vs[(ts + e) * 136 + v]);
        bf16* dst = VT + ((size_t)bh * 128 + v) * T + t0 + ts;
        u32x4v w; w.x = pk2(x[0], x[1]); w.y = pk2(x[2], x[3]); w.z = pk2(x[4], x[5]); w.w = pk2(x[6], x[7]);
        *(u32x4v*)dst = w;
        w.x = pk2(x[8], x[9]); w.y = pk2(x[10], x[11]); w.z = pk2(x[12], x[13]); w.w = pk2(x[14], x[15]);
        *(u32x4v*)(dst + 8) = w;
    }
    LDSBAR();
}
__device__ __forceinline__ void fcum_item(int b, const bf16* PROJ, const float* f_bias, float* FCUM, unsigned char* lds) {
    const int tid = fresh_tid(), wave = __builtin_amdgcn_readfirstlane(tid >> 6), lane = tid & 63;
    float* wt = (float*)lds;
    const float bb[4] = {f_bias[0], f_bias[1], f_bias[2], f_bias[3]};
    const bf16* base = PROJ + ((size_t)b * T + 8 * tid) * INP + C_FOX_F;
    u32x2v v[8];
#pragma unroll
    for (int e = 0; e < 8; ++e) v[e] = *(const u32x2v*)(base + (size_t)e * INP);
    float ls[8][4]; float run[4] = {0.f, 0.f, 0.f, 0.f};
#pragma unroll
    for (int e = 0; e < 8; ++e) {
        run[0] += logsigmoidf_(bflo(v[e].x) + bb[0]); run[1] += logsigmoidf_(bfhi(v[e].x) + bb[1]); run[2] += logsigmoidf_(bflo(v[e].y) + bb[2]); run[3] += logsigmoidf_(bfhi(v[e].y) + bb[3]);
        ls[e][0] = run[0]; ls[e][1] = run[1]; ls[e][2] = run[2]; ls[e][3] = run[3];
    }
    float off[4];
#pragma unroll
    for (int h = 0; h < 4; ++h) { const float inc = wave_iscan(run[h], lane); off[h] = inc - run[h]; if (lane == 63) wt[wave * 4 + h] = inc; }
    LDSBAR();
#pragma unroll
    for (int h = 0; h < 4; ++h) { float o = off[h];
        for (int w = 0; w < wave; ++w) o += wt[w * 4 + h];
        float* dst = FCUM + ((size_t)b * 4 + h) * T + 8 * tid;
        *(f32x4*)dst = (f32x4){o + ls[0][h], o + ls[1][h], o + ls[2][h], o + ls[3][h]};
        *(f32x4*)(dst + 4) = (f32x4){o + ls[4][h], o + ls[5][h], o + ls[6][h], o + ls[7][h]}; }
    LDSBAR();
}

template <int DK, bool DELTA>
__device__ __forceinline__ void scan_bh(int bh, const unsigned char* scr_base, size_t item_bytes, const float* dec, const bf16* PROJ, int gcol,
                                        const float* norm_w, bf16* Y, int ycol, unsigned char* lds) {
    const int tid = fresh_tid(), wave = __builtin_amdgcn_readfirstlane(tid >> 6), lane = tid & 63, fr = lane & 15, fq = lane >> 4;
    const int b = bh >> 2;
    constexpr int PQ = DK + 16;
    constexpr int NQ = DK / 64;
    constexpr size_t O_QG = 0, O_W = DELTA ? 16384 : 0, O_K2T = DELTA ? 32768 : 8192, O_UT = DELTA ? 49152 : 16384, O_ATT = DELTA ? 65536 : 32768;
    bf16* QGt = (bf16*)lds;
    bf16* Wt = QGt + 64 * PQ;
    bf16* K2Tt = Wt + 64 * PQ;
    bf16* ATTt = K2Tt + DK * 80;
    bf16* UTt = ATTt + 64 * 80;
    bf16* Gt = UTt + 128 * 80;
    float* DECt = (float*)(Gt + 64 * 136);
    float* PART = DECt + DK;
    float* RINV = PART + 512;
    f32x4 S[DK / 16];
#pragma unroll
    for (int kb = 0; kb < DK / 16; ++kb) S[kb] = (f32x4){0.f, 0.f, 0.f, 0.f};
    u32x4v rq[NQ], rw[NQ], rk[NQ], ra, ru[2]; float rdec = 0.f;
#define SCAN_ISSUE(n_) do { const unsigned char* it_ = scr_base + (size_t)(bh * 64 + (n_)) * item_bytes; \
        _Pragma("unroll") for (int i = 0; i < NQ; ++i) { rq[i] = *(const u32x4v*)(it_ + O_QG + (size_t)(tid + 512 * i) * 16); if (DELTA) rw[i] = *(const u32x4v*)(it_ + O_W + (size_t)(tid + 512 * i) * 16); \
            rk[i] = *(const u32x4v*)(it_ + O_K2T + (size_t)(tid + 512 * i) * 16); } \
        ra = *(const u32x4v*)(it_ + O_ATT + (size_t)tid * 16); \
        ru[0] = *(const u32x4v*)(it_ + O_UT + (size_t)tid * 16); ru[1] = *(const u32x4v*)(it_ + O_UT + (size_t)(tid + 512) * 16); \
        if (tid < DK) rdec = DELTA ? dec[bh * 64 + (n_)] : dec[(size_t)(bh * 64 + (n_)) * 64 + tid]; } while (0)
    SCAN_ISSUE(0);
    for (int n = 0; n < 64; ++n) {
        LDSBAR();
#pragma unroll
        for (int i = 0; i < NQ; ++i) { const int p = tid + 512 * i;
            { const int r = p / (DK / 8), cp = p % (DK / 8); lds_put_perm(QGt + r * PQ, 8 * cp, rq[i]); if (DELTA) lds_put_perm(Wt + r * PQ, 8 * cp, rw[i]); }
            { const int r = p >> 3, cp = p & 7; lds_put_perm(K2Tt + r * 80, 8 * cp, rk[i]); } }
        { const int r = tid >> 3, cp = tid & 7; lds_put_perm(ATTt + r * 80, 8 * cp, ra); }
#pragma unroll
        for (int i = 0; i < 2; ++i) { const int p = tid + 512 * i; const int r = p >> 3, cp = p & 7; *(u32x4v*)(UTt + r * 80 + 8 * cp) = ru[i]; }
        if (tid < DK) DECt[tid] = rdec;
        LDSBAR();
        if (n + 1 < 64) SCAN_ISSUE(n + 1);
        const size_t row0 = (size_t)b * T + n * 64;
        bf16x8 Sf[DK / 32];
#pragma unroll
        for (int ks = 0; ks < DK / 32; ++ks) Sf[ks] = pack8(S[2 * ks], S[2 * ks + 1]);
        f32x4 vn[4], o[4];
        bf16x8 f0[8], f1[8];
        u32x2v uu[4];
#pragma unroll
        for (int mt = 0; mt < 4; ++mt) { uu[mt] = *(const u32x2v*)(UTt + (16 * wave + fr) * 80 + 16 * mt + 4 * fq); o[mt] = (f32x4){0.f, 0.f, 0.f, 0.f}; }
        if (DELTA) {
            f32x4 P[4];
#pragma unroll
            for (int mt = 0; mt < 4; ++mt) P[mt] = (f32x4){0.f, 0.f, 0.f, 0.f};
#pragma unroll
            for (int q = 0; q < 8; ++q) f0[q] = afrag_lin(Wt + (16 * (q & 3) + fr) * PQ, 32 * (q >> 2), fq);
            SB();
#pragma unroll
            for (int q = 0; q < 8; ++q) f1[q] = afrag_lin(Wt + (16 * (q & 3) + fr) * PQ, 32 * (2 + (q >> 2)), fq);
            SB();
#pragma unroll
            for (int q = 0; q < 8; ++q) P[q & 3] = MFMA16(f0[q], Sf[q >> 2], P[q & 3]);
            SB();
#pragma unroll
            for (int q = 0; q < 8; ++q) f0[q] = afrag_lin(QGt + (16 * (q & 3) + fr) * PQ, 32 * (q >> 2), fq);
            SB();
#pragma unroll
            for (int q = 0; q < 8; ++q) P[q & 3] = MFMA16(f1[q], Sf[2 + (q >> 2)], P[q & 3]);
            SB();
#pragma unroll
            for (int q = 0; q < 8; ++q) f1[q] = afrag_lin(QGt + (16 * (q & 3) + fr) * PQ, 32 * (2 + (q >> 2)), fq);
            SB();
#pragma unroll
            for (int q = 0; q < 8; ++q) o[q & 3] = MFMA16(f0[q], Sf[q >> 2], o[q & 3]);
            SB();
#pragma unroll
            for (int q = 0; q < 8; ++q) f0[q] = afrag_lin(ATTt + (16 * (q & 3) + fr) * 80, 32 * (q >> 2), fq);
            SB();
#pragma unroll
            for (int q = 0; q < 8; ++q) o[q & 3] = MFMA16(f1[q], Sf[2 + (q >> 2)], o[q & 3]);
#pragma unroll
            for (int mt = 0; mt < 4; ++mt) vn[mt] = (f32x4){bflo(uu[mt].x), bfhi(uu[mt].x), bflo(uu[mt].y), bfhi(uu[mt].y)} - P[mt];
        } else {
#pragma unroll
            for (int q = 0; q < 8; ++q) f1[q] = afrag_lin(QGt + (16 * (q & 3) + fr) * PQ, 32 * (q >> 2), fq);
            SB();
#pragma unroll
            for (int q = 0; q < 8; ++q) f0[q] = afrag_lin(ATTt + (16 * (q & 3) + fr) * 80, 32 * (q >> 2), fq);
            SB();
#pragma unroll
            for (int q = 0; q < 8; ++q) o[q & 3] = MFMA16(f1[q], Sf[q >> 2], o[q & 3]);
#pragma unroll
            for (int mt = 0; mt < 4; ++mt) vn[mt] = (f32x4){bflo(uu[mt].x), bfhi(uu[mt].x), bflo(uu[mt].y), bfhi(uu[mt].y)};
        }
        bf16x8 Vf[2];
        Vf[0] = pack8(vn[0], vn[1]); Vf[1] = pack8(vn[2], vn[3]);
        SB();
        constexpr int NKB = DK / 16, KG = (NKB * 2) / 8;
#pragma unroll
        for (int q = 0; q < 8; ++q) { const int t = q, kb = t % NKB, k2 = t / NKB; f1[q] = afrag_lin(K2Tt + (16 * kb + fr) * 80, 32 * k2, fq); }
        SB();
#pragma unroll
        for (int q = 0; q < 8; ++q) o[q & 3] = MFMA16(f0[q], Vf[q >> 2], o[q & 3]);
#pragma unroll
        for (int kb = 0; kb < NKB; ++kb) S[kb] = S[kb] * *(const f32x4*)(DECt + 16 * kb + 4 * fq);
        SB();
        if (KG == 2) {
#pragma unroll
            for (int q = 0; q < 8; ++q) { const int t = 8 + q, kb = t % NKB, k2 = t / NKB; f0[q] = afrag_lin(K2Tt + (16 * kb + fr) * 80, 32 * k2, fq); }
            SB();
        }
#pragma unroll
        for (int q = 0; q < 8; ++q) { const int t = q, kb = t % NKB, k2 = t / NKB; S[kb] = MFMA16(f1[q], Vf[k2], S[kb]); }
        if (KG == 2) {
            SB();
#pragma unroll
            for (int q = 0; q < 8; ++q) { const int t = 8 + q, kb = t % NKB, k2 = t / NKB; S[kb] = MFMA16(f0[q], Vf[k2], S[kb]); }
        }
#pragma unroll
        for (int mt = 0; mt < 4; ++mt)
#pragma unroll
            for (int j = 0; j < 4; ++j) Y[(row0 + 16 * mt + 4 * fq + j) * D + ycol + 16 * wave + fr] = bf1(o[mt][j]);
    }
#undef SCAN_ISSUE
    __syncthreads();
}

__device__ __forceinline__ void phase_mixnorm(const bf16* PROJ, const float* gla_norm, const float* gdn_norm, bf16* Y) {
    const int tid_ = fresh_tid(), wave = __builtin_amdgcn_readfirstlane(tid_ >> 6), lane = tid_ & 63;
    const int gw = fresh_bid() * 8 + wave, NGW = gridDim.x * 8;
    const int hh = lane >> 3, c16 = (lane & 7) * 16;
    const float* nw = (hh < 4 ? gla_norm : gdn_norm) + c16;
    float nwv[16];
#pragma unroll
    for (int e = 0; e < 16; e += 4) *(f32x4*)(nwv + e) = *(const f32x4*)(nw + e);
    const int gcol = (hh < 4 ? C_GLA_G : C_GDN_G) + (hh & 3) * 128 + c16;
#define MIX_LOAD(m_, Y0, Y1, G0, G1) do { const bf16* yp_ = Y + (size_t)(m_) * D + 16 * lane; const bf16* gp_ = PROJ + (size_t)(m_) * INP + gcol; \
        Y0 = *(const u32x4v*)yp_; Y1 = *(const u32x4v*)(yp_ + 8); G0 = *(const u32x4v*)gp_; G1 = *(const u32x4v*)(gp_ + 8); } while (0)
#define MIX_DO(m_, y0, y1, g0, g1) do { \
        float o[16], g[16]; \
        o[0] = bflo(y0.x); o[1] = bfhi(y0.x); o[2] = bflo(y0.y); o[3] = bfhi(y0.y); o[4] = bflo(y0.z); o[5] = bfhi(y0.z); o[6] = bflo(y0.w); o[7] = bfhi(y0.w); \
        o[8] = bflo(y1.x); o[9] = bfhi(y1.x); o[10] = bflo(y1.y); o[11] = bfhi(y1.y); o[12] = bflo(y1.z); o[13] = bfhi(y1.z); o[14] = bflo(y1.w); o[15] = bfhi(y1.w); \
        g[0] = bflo(g0.x); g[1] = bfhi(g0.x); g[2] = bflo(g0.y); g[3] = bfhi(g0.y); g[4] = bflo(g0.z); g[5] = bfhi(g0.z); g[6] = bflo(g0.w); g[7] = bfhi(g0.w); \
        g[8] = bflo(g1.x); g[9] = bfhi(g1.x); g[10] = bflo(g1.y); g[11] = bfhi(g1.y); g[12] = bflo(g1.z); g[13] = bfhi(g1.z); g[14] = bflo(g1.w); g[15] = bfhi(g1.w); \
        float ss = 0.f; \
        _Pragma("unroll") for (int e = 0; e < 16; ++e) ss += o[e] * o[e]; \
        ss += DPPF(ss, 0xB1, 0xf, false); ss += DPPF(ss, 0x4E, 0xf, false); ss += DPPF(ss, 0x141, 0xf, false);     \
        const float rinv = rsqrtf(ss * (1.f / 128.f) + EPS); \
        float y[16]; \
        _Pragma("unroll") for (int e = 0; e < 16; ++e) y[e] = o[e] * rinv * nwv[e] * siluf_(g[e]); \
        bf16* yp = Y + (size_t)(m_) * D + 16 * lane; \
        u32x4v w; w.x = pk2(y[0], y[1]); w.y = pk2(y[2], y[3]); w.z = pk2(y[4], y[5]); w.w = pk2(y[6], y[7]); \
        *(u32x4v*)yp = w; \
        w.x = pk2(y[8], y[9]); w.y = pk2(y[10], y[11]); w.z = pk2(y[12], y[13]); w.w = pk2(y[14], y[15]); \
        *(u32x4v*)(yp + 8) = w; } while (0)
    if (gw >= M) return;
    u32x4v ay0, ay1, ag0, ag1, by0, by1, bg0, bg1;
    MIX_LOAD(gw, ay0, ay1, ag0, ag1);
    for (int m = gw; m < M; m += 2 * NGW) {
        const bool hb = m + NGW < M, ha = m + 2 * NGW < M;
        if (hb) MIX_LOAD(m + NGW, by0, by1, bg0, bg1);
        MIX_DO(m, ay0, ay1, ag0, ag1);
        if (ha) MIX_LOAD(m + 2 * NGW, ay0, ay1, ag0, ag1);
        if (hb) MIX_DO(m + NGW, by0, by1, bg0, bg1);
    }
#undef MIX_LOAD
#undef MIX_DO
}

__device__ __forceinline__ void fox_item(int idx, const bf16* PROJ, const bf16* VT, const float* FCUM, bf16* Y, unsigned char* lds) {
    const int tid = fresh_tid(), wave = __builtin_amdgcn_readfirstlane(tid >> 6), lane = tid & 63, fr = lane & 15, fq = lane >> 4;
    const int qb = 31 - (idx >> 4), bh = idx & 15, b = bh >> 2, h = bh & 3, q0 = qb * 128;
    constexpr int FOXBUF = 64 * 144 * 2 + 128 * 80 * 2 + 256;
    const int qrow = q0 + 16 * wave + fr;
    bf16x8 Qf[4];
    {
        const bf16* qp = PROJ + ((size_t)b * T + qrow) * INP + C_FOX_Q + h * 128 + 8 * fq;
        const float sc = 0.08838834764831845f * LOG2E;
#pragma unroll
        for (int ks = 0; ks < 4; ++ks) { const u32x4v v = *(const u32x4v*)(qp + 32 * ks); u32x4v w;
            w.x = pk2(bflo(v.x) * sc, bfhi(v.x) * sc); w.y = pk2(bflo(v.y) * sc, bfhi(v.y) * sc); w.z = pk2(bflo(v.z) * sc, bfhi(v.z) * sc); w.w = pk2(bflo(v.w) * sc, bfhi(v.w) * sc);
            Qf[ks] = __builtin_bit_cast(bf16x8, w); }
    }
    const float* Fb = FCUM + (size_t)bh * T;
    const float Fref = Fb[q0];
    const int ntile = (q0 + 128) / 64;
    f32x4 O[8];
#pragma unroll
    for (int dt = 0; dt < 8; ++dt) O[dt] = (f32x4){0.f, 0.f, 0.f, 0.f};
    float mrun = -INFINITY, lsum = 0.f;
    u32x4v rkA[2], rvA[2], rkB[2], rvB[2]; float rfA = 0.f, rfB = 0.f;
#define FOX_ISSUE(kt_, rk, rv, rf) do { const int k0_ = (ntile - 1 - (kt_)) * 64;     \
        _Pragma("unroll") for (int i = 0; i < 2; ++i) { const int p_ = tid + 512 * i; \
            rk[i] = *(const u32x4v*)(PROJ + ((size_t)b * T + k0_ + (p_ >> 4)) * INP + C_FOX_K + h * 128 + 8 * (p_ & 15)); \
            rv[i] = *(const u32x4v*)(VT + ((size_t)bh * 128 + (p_ >> 3)) * T + k0_ + 8 * (p_ & 7)); } \
        if (tid < 64) rf = (Fref - Fb[k0_ + tid]) * LOG2E; } while (0)
#define FOX_PUT(buf_, rk, rv, rf) do { bf16* Kw_ = (bf16*)(lds + (buf_) * FOXBUF); bf16* Vw_ = Kw_ + 64 * 144; float* Fw_ = (float*)(Vw_ + 128 * 80); \
        _Pragma("unroll") for (int i = 0; i < 2; ++i) { const int p_ = tid + 512 * i; \
            *(u32x4v*)(Kw_ + (p_ >> 4) * 144 + 8 * (p_ & 15)) = rk[i]; lds_put_perm(Vw_ + (p_ >> 3) * 80, 8 * (p_ & 7), rv[i]); } \
        if (tid < 64) Fw_[tid] = rf; } while (0)
#define FOX_STEP(kt_, rk, rv, rf) do { \
        if ((kt_) + 1 < ntile) FOX_PUT(((kt_) + 1) & 1, rk, rv, rf); \
        if ((kt_) + 3 < ntile) FOX_ISSUE((kt_) + 3, rk, rv, rf); \
        const bf16* Kt = (const bf16*)(lds + ((kt_) & 1) * FOXBUF); const bf16* VTt = Kt + 64 * 144; const float* Ft = (const float*)(VTt + 128 * 80); \
        const int k0 = (ntile - 1 - (kt_)) * 64; \
        if (k0 <= q0 + 16 * wave + 15) { \
            f32x4 s[4]; bf16x8 fa[8], fb[8]; \
            _Pragma("unroll") for (int q = 0; q < 8; ++q) fa[q] = *(const bf16x8*)(Kt + (16 * (q & 3) + fr) * 144 + 32 * (q >> 2) + 8 * fq); \
            SB(); \
            _Pragma("unroll") for (int q = 0; q < 8; ++q) fb[q] = *(const bf16x8*)(Kt + (16 * (q & 3) + fr) * 144 + 32 * (2 + (q >> 2)) + 8 * fq); \
            _Pragma("unroll") for (int t4 = 0; t4 < 4; ++t4) s[t4] = *(const f32x4*)(Ft + 16 * t4 + 4 * fq); \
            SB(); \
            _Pragma("unroll") for (int q = 0; q < 8; ++q) s[q & 3] = MFMA16(fa[q], Qf[q >> 2], s[q & 3]); \
            SB(); \
            _Pragma("unroll") for (int q = 0; q < 8; ++q) fa[q] = afrag_lin(VTt + (16 * q + fr) * 80, 0, fq); \
            SB(); \
            _Pragma("unroll") for (int q = 0; q < 8; ++q) s[q & 3] = MFMA16(fb[q], Qf[2 + (q >> 2)], s[q & 3]); \
            SB(); \
            _Pragma("unroll") for (int q = 0; q < 8; ++q) fb[q] = afrag_lin(VTt + (16 * q + fr) * 80, 32, fq); \
            SB(); \
            if (k0 + 63 > q0 + 16 * wave) { \
                _Pragma("unroll") for (int t4 = 0; t4 < 4; ++t4) \
                    _Pragma("unroll") for (int j = 0; j < 4; ++j) if (k0 + 16 * t4 + 4 * fq + j > qrow) s[t4][j] = -INFINITY; \
            } \
            float mx = -INFINITY; \
            _Pragma("unroll") for (int t4 = 0; t4 < 4; ++t4) mx = fmaxf(fmaxf(mx, fmaxf(s[t4][0], s[t4][1])), fmaxf(s[t4][2], s[t4][3])); \
            mx = fmaxf(mx, __shfl_xor(mx, 16)); mx = fmaxf(mx, __shfl_xor(mx, 32)); \
            const float mnew = fmaxf(mrun, mx); \
            const float alpha = __builtin_amdgcn_exp2f(mrun - mnew); \
            mrun = mnew; \
            float ps = 0.f; \
            _Pragma("unroll") for (int t4 = 0; t4 < 4; ++t4) \
                _Pragma("unroll") for (int j = 0; j < 4; ++j) { const float p = __builtin_amdgcn_exp2f(s[t4][j] - mnew); s[t4][j] = p; ps += p; } \
            lsum = lsum * alpha + ps; \
            bf16x8 Pf[2]; \
            Pf[0] = pack8(s[0], s[1]); Pf[1] = pack8(s[2], s[3]); \
            if (__builtin_amdgcn_ballot_w64(alpha != 1.f) != 0ull) {     \
                _Pragma("unroll") for (int dt = 0; dt < 8; ++dt) O[dt] = O[dt] * alpha; } \
            _Pragma("unroll") for (int dt = 0; dt < 8; ++dt) O[dt] = MFMA16(fa[dt], Pf[0], O[dt]); \
            _Pragma("unroll") for (int dt = 0; dt < 8; ++dt) O[dt] = MFMA16(fb[dt], Pf[1], O[dt]); \
        } \
        LDSBAR(); } while (0)
    FOX_ISSUE(0, rkA, rvA, rfA);
    FOX_ISSUE(1, rkB, rvB, rfB);
    FOX_PUT(0, rkA, rvA, rfA);
    if (2 < ntile) FOX_ISSUE(2, rkA, rvA, rfA);
    LDSBAR();
    for (int kt = 0; kt < ntile; kt += 2) {
        FOX_STEP(kt, rkB, rvB, rfB);
        FOX_STEP(kt + 1, rkA, rvA, rfA);
    }
#undef FOX_ISSUE
#undef FOX_STEP
#undef FOX_PUT
    lsum += __shfl_xor(lsum, 16); lsum += __shfl_xor(lsum, 32);
    const float inv = 1.f / lsum;
    bf16* yp = Y + ((size_t)b * T + qrow) * D + 1536 + h * 128 + 4 * fq;
#pragma unroll
    for (int dt = 0; dt < 8; ++dt) { const f32x4 o = O[dt] * inv; u32x2v w; w.x = pk2(o.x, o.y); w.y = pk2(o.z, o.w); *(u32x2v*)(yp + 16 * dt) = w; }
    __syncthreads();
}

__device__ __forceinline__ void phase_act(const bf16* GU, const float* cw, const float* cb, bf16* ACT) {
    const size_t gt = (size_t)fresh_bid() * 512 + fresh_tid(), GT = (size_t)gridDim.x * 512;
    constexpr int NCG = DFF / 8, RUN = 32;
    for (size_t idx = gt; idx < (size_t)NCG * (M / RUN); idx += GT) {
        const int cgp = (int)(idx % NCG), run = (int)(idx / NCG), r0 = run * RUN, c0 = cgp * 8;
        float w0[8], w1[8], w2[8], bb[8];
#pragma unroll
        for (int e = 0; e < 8; e += 4) { *(f32x4*)(w0 + e) = *(const f32x4*)(cw + c0 + e); *(f32x4*)(w1 + e) = *(const f32x4*)(cw + DFF + c0 + e);
            *(f32x4*)(w2 + e) = *(const f32x4*)(cw + 2 * DFF + c0 + e); *(f32x4*)(bb + e) = *(const f32x4*)(cb + c0 + e); }
        u32x4v g2 = {0u, 0u, 0u, 0u}, g1 = g2;
        if ((r0 % T) != 0) { g2 = *(const u32x4v*)(GU + (size_t)(r0 - 2) * (2 * DFF) + c0); g1 = *(const u32x4v*)(GU + (size_t)(r0 - 1) * (2 * DFF) + c0); }
#pragma unroll 4
        for (int r = r0; r < r0 + RUN; ++r) {
            const u32x4v g = *(const u32x4v*)(GU + (size_t)r * (2 * DFF) + c0), u = *(const u32x4v*)(GU + (size_t)r * (2 * DFF) + DFF + c0);
            u32x4v o;
#define ACT2(k, fld) { const float a0 = w0[2 * k] * bflo(g2.fld) + w1[2 * k] * bflo(g1.fld) + w2[2 * k] * bflo(g.fld) + bb[2 * k]; \
                       const float a1 = w0[2 * k + 1] * bfhi(g2.fld) + w1[2 * k + 1] * bfhi(g1.fld) + w2[2 * k + 1] * bfhi(g.fld) + bb[2 * k + 1]; \
                       o.fld = pk2(siluf_(a0) * bflo(u.fld), siluf_(a1) * bfhi(u.fld)); }
            ACT2(0, x) ACT2(1, y) ACT2(2, z) ACT2(3, w)
#undef ACT2
            *(u32x4v*)(ACT + (size_t)r * DFF + c0) = o;
            g2 = g1; g1 = g;
        }
    }
}

__device__ __forceinline__ void phase_actfix(const float* GLAST, const float* GFIRST, const float* UFIRST, const float* cw, const float* cb, bf16* ACTp) {
    const int gt = fresh_bid() * 512 + fresh_tid(), GT = gridDim.x * 512;
    constexpr int NCG = DFF / 8;
    for (int idx = gt; idx < NCG * 2 * (M / 256); idx += GT) {
        const int cgp = idx % NCG, ri = idx / NCG, i = ri & 1, pm = ri >> 1, c0 = cgp * 8;
        const bool first = (pm % (T / 256)) == 0;
        float g[8], u[8], g1[8], g2[8];
#pragma unroll
        for (int e = 0; e < 8; e += 4) {
            *(f32x4*)(g + e) = *(const f32x4*)(GFIRST + (size_t)(pm * 2 + i) * DFF + c0 + e);
            *(f32x4*)(u + e) = *(const f32x4*)(UFIRST + (size_t)(pm * 2 + i) * DFF + c0 + e);
            const f32x4 z = {0.f, 0.f, 0.f, 0.f};
            const f32x4 l1 = first ? z : *(const f32x4*)(GLAST + (size_t)((pm - 1) * 2 + 1) * DFF + c0 + e);
            const f32x4 l0 = first ? z : *(const f32x4*)(GLAST + (size_t)((pm - 1) * 2 + 0) * DFF + c0 + e);
            const f32x4 f0 = *(const f32x4*)(GFIRST + (size_t)(pm * 2 + 0) * DFF + c0 + e);
            *(f32x4*)(g1 + e) = (i == 1) ? f0 : l1;
            *(f32x4*)(g2 + e) = (i == 1) ? l1 : l0;
        }
        float o[8];
#pragma unroll
        for (int e = 0; e < 8; ++e) { const float a = cw[c0 + e] * g2[e] + cw[DFF + c0 + e] * g1[e] + cw[2 * DFF + c0 + e] * g[e] + cb[c0 + e]; o[e] = siluf_(a) * u[e]; }
        u32x4v w; w.x = pk2(o[0], o[1]); w.y = pk2(o[2], o[3]); w.z = pk2(o[4], o[5]); w.w = pk2(o[6], o[7]);
        *(u32x4v*)(ACTp + (size_t)(pm * 256 + i) * DFF + c0) = w;
    }
}

__device__ __forceinline__ void actfix_tile(int pm, const float* GLAST, const float* GFIRST, const float* UFIRST, const float* cw, const float* cb, bf16* ACTp) {
    const int tid = fresh_tid();
    constexpr int NCG = DFF / 8;
    const bool first = (pm % (T / 256)) == 0;
    for (int idx = tid; idx < 2 * NCG; idx += 512) {
        const int cgp = idx % NCG, i = idx / NCG, c0 = cgp * 8;
        unsigned pk[4];
#pragma unroll
        for (int h2 = 0; h2 < 2; ++h2) {
            const int c = c0 + 4 * h2;
            const f32x4 z = {0.f, 0.f, 0.f, 0.f};
            const f32x4 g = *(const f32x4*)(GFIRST + (size_t)(pm * 2 + i) * DFF + c), u = *(const f32x4*)(UFIRST + (size_t)(pm * 2 + i) * DFF + c);
            const f32x4 l1 = first ? z : *(const f32x4*)(GLAST + (size_t)((pm - 1) * 2 + 1) * DFF + c);
            const f32x4 l0 = first ? z : *(const f32x4*)(GLAST + (size_t)((pm - 1) * 2 + 0) * DFF + c);
            const f32x4 f0 = *(const f32x4*)(GFIRST + (size_t)(pm * 2 + 0) * DFF + c);
            const f32x4 g1 = (i == 1) ? f0 : l1, g2 = (i == 1) ? l1 : l0;
            const f32x4 w0 = *(const f32x4*)(cw + c), w1 = *(const f32x4*)(cw + DFF + c), w2 = *(const f32x4*)(cw + 2 * DFF + c), bb = *(const f32x4*)(cb + c);
            const f32x4 a = w0 * g2 + w1 * g1 + w2 * g + bb;
            const f32x4 o = {siluf_(a.x) * u.x, siluf_(a.y) * u.y, siluf_(a.z) * u.z, siluf_(a.w) * u.w};
            pk[2 * h2] = pk2(o.x, o.y); pk[2 * h2 + 1] = pk2(o.z, o.w);
        }
        u32x4v w; w.x = pk[0]; w.y = pk[1]; w.z = pk[2]; w.w = pk[3];
        *(u32x4v*)(ACTp + (size_t)(pm * 256 + i) * DFF + c0) = w;
    }
}

#ifndef GEMM_ALIGN
#define GEMM_ALIGN true
#endif
#ifndef GEMM_SP2
#define GEMM_SP2 true
#endif
#ifndef WGM_IN
#define WGM_IN 4
#endif
#ifndef WGM_OUT
#define WGM_OUT 4
#endif
#ifndef WGM_GU
#define WGM_GU 4
#endif
#ifndef WGM_DN
#define WGM_DN 4
#endif
#ifndef CREP
#define CREP 1
#endif
#ifndef CLO
#define CLO 0
#define CHI 0
#endif
#ifndef SREP
#define SREP 1
#endif
#ifndef FREP
#define FREP 1
#endif
struct Args { const float* in[24]; float* out; unsigned char* ws; };
enum { I_X = 0, I_C, I_WMOD, I_BMOD, I_NMIX, I_NFFN, I_WIN, I_GLAWLR, I_GLABLR, I_GLANORM, I_GDNCONV, I_GDNALOG, I_GDNDT, I_GDNNORM,
       I_POOLW, I_POOLSC, I_FOXB, I_WOUT, I_WGATE, I_WUP, I_FCW, I_FCB, I_WDOWN, I_NFINAL };

typedef const Args __attribute__((address_space(4)))* KArgsP;
__device__ __forceinline__ KArgsP fresh_args() { KArgsP p = (KArgsP)__builtin_amdgcn_kernarg_segment_ptr(); asm volatile("" : "+s"(p)); return p; }
#define KA fresh_args()
#define ws (KA->ws)
#define MOD ((float*)(ws + WS_MOD))
#define FCUM ((float*)(ws + WS_FCUM))
#define GLADEC ((float*)(ws + WS_GLADEC))
#define GDNDEC ((float*)(ws + WS_GDNDEC))
#define PWT ((bf16*)(ws + WS_PWT))
#define H ((bf16*)(ws + WS_H))
#define ACT ((bf16*)(ws + WS_ACT))
#define PROJ ((bf16*)(ws + WS_PROJ))
#define Y ((bf16*)(ws + WS_Y))
#define GU ((bf16*)(ws + WS_GU))
#define VT ((bf16*)(ws + WS_VT))
__global__ void __launch_bounds__(512, 2) mk_fwd(Args a) {
    extern __shared__ __attribute__((aligned(16))) unsigned char lds[];
#ifdef TEST_NOSYNC
    struct { __device__ void sync() const { __syncthreads(); } } grid;
#else
    cg::grid_group grid = cg::this_grid();
#endif
    const int G = gridDim.x;
#define bx fresh_bid()
    {
        volatile LAS unsigned* bst = (volatile LAS unsigned*)((LAS unsigned char*)lds + (LDS_BYTES - 64));
        if (threadIdx.x < 2) bst[threadIdx.x] = 0u;
        __syncthreads();
        (void)xcd_barrier_post((unsigned*)ws, bst);
    }
#define GSYNC() do { XcdBarrier b_; b_.bar = (unsigned*)ws; b_.x = xb_xcc_id(); b_.st = (volatile LAS unsigned*)((LAS unsigned char*)lds + (LDS_BYTES - 64)); xcd_barrier(b_); } while (0)
    PG8_LAS unsigned char* gl = (PG8_LAS unsigned char*)lds;

#ifndef NO_MOD
    phase_mod(KA->in[I_C], KA->in[I_WMOD], KA->in[I_BMOD], MOD, lds);
#endif
    if (KA->out == nullptr) grid.sync();
    GSYNC();
#ifdef TEST_NOLOOP
    for (int l = 0; l < 1; ++l) {
#else
#pragma unroll
    for (int l = 0; l < NL; ++l) {
#endif
        const float* modl = MOD + (size_t)l * NB * MODW;
        const float* xin = (l == 0) ? KA->in[I_X] : KA->out;
        {
            LayerW L{KA->in[I_WIN] + (size_t)l * D * INW, KA->in[I_WOUT] + (size_t)l * D * D, KA->in[I_WGATE] + (size_t)l * D * DFF, KA->in[I_WUP] + (size_t)l * D * DFF,
                     KA->in[I_WDOWN] + (size_t)l * DFF * D, KA->in[I_POOLW] + (size_t)l * 4 * 128 * 128};
#ifndef NO_TR
            phase_transpose(L, ws, lds, 0, 0, G);
#endif
            phase_norm(xin, KA->in[I_NMIX] + (size_t)l * D, modl, 0, 1, H);
        }
        GSYNC();
#ifdef DUP_A
        {
            LayerW L{KA->in[I_WIN] + (size_t)l * D * INW, KA->in[I_WOUT] + (size_t)l * D * D, KA->in[I_WGATE] + (size_t)l * D * DFF, KA->in[I_WUP] + (size_t)l * D * DFF,
                     KA->in[I_WDOWN] + (size_t)l * DFF * D, KA->in[I_POOLW] + (size_t)l * 4 * 128 * 128};
#ifndef NO_TR
            phase_transpose(L, ws, lds, 0, 0, G);
#endif
            phase_norm(xin, KA->in[I_NMIX] + (size_t)l * D, modl, 0, 1, H);
        }
        GSYNC();
#endif
        {
            pg8::Gemm g{H, (const bf16*)(ws + WS_WIN), M, INP, D}; pg8::StaticOrder S; S.init(M, INP, G, bx, WGM_IN);
            pg8::EpiStoreBf16 E{PROJ, INP};
#ifndef NO_GEMM0
            pg8::gemm_phase<pg8::EpiStoreBf16, pg8::StaticOrder, GEMM_ALIGN, GEMM_SP2>(gl, g, S, E);
#endif
        }
        GSYNC();
#ifdef DUP_B
        {
            pg8::Gemm g{H, (const bf16*)(ws + WS_WIN), M, INP, D}; pg8::StaticOrder S; S.init(M, INP, G, bx, WGM_IN);
            pg8::EpiStoreBf16 E{PROJ, INP};
#ifndef NO_GEMM0
            pg8::gemm_phase<pg8::EpiStoreBf16, pg8::StaticOrder, GEMM_ALIGN, GEMM_SP2>(gl, g, S, E);
#endif
        }
        GSYNC();
#endif
        {
            const float* conv_w = KA->in[I_GDNCONV] + (size_t)l * 4 * 1536;
            for (int rep_ = 0; rep_ < CREP; ++rep_)
            for (int it = bx; it < 4100; it += G) {
                if (rep_ > 0 && !(it >= CLO && it < CHI)) continue;
#ifndef NO_GDNP
                if (it < 1024) gdn_prep_item(it, PROJ, conv_w, KA->in[I_GDNALOG] + l * 4, KA->in[I_GDNDT] + l * 4, ws + WS_GDN, GDNDEC, lds);
                else
#endif
#ifndef NO_GLAP
                if (it < 2048) gla_prep_item(it - 1024, PROJ, KA->in[I_GLAWLR] + (size_t)l * 16 * 256, KA->in[I_GLABLR] + (size_t)l * 256, ws + WS_GLA, GLADEC, lds);
                else
#endif
#ifndef NO_POOL
                if (it < 3072) pool_item(it - 2048, PROJ, PWT, KA->in[I_POOLSC] + (size_t)l * 512, Y, lds);
                else
#endif
                if (it < 4096) vt_item(it - 3072, PROJ, VT, lds);
                else fcum_item(it - 4096, PROJ, KA->in[I_FOXB] + l * 4, FCUM, lds);
            }
        }
        GSYNC();
#ifdef DUP_C
        {
            const float* conv_w = KA->in[I_GDNCONV] + (size_t)l * 4 * 1536;
            for (int rep_ = 0; rep_ < CREP; ++rep_)
            for (int it = bx; it < 4100; it += G) {
                if (rep_ > 0 && !(it >= CLO && it < CHI)) continue;
#ifndef NO_GDNP
                if (it < 1024) gdn_prep_item(it, PROJ, conv_w, KA->in[I_GDNALOG] + l * 4, KA->in[I_GDNDT] + l * 4, ws + WS_GDN, GDNDEC, lds);
                else
#endif
#ifndef NO_GLAP
                if (it < 2048) gla_prep_item(it - 1024, PROJ, KA->in[I_GLAWLR] + (size_t)l * 16 * 256, KA->in[I_GLABLR] + (size_t)l * 256, ws + WS_GLA, GLADEC, lds);
                else
#endif
#ifndef NO_POOL
                if (it < 3072) pool_item(it - 2048, PROJ, PWT, KA->in[I_POOLSC] + (size_t)l * 512, Y, lds);
                else
#endif
                if (it < 4096) vt_item(it - 3072, PROJ, VT, lds);
                else fcum_item(it - 4096, PROJ, KA->in[I_FOXB] + l * 4, FCUM, lds);
            }
        }
        GSYNC();
#endif
        {
            for (int rep_ = 0; rep_ < SREP; ++rep_)
            for (int s = bx; s < 32; s += G) {
#ifndef NO_SCAN
                if (s < 16) scan_bh<128, true>(s, ws + WS_GDN, GDN_ITEM, GDNDEC, PROJ, C_GDN_G + (s & 3) * 128, KA->in[I_GDNNORM] + (size_t)l * 128, Y, 512 + (s & 3) * 128, lds);
                else scan_bh<64, false>(s - 16, ws + WS_GLA, GLA_ITEM, GLADEC, PROJ, C_GLA_G + (s & 3) * 128, KA->in[I_GLANORM] + (size_t)l * 128, Y, (s & 3) * 128, lds);
#endif
            }
            const int NA = (G > 32) ? G - 32 : G, ab = (G > 32) ? bx - 32 : bx;
            for (int rep_ = 0; rep_ < FREP; ++rep_)
            if (ab >= 0 && NA == 224) {
                const int fbh = ab & 15, slot = ab >> 4;
                const int n_it = (slot < 13) ? 2 : 6;
                for (int k = 0; k < n_it; ++k) {
                    const int qbk = (slot < 13) ? ((k == 0) ? 31 - slot : 5 + slot) : ((k == 0) ? 18 : 5 - k);
                    fox_item((31 - qbk) * 16 + fbh, PROJ, VT, FCUM, Y, lds);
                }
            } else
            if (ab >= 0) for (int r = 0;; ++r) { const int idx = r * NA + ((r & 1) ? NA - 1 - ab : ab); if (r * NA >= 512) break;
#ifndef NO_FOX
 if (idx < 512) fox_item(idx, PROJ, VT, FCUM, Y, lds);
#endif
 }
            {
                LayerW L{KA->in[I_WIN] + (size_t)l * D * INW, KA->in[I_WOUT] + (size_t)l * D * D, KA->in[I_WGATE] + (size_t)l * D * DFF, KA->in[I_WUP] + (size_t)l * D * DFF,
                         KA->in[I_WDOWN] + (size_t)l * DFF * D, KA->in[I_POOLW] + (size_t)l * 4 * 128 * 128};
                if (G > 32) phase_transpose(L, ws, lds, 1, 32, G - 32); else phase_transpose(L, ws, lds, 1, 0, G);
            }
        }
        GSYNC();
#ifdef DUP_D
        {
            for (int rep_ = 0; rep_ < SREP; ++rep_)
            for (int s = bx; s < 32; s += G) {
#ifndef NO_SCAN
                if (s < 16) scan_bh<128, true>(s, ws + WS_GDN, GDN_ITEM, GDNDEC, PROJ, C_GDN_G + (s & 3) * 128, KA->in[I_GDNNORM] + (size_t)l * 128, Y, 512 + (s & 3) * 128, lds);
                else scan_bh<64, false>(s - 16, ws + WS_GLA, GLA_ITEM, GLADEC, PROJ, C_GLA_G + (s & 3) * 128, KA->in[I_GLANORM] + (size_t)l * 128, Y, (s & 3) * 128, lds);
#endif
            }
            const int NA = (G > 32) ? G - 32 : G, ab = (G > 32) ? bx - 32 : bx;
            for (int rep_ = 0; rep_ < FREP; ++rep_)
            if (ab >= 0 && NA == 224) {
                const int fbh = ab & 15, slot = ab >> 4;
                const int n_it = (slot < 13) ? 2 : 6;
                for (int k = 0; k < n_it; ++k) {
                    const int qbk = (slot < 13) ? ((k == 0) ? 31 - slot : 5 + slot) : ((k == 0) ? 18 : 5 - k);
                    fox_item((31 - qbk) * 16 + fbh, PROJ, VT, FCUM, Y, lds);
                }
            } else
            if (ab >= 0) for (int r = 0;; ++r) { const int idx = r * NA + ((r & 1) ? NA - 1 - ab : ab); if (r * NA >= 512) break;
#ifndef NO_FOX
 if (idx < 512) fox_item(idx, PROJ, VT, FCUM, Y, lds);
#endif
 }
            {
                LayerW L{KA->in[I_WIN] + (size_t)l * D * INW, KA->in[I_WOUT] + (size_t)l * D * D, KA->in[I_WGATE] + (size_t)l * D * DFF, KA->in[I_WUP] + (size_t)l * D * DFF,
                         KA->in[I_WDOWN] + (size_t)l * DFF * D, KA->in[I_POOLW] + (size_t)l * 4 * 128 * 128};
                if (G > 32) phase_transpose(L, ws, lds, 1, 32, G - 32); else phase_transpose(L, ws, lds, 1, 0, G);
            }
        }
        GSYNC();
#endif
        phase_mixnorm(PROJ, KA->in[I_GLANORM] + (size_t)l * 128, KA->in[I_GDNNORM] + (size_t)l * 128, Y);
        GSYNC();
        {
            pg8::Gemm g{Y, (const bf16*)(ws + WS_WOUT), M, D, D}; pg8::StaticOrder S; S.init(M, D, G, bx, WGM_OUT);
            pg8::EpiResid E{xin, KA->out, modl + 2 * D, D, MODW, T};
#ifndef NO_GEMM1
            pg8::gemm_phase<pg8::EpiResid, pg8::StaticOrder, GEMM_ALIGN, GEMM_SP2>(gl, g, S, E);
#endif
        }
        GSYNC();
#ifdef DUP_E
        if (l == 0) {
        {
            pg8::Gemm g{Y, (const bf16*)(ws + WS_WOUT), M, D, D}; pg8::StaticOrder S; S.init(M, D, G, bx, WGM_OUT);
            pg8::EpiResid E{xin, KA->out, modl + 2 * D, D, MODW, T};
#ifndef NO_GEMM1
            pg8::gemm_phase<pg8::EpiResid, pg8::StaticOrder, GEMM_ALIGN, GEMM_SP2>(gl, g, S, E);
#endif
        }
        GSYNC();
        }
#endif
        phase_norm(KA->out, KA->in[I_NFFN] + (size_t)l * D, modl, 3, 4, H);
        GSYNC();
#ifdef DUP_F
        phase_norm(KA->out, KA->in[I_NFFN] + (size_t)l * D, modl, 3, 4, H);
        GSYNC();
#endif
        {
            pg8::Gemm g{H, (const bf16*)(ws + WS_WGU), M, 2 * DFF, D}; pg8::StaticOrder S; S.init(M, 2 * DFF, G, bx, WGM_GU);
            pg8::EpiGateUp E{ACT, KA->in[I_FCW] + (size_t)l * 3 * DFF, KA->in[I_FCB] + (size_t)l * DFF, (float*)(ws + WS_SIDE), (float*)(ws + WS_SIDE) + (size_t)128 * DFF, (float*)(ws + WS_SIDE) + (size_t)256 * DFF,
                              (PG8_LAS float*)(gl + 131072), DFF};
            pg8::gemm_phase<pg8::EpiGateUp, pg8::StaticOrder, GEMM_ALIGN, GEMM_SP2>(gl, g, S, E);
        }
        GSYNC();
        if (G == 256) {
            const int c_ = bx;
#pragma unroll
            for (int i_ = 0; i_ < (M / 256) * (D / 256) / 256; ++i_) {
                constexpr int nM_ = M / 256, nN_ = D / 256, nwg_ = nM_ * nN_, q_ = nwg_ / 8;
                const int L_ = i_ * 256 + c_, wg_ = (L_ % 8) * q_ + L_ / 8;
                const int nig_ = WGM_DN * nN_, fm_ = (wg_ / nig_) * WGM_DN, gsz_ = (nM_ - fm_) < WGM_DN ? (nM_ - fm_) : WGM_DN;
                const int pm_ = fm_ + ((wg_ % nig_) % gsz_);
                actfix_tile(pm_, (const float*)(ws + WS_SIDE), (const float*)(ws + WS_SIDE) + (size_t)128 * DFF, (const float*)(ws + WS_SIDE) + (size_t)256 * DFF,
                            KA->in[I_FCW] + (size_t)l * 3 * DFF, KA->in[I_FCB] + (size_t)l * DFF, ACT); }
            asm volatile("s_waitcnt vmcnt(0)" ::: "memory"); __syncthreads();
        } else {
            phase_actfix((const float*)(ws + WS_SIDE), (const float*)(ws + WS_SIDE) + (size_t)128 * DFF, (const float*)(ws + WS_SIDE) + (size_t)256 * DFF,
                         KA->in[I_FCW] + (size_t)l * 3 * DFF, KA->in[I_FCB] + (size_t)l * DFF, ACT);
            GSYNC();
        }
        {
            pg8::Gemm g{ACT, (const bf16*)(ws + WS_WDN), M, D, DFF}; pg8::StaticOrder S; S.init(M, D, G, bx, WGM_DN);
            pg8::EpiResid E{KA->out, KA->out, modl + 5 * D, D, MODW, T};
#ifndef NO_GEMM3
            pg8::gemm_phase<pg8::EpiResid, pg8::StaticOrder, GEMM_ALIGN, GEMM_SP2>(gl, g, S, E);
#endif
        }
        GSYNC();
    }
#ifdef XSYNC
    for (int i_ = 0; i_ < XSYNC; ++i_) GSYNC();
#endif
    phase_final_norm(KA->out, KA->in[I_NFINAL]);
}

#undef KA
#undef ws
#undef MOD
#undef FCUM
#undef GLADEC
#undef GDNDEC
#undef PWT
#undef H
#undef ACT
#undef PROJ
#undef Y
#undef GU
#undef VT
#undef bx
extern "C" void kernel_launch(void* const* d_in, const int* in_sizes, int n_in, void* d_out, int out_size, void* d_ws, size_t ws_size, hipStream_t stream) {
    static int grid = 0;
    if (grid == 0) {
        int dev = 0, cus = 0, per_cu = 0;
        (void)hipGetDevice(&dev);
        (void)hipDeviceGetAttribute(&cus, hipDeviceAttributeMultiprocessorCount, dev);
        (void)hipFuncSetAttribute((const void*)mk_fwd, hipFuncAttributeMaxDynamicSharedMemorySize, LDS_BYTES);
        (void)hipOccupancyMaxActiveBlocksPerMultiprocessor(&per_cu, (const void*)mk_fwd, 512, LDS_BYTES);
        if (per_cu < 1) fprintf(stderr, "kernel_launch: occupancy query reports %d blocks per CU\n", per_cu);
        if (n_in != 24 || out_size != M * D || ws_size < WS_END) { fprintf(stderr, "kernel_launch: unexpected shapes (n_in %d out %d ws %zu)\n", n_in, out_size, ws_size); grid = -1; return; }
        grid = cus > 0 ? cus : 256;
    }
    if (grid < 0) return;
    if (hipMemsetAsync(d_ws, 0, 65536, stream) != hipSuccess) { fprintf(stderr, "kernel_launch: memset of the barrier words failed\n"); return; }
    Args a{};
    for (int i = 0; i < 24; ++i) a.in[i] = (const float*)d_in[i];
    a.out = (float*)d_out; a.ws = (unsigned char*)d_ws;
    void* args[] = {&a};
    hipError_t e = hipLaunchCooperativeKernel((const void*)mk_fwd, dim3(grid), dim3(512), args, LDS_BYTES, stream);
    if (e != hipSuccess) fprintf(stderr, "kernel_launch: cooperative launch failed: %s (grid %d)\n", hipGetErrorString(e), grid);
}
```

```cpp
#include <hip/hip_runtime.h>
#include <hip/hip_cooperative_groups.h>
#include <cstdio>
#include <cstdint>
namespace cg = cooperative_groups;
#ifndef PG8_WGM
#define PG8_WGM 8
#endif
__device__ __forceinline__ int fresh_tid() { int t = threadIdx.x; asm volatile("" : "+v"(t)); return t; }
__device__ __forceinline__ int fresh_bid() { int t = blockIdx.x; asm volatile("" : "+s"(t)); return t; }
namespace pg8 {
#define PG8_LAS __attribute__((address_space(3)))
typedef unsigned short bf16_t;
typedef short bf16x8 __attribute__((ext_vector_type(8)));
typedef float f32x4 __attribute__((ext_vector_type(4)));
typedef unsigned u32x4 __attribute__((ext_vector_type(4)));
constexpr int BM = 256, BK = 64, HALF = 128, HTB = HALF * BK * 2  , STAGE_BYTES = 8 * HTB, NXCD = 8, WGM = PG8_WGM;

__host__ __device__ __forceinline__ int lds_byte(int r, int c) { const int st = (r >> 4) * 2 + (c >> 5), rr = r & 15, cc = c & 31, ob = rr * 64 + cc * 2; return st * 1024 + (ob ^ (((ob >> 9) & 1) << 5)); }
__host__ __device__ __forceinline__ void stage_rc(int b, int& R, int& C) { const int st = b / 1024, sb = b % 1024, swz = sb ^ (((sb >> 9) & 1) << 5); R = (st >> 1) * 16 + swz / 64; C = (st & 1) * 32 + (swz % 64) / 2; }
__host__ __device__ __forceinline__ int perm32(int rho) { const int n = rho >> 4, i = rho & 15; return 8 * (i >> 2) + 4 * n + (i & 3); }

struct Unit { int pm, pn; };
struct Gemm { const bf16_t* A; const bf16_t* Bt; int M, N, K; };

struct StaticOrder {
    int nM, nN, nwg, G, c, wgm;
    __host__ __device__ void init(int M, int N, int G_, int c_, int wgm_ = WGM) { nM = M / BM; nN = N / BM; nwg = nM * nN; G = G_; c = c_; wgm = wgm_; }
    __host__ __device__ bool next(int i, Unit& u) const {
        const long L = (long)i * G + c; if (L >= nwg) return false;
        int wgid = (int)L; { const int q = nwg / NXCD, r = nwg % NXCD, xcd = wgid % NXCD, off = wgid / NXCD; wgid = (xcd < r ? xcd * (q + 1) : r * (q + 1) + (xcd - r) * q) + off; }
        const int nig = wgm * nN, gid = wgid / nig, fm = gid * wgm, gsz = (nM - fm) < wgm ? (nM - fm) : wgm;
        u.pm = fm + ((wgid % nig) % gsz); u.pn = (wgid % nig) / gsz; return true;
    }
    __device__ __forceinline__ void a_ready(const Unit&) const {}
    __device__ __forceinline__ void done(const Unit&) const {}
};

__device__ __forceinline__ unsigned cvt_pk_bf16(float lo, float hi) { unsigned r; asm volatile("v_cvt_pk_bf16_f32 %0, %1, %2" : "=v"(r) : "v"(lo), "v"(hi)); return r; }
typedef unsigned u32x4 __attribute__((ext_vector_type(4)));
struct EpiStoreBf16 {
    static constexpr bool PERM = true, AFTER_DRAIN = false;
    bf16_t* O; int ldc;
    __device__ __forceinline__ void operator()(const f32x4 (&acc)[2][2][4][2], const Unit& u, int wr, int wc, int fr, int fq) const {
        const int row0 = u.pm * BM + wr * 64 + fr; const int col0 = u.pn * BM + wc * 32 + 8 * fq;
#pragma unroll
        for (int ai = 0; ai < 2; ++ai)
#pragma unroll
            for (int m = 0; m < 4; ++m) { bf16_t* rowp = O + (size_t)(row0 + ai * HALF + m * 16) * ldc + col0;
#pragma unroll
                for (int bj = 0; bj < 2; ++bj) { const f32x4 v0 = acc[ai][bj][m][0], v1 = acc[ai][bj][m][1];
                    u32x4 w; w.x = cvt_pk_bf16(v0[0], v0[1]); w.y = cvt_pk_bf16(v0[2], v0[3]); w.z = cvt_pk_bf16(v1[0], v1[1]); w.w = cvt_pk_bf16(v1[2], v1[3]);
                    *(u32x4*)(rowp + bj * HALF) = w; } }
    }
};
struct EpiResid {
    static constexpr bool PERM = false, AFTER_DRAIN = false;
    const float* base; float* out; const float* gate; int ldc; int gpitch; int rows_per_batch;
    __device__ __forceinline__ void operator()(const f32x4 (&acc)[2][2][4][2], const Unit& u, int wr, int wc, int fr, int fq) const {
        const int row0 = u.pm * BM + wr * 64 + fr; const int col0 = u.pn * BM + wc * 32 + 4 * fq;
        const float* g = gate + (size_t)((u.pm * BM) / rows_per_batch) * gpitch + col0;
        f32x4 gv[2][2];
#pragma unroll
        for (int bj = 0; bj < 2; ++bj)
#pragma unroll
            for (int n = 0; n < 2; ++n) gv[bj][n] = *(const f32x4*)(g + bj * HALF + n * 16);
        f32x4 pb[3][4];
#define ER_LOAD(G_, D_) do { const size_t off_ = (size_t)(row0 + ((G_) >> 2) * HALF + ((G_) & 3) * 16) * ldc + col0; \
        _Pragma("unroll") for (int q_ = 0; q_ < 4; ++q_) D_[q_] = *(const f32x4*)(base + off_ + (q_ >> 1) * HALF + (q_ & 1) * 16); } while (0)
        ER_LOAD(0, pb[0]); ER_LOAD(1, pb[1]);
#pragma unroll
        for (int G = 0; G < 8; ++G) {
            if (G + 2 < 8) ER_LOAD(G + 2, pb[(G + 2) % 3]);
            __builtin_amdgcn_sched_barrier(0);
            const int ai = G >> 2, m = G & 3;
            const size_t off = (size_t)(row0 + ai * HALF + m * 16) * ldc + col0;
#pragma unroll
            for (int q = 0; q < 4; ++q) { const int bj = q >> 1, n = q & 1;
                *(f32x4*)(out + off + bj * HALF + n * 16) = pb[G % 3][q] + gv[bj][n] * acc[ai][bj][m][n]; }
            __builtin_amdgcn_sched_barrier(0);
        }
#undef ER_LOAD
    }
};
template <int N> __device__ __forceinline__ float dpp_ror(float v) { return __builtin_bit_cast(float, __builtin_amdgcn_update_dpp(0, __builtin_bit_cast(int, v), 0x120 + N, 0xf, 0xf, false)); }
struct EpiGateUp {
    static constexpr bool PERM = true, AFTER_DRAIN = false;
    bf16_t* ACT; const float* cw; const float* cb; float* GLAST; float* GFIRST; float* UFIRST; PG8_LAS float* XL; int dff;
    __device__ __forceinline__ void operator()(const f32x4 (&acc)[2][2][4][2], const Unit& u, int wr, int wc, int fr, int fq) const {
        const int ch0 = u.pn * 128 + wc * 32 + 8 * fq;
        float w0[8], w1[8], w2[8], bb[8];
#pragma unroll
        for (int n = 0; n < 2; ++n) { const f32x4 a = *(const f32x4*)(cw + ch0 + 4 * n), b = *(const f32x4*)(cw + dff + ch0 + 4 * n), c = *(const f32x4*)(cw + 2 * dff + ch0 + 4 * n), d = *(const f32x4*)(cb + ch0 + 4 * n);
#pragma unroll
            for (int j = 0; j < 4; ++j) { w0[4 * n + j] = a[j]; w1[4 * n + j] = b[j]; w2[4 * n + j] = c[j]; bb[4 * n + j] = d[j]; } }
        if (fr >= 14) {
#pragma unroll
            for (int ai = 0; ai < 2; ++ai)
#pragma unroll
                for (int n = 0; n < 2; ++n) *(PG8_LAS f32x4*)(XL + ((((ai * 2 + wr) * 4 + wc) * 2 + (fr - 14)) * 32 + 8 * fq + 4 * n)) = acc[ai][0][3][n];
            if (wr == 1) {
#pragma unroll
                for (int n = 0; n < 2; ++n) *(f32x4*)(GLAST + (size_t)(u.pm * 2 + (fr - 14)) * dff + ch0 + 4 * n) = acc[1][0][3][n];
            }
        }
        if (wr == 0 && fr < 2) {
#pragma unroll
            for (int n = 0; n < 2; ++n) { *(f32x4*)(GFIRST + (size_t)(u.pm * 2 + fr) * dff + ch0 + 4 * n) = acc[0][0][0][n]; *(f32x4*)(UFIRST + (size_t)(u.pm * 2 + fr) * dff + ch0 + 4 * n) = acc[0][1][0][n]; }
        }
        asm volatile("s_waitcnt lgkmcnt(0)" ::: "memory"); __builtin_amdgcn_s_barrier(); asm volatile("" ::: "memory");
        const int row0 = u.pm * BM + wr * 64 + fr;
#pragma unroll
        for (int ai = 0; ai < 2; ++ai) {
            float pv[8];
            {
                const int sai = (wr == 1) ? ai : 0, swr = (wr == 1) ? 0 : 1;
                const bool have = (wr == 1) || (ai == 1);
                PG8_LAS const float* src = XL + ((((sai * 2 + swr) * 4 + wc) * 2 + ((fr == 15) ? 1 : 0)) * 32 + 8 * fq);
                const f32x4 x0 = *(PG8_LAS const f32x4*)src, x1 = *(PG8_LAS const f32x4*)(src + 4);
#pragma unroll
                for (int j = 0; j < 4; ++j) { pv[j] = have ? x0[j] : 0.f; pv[4 + j] = have ? x1[j] : 0.f; }
            }
            float r1p[8], r2p[8];
#pragma unroll
            for (int e = 0; e < 8; ++e) { r1p[e] = dpp_ror<1>(pv[e]); r2p[e] = dpp_ror<2>(pv[e]); }
#pragma unroll
            for (int m = 0; m < 4; ++m) {
                u32x4 w;
                unsigned pk[4];
#pragma unroll
                for (int n = 0; n < 2; ++n) {
                    float o[4];
#pragma unroll
                    for (int j = 0; j < 4; ++j) {
                        const int e = 4 * n + j;
                        const float g = acc[ai][0][m][n][j], up = acc[ai][1][m][n][j];
                        const float g1s = dpp_ror<1>(g), g2s = dpp_ror<2>(g);
                        const float g1 = (fr >= 1) ? g1s : r1p[e], g2 = (fr >= 2) ? g2s : r2p[e];
                        r1p[e] = g1s; r2p[e] = g2s;
                        const float a = w0[e] * g2 + w1[e] * g1 + w2[e] * g + bb[e];
                        o[j] = a * __builtin_amdgcn_rcpf(1.f + __expf(-a)) * up;
                    }
                    pk[2 * n] = cvt_pk_bf16(o[0], o[1]); pk[2 * n + 1] = cvt_pk_bf16(o[2], o[3]);
                }
                w.x = pk[0]; w.y = pk[1]; w.z = pk[2]; w.w = pk[3];
                *(u32x4*)(ACT + (size_t)(row0 + ai * HALF + m * 16) * dff + ch0) = w;
            }
        }
    }
};
template <class Epi, class Sched, bool ALIGN_EPI = false, bool SP2 = false>
__device__ __forceinline__ void gemm_phase(PG8_LAS unsigned char* lds, const Gemm g, const Sched& S, const Epi& E) {
    const int tid = fresh_tid(), wid = __builtin_amdgcn_readfirstlane(tid >> 6), lane = tid & 63, wr = wid >> 2, wc = wid & 3, fr = lane & 15, fq = lane >> 4;
    const int K = g.K, nt = K / BK;
    unsigned voffA[2], voffB[2];
#pragma unroll
    for (int i = 0; i < 2; ++i) { int R, C; stage_rc(tid * 16 + i * 8192, R, C); const int Rb = Epi::PERM ? ((R & ~31) + perm32(R & 31)) : R;
        voffA[i] = (unsigned)(R * K + C) * 2u; voffB[i] = (unsigned)(Rb * K + C) * 2u; }
    const size_t kstep = (size_t)(BK * 2);
    const size_t hstep = (size_t)HALF * K * 2;
    const size_t tstep = 2 * hstep;
    const unsigned ldsw = (unsigned)wid * 1024u;
    const int aoff = lds_byte(wr * 64 + fr, fq * 8), boff = lds_byte(wc * 32 + fr, fq * 8);
#define PG8_SA(b, h) (((b) * 2 + (h)) * HTB)
#define PG8_SB(b, h) ((4 + (b) * 2 + (h)) * HTB)
#define PG8_STAGE(bufoff, gbase, voff) do { _Pragma("unroll") for (int _i = 0; _i < 2; ++_i) \
        __builtin_amdgcn_global_load_lds((const unsigned*)((const char*)(gbase) + (voff)[_i]), (PG8_LAS unsigned*)(lds + (bufoff) + ldsw + _i * 8192), 16, 0, 0); } while (0)
#define PG8_LDA(dst, b, h) do { _Pragma("unroll") for (int m = 0; m < 4; ++m) _Pragma("unroll") for (int k = 0; k < 2; ++k) dst[m][k] = *(const PG8_LAS bf16x8*)(lds + PG8_SA(b, h) + aoff + m * 2048 + k * 1024); } while (0)
#define PG8_LDB(dst, b, h) do { _Pragma("unroll") for (int n = 0; n < 2; ++n) _Pragma("unroll") for (int k = 0; k < 2; ++k) dst[n][k] = *(const PG8_LAS bf16x8*)(lds + PG8_SB(b, h) + boff + n * 2048 + k * 1024); } while (0)
#define PG8_MMA(ai, bj, At, Bt) do { __builtin_amdgcn_s_setprio(1); _Pragma("unroll") for (int m = 0; m < 4; ++m) _Pragma("unroll") for (int n = 0; n < 2; ++n) _Pragma("unroll") for (int k = 0; k < 2; ++k) \
        acc[ai][bj][m][n] = __builtin_amdgcn_mfma_f32_16x16x32_bf16(Bt[n][k], At[m][k], acc[ai][bj][m][n], 0, 0, 0); __builtin_amdgcn_s_setprio(0); } while (0)
#define PG8_WAIT_V(n) asm volatile("s_waitcnt vmcnt(" #n ")" ::: "memory")
#define PG8_WAIT_L(n) asm volatile("s_waitcnt lgkmcnt(" #n ")" ::: "memory")
#define PG8_BAR __builtin_amdgcn_s_barrier()
#define PG8_SCHED __builtin_amdgcn_sched_barrier(0)
    Unit cur, nxt; int ui = 0;
    if (!S.next(0, cur)) return;
    f32x4 acc[2][2][4][2];
#pragma unroll
    for (int a = 0; a < 2; ++a)
#pragma unroll
        for (int b = 0; b < 2; ++b)
#pragma unroll
            for (int m = 0; m < 4; ++m)
#pragma unroll
                for (int n = 0; n < 2; ++n) acc[a][b][m][n] = (f32x4){0.f, 0.f, 0.f, 0.f};
    bf16x8 At[4][2], B0[2][2], B1[2][2];
    const char* cA = (const char*)g.A + (size_t)cur.pm * tstep; const char* cB = (const char*)g.Bt + (size_t)cur.pn * tstep;
    S.a_ready(cur);
    if constexpr (SP2) {
        PG8_STAGE(PG8_SB(0, 0), cB, voffB); PG8_STAGE(PG8_SB(0, 1), cB + hstep, voffB); PG8_STAGE(PG8_SA(0, 0), cA, voffA); PG8_STAGE(PG8_SA(0, 1), cA + hstep, voffA);
        if (wr == 1) PG8_BAR;
        PG8_WAIT_V(2); PG8_BAR;
        PG8_STAGE(PG8_SB(1, 0), cB + kstep, voffB); PG8_STAGE(PG8_SA(1, 0), cA + kstep, voffA); PG8_STAGE(PG8_SB(1, 1), cB + hstep + kstep, voffB);
        PG8_WAIT_V(6); PG8_BAR;
    } else {
        PG8_STAGE(PG8_SB(0, 0), cB, voffB); PG8_STAGE(PG8_SA(0, 0), cA, voffA); PG8_STAGE(PG8_SB(0, 1), cB + hstep, voffB); PG8_STAGE(PG8_SA(0, 1), cA + hstep, voffA);
        if (wr == 1) PG8_BAR;
        PG8_WAIT_V(4); PG8_BAR;
        PG8_STAGE(PG8_SB(1, 0), cB + kstep, voffB); PG8_STAGE(PG8_SA(1, 0), cA + kstep, voffA); PG8_STAGE(PG8_SB(1, 1), cB + hstep + kstep, voffB);
        PG8_WAIT_V(6); PG8_BAR;
    }
    for (;;) {
        const bool has_next = S.next(ui + 1, nxt);
        const char* nA = has_next ? (const char*)g.A + (size_t)nxt.pm * tstep : cA; const char* nB = has_next ? (const char*)g.Bt + (size_t)nxt.pn * tstep : cB;
        for (int t = 0; t < nt; t += 2) {
            const bool last = (t == nt - 2);
            const char* a1 = cA + (size_t)(t + 1) * kstep;
            const char* a2 = last ? nA : cA + (size_t)(t + 2) * kstep; const char* b2 = last ? nB : cB + (size_t)(t + 2) * kstep;
            const char* a3 = a2 + kstep; const char* b3 = b2 + kstep;
            if (last && has_next) S.a_ready(nxt);
            if constexpr (SP2) {
            PG8_LDB(B0, 0, 0); PG8_LDB(B1, 0, 1); PG8_SCHED; PG8_LDA(At, 0, 0); PG8_STAGE(PG8_SA(1, 1), a1 + hstep, voffA);
            PG8_WAIT_V(8); PG8_WAIT_L(0); PG8_BAR; PG8_MMA(0, 0, At, B0); PG8_MMA(0, 1, At, B1); PG8_BAR; PG8_SCHED;
            PG8_LDA(At, 0, 1); PG8_STAGE(PG8_SB(0, 0), b2, voffB); PG8_STAGE(PG8_SB(0, 1), b2 + hstep, voffB); PG8_STAGE(PG8_SA(0, 0), a2, voffA);
            PG8_WAIT_V(8); PG8_WAIT_L(0); PG8_BAR; PG8_MMA(1, 0, At, B0); PG8_MMA(1, 1, At, B1); PG8_BAR; PG8_SCHED;
            PG8_LDB(B0, 1, 0); PG8_LDB(B1, 1, 1); PG8_SCHED; PG8_LDA(At, 1, 0); PG8_STAGE(PG8_SA(0, 1), a2 + hstep, voffA);
            PG8_WAIT_V(8); PG8_WAIT_L(0); PG8_BAR; PG8_MMA(0, 0, At, B0); PG8_MMA(0, 1, At, B1); PG8_BAR; PG8_SCHED;
            PG8_LDA(At, 1, 1); PG8_STAGE(PG8_SB(1, 0), b3, voffB); PG8_STAGE(PG8_SB(1, 1), b3 + hstep, voffB); PG8_STAGE(PG8_SA(1, 0), a3, voffA);
            PG8_WAIT_V(8); PG8_WAIT_L(0); PG8_BAR; PG8_MMA(1, 0, At, B0); PG8_MMA(1, 1, At, B1); PG8_BAR; PG8_SCHED;
            } else {
            PG8_LDB(B0, 0, 0); PG8_SCHED; PG8_LDA(At, 0, 0); PG8_STAGE(PG8_SA(1, 1), a1 + hstep, voffA);
            PG8_WAIT_L(8); PG8_BAR; PG8_WAIT_L(0); PG8_MMA(0, 0, At, B0); PG8_BAR; PG8_SCHED;
            PG8_LDB(B1, 0, 1); PG8_STAGE(PG8_SB(0, 0), b2, voffB);
            PG8_BAR; PG8_WAIT_L(0); PG8_MMA(0, 1, At, B1); PG8_BAR;
            PG8_LDA(At, 0, 1); PG8_STAGE(PG8_SA(0, 0), a2, voffA);
            PG8_BAR; PG8_WAIT_L(0); PG8_MMA(1, 0, At, B0); PG8_BAR; PG8_SCHED;
            PG8_STAGE(PG8_SB(0, 1), b2 + hstep, voffB);
            PG8_WAIT_V(6); PG8_BAR; PG8_MMA(1, 1, At, B1); PG8_BAR;
            PG8_LDB(B0, 1, 0); PG8_SCHED; PG8_LDA(At, 1, 0); PG8_STAGE(PG8_SA(0, 1), a2 + hstep, voffA);
            PG8_WAIT_L(8); PG8_BAR; PG8_WAIT_L(0); PG8_MMA(0, 0, At, B0); PG8_BAR; PG8_SCHED;
            PG8_LDB(B1, 1, 1); PG8_STAGE(PG8_SB(1, 0), b3, voffB);
            PG8_BAR; PG8_WAIT_L(0); PG8_MMA(0, 1, At, B1); PG8_BAR;
            PG8_LDA(At, 1, 1); PG8_STAGE(PG8_SA(1, 0), a3, voffA);
            PG8_BAR; PG8_WAIT_L(0); PG8_MMA(1, 0, At, B0); PG8_BAR; PG8_SCHED;
            PG8_STAGE(PG8_SB(1, 1), b3 + hstep, voffB);
            PG8_WAIT_V(6); PG8_BAR; PG8_MMA(1, 1, At, B1); PG8_BAR;
            }
        }
        if constexpr (ALIGN_EPI) { if (wr == 0) PG8_BAR; }
        if constexpr (!Epi::AFTER_DRAIN) { E(acc, cur, wr, wc, fr, fq); S.done(cur); }
        if (!has_next) break;
#pragma unroll
        for (int a = 0; a < 2; ++a)
#pragma unroll
            for (int b = 0; b < 2; ++b)
#pragma unroll
                for (int m = 0; m < 4; ++m)
#pragma unroll
                    for (int n = 0; n < 2; ++n) acc[a][b][m][n] = (f32x4){0.f, 0.f, 0.f, 0.f};
        cur = nxt; cA = nA; cB = nB; ++ui;
        if constexpr (ALIGN_EPI) { if (wr == 1) PG8_BAR; }
    }
    PG8_WAIT_V(0);
    if constexpr (!ALIGN_EPI) { if (wr == 0) PG8_BAR; }
    PG8_BAR;
    if constexpr (Epi::AFTER_DRAIN) { E.fused(acc, cur, wr, wc, fr, fq, lds, wid, lane); S.done(cur); }
#undef PG8_SA
#undef PG8_SB
#undef PG8_STAGE
#undef PG8_LDA
#undef PG8_LDB
#undef PG8_MMA
#undef PG8_WAIT_V
#undef PG8_WAIT_L
#undef PG8_BAR
#undef PG8_SCHED
}
}
#define LAS __attribute__((address_space(3)))
#define XB_TMO      128
#define XB_XCNT(j)  (256  + 64 * (j))
#define XB_XSUB(j)  (1280 + 64 * (j))
#define XB_XGEN(j)  (2304 + 64 * (j))
#define XB_TOP      3328
#define XB_TOPGEN   3392
#define XCD_BAR_WORDS 3456
#define XB_SPIN_CAP (1u << 18)

__device__ __forceinline__ unsigned xb_ld(unsigned* p)              { return __hip_atomic_load(p, __ATOMIC_RELAXED, __HIP_MEMORY_SCOPE_AGENT); }
__device__ __forceinline__ unsigned xb_add(unsigned* p, unsigned v) { return __hip_atomic_fetch_add(p, v, __ATOMIC_RELAXED, __HIP_MEMORY_SCOPE_AGENT); }
__device__ __forceinline__ unsigned xb_xcc_id() { return (unsigned)__builtin_amdgcn_s_getreg((3 << 11) | 20) & 0xFu; }
#define XB_SPIN(cond, bar) do { unsigned _sp = 0; while (cond) { __builtin_amdgcn_s_sleep(1); \
    if ((++_sp & 255u) == 0u) { if (xb_ld(&(bar)[XB_TMO])) break; if (_sp > XB_SPIN_CAP) { atomicAdd(&(bar)[XB_TMO], 1u); break; } } } } while (0)

struct XcdBarrier {
    unsigned* bar; unsigned x;
    volatile LAS unsigned* st;
};

__device__ __forceinline__ XcdBarrier xcd_barrier_post(unsigned* bar, volatile LAS unsigned* st) {
    XcdBarrier b; b.bar = bar; b.x = xb_xcc_id(); b.st = st;
    if (threadIdx.x == 0) (void)xb_add(&bar[XB_XCNT(b.x)], 1u);
    return b;
}
__device__ __forceinline__ void xcd_barrier_complete(unsigned* bar, unsigned x, unsigned& nloc, unsigned& nx) {
    const unsigned G = gridDim.x * gridDim.y * gridDim.z;
    unsigned sum, cnt, mine, sp = 0u;
    for (;;) {
        sum = 0u; cnt = 0u; mine = 0u;
#pragma unroll
        for (unsigned j = 0; j < 16; ++j) { const unsigned c = xb_ld(&bar[XB_XCNT(j)]); sum += c; cnt += (c > 0u) ? 1u : 0u; mine = (j == x) ? c : mine; }
        if (sum == G) break;
        __builtin_amdgcn_s_sleep(1);
        if ((++sp & 255u) == 0u) { if (xb_ld(&bar[XB_TMO])) break; if (sp > XB_SPIN_CAP) { atomicAdd(&bar[XB_TMO], 1u); break; } }
    }
    nloc = mine > 0u ? mine : 1u; nx = cnt > 0u ? cnt : 1u;
}

__device__ __forceinline__ void xcd_barrier(const XcdBarrier& b) {
    asm volatile("s_waitcnt vmcnt(0)" ::: "memory");
    __syncthreads();
    if (threadIdx.x == 0) {
        unsigned* bar = b.bar;
        __builtin_amdgcn_s_waitcnt(0);
        unsigned nloc = b.st[0], nx = b.st[1];
        if (nloc == 0u) { xcd_barrier_complete(bar, b.x, nloc, nx); b.st[0] = nloc; b.st[1] = nx; }
        const unsigned old = xb_add(&bar[XB_XSUB(b.x)], 1u);
        const unsigned gen = old / nloc;
        if (old + 1u == (gen + 1u) * nloc) {
            __builtin_amdgcn_fence(__ATOMIC_RELEASE, "agent");
            asm volatile("s_waitcnt vmcnt(0)" ::: "memory");
            const unsigned og = xb_add(&bar[XB_TOP], 1u);
            const unsigned tg = og / nx;
            if (og + 1u == (tg + 1u) * nx) xb_add(&bar[XB_TOPGEN], 1u);
            else XB_SPIN(xb_ld(&bar[XB_TOPGEN]) == tg, bar);
            __builtin_amdgcn_fence(__ATOMIC_ACQUIRE, "agent");
            xb_add(&bar[XB_XGEN(b.x)], 1u);
            asm volatile("s_waitcnt vmcnt(0)" ::: "memory");
        } else {
            XB_SPIN(xb_ld(&bar[XB_XGEN(b.x)]) == gen, bar);
            __builtin_amdgcn_fence(__ATOMIC_ACQUIRE, "agent");
            asm volatile("s_waitcnt vmcnt(0)" ::: "memory");
        }
    }
    __syncthreads();
}

constexpr int NB = 4, T = 4096, M = NB * T, D = 2048, DFF = 5632, INW = 5660, INP = 5888, NL = 2, MODW = 6 * D;
constexpr int C_GLA_Q = 0, C_GLA_K = 256, C_GLA_V = 512, C_GLA_G = 1024, C_GLA_LR = 1536,
              C_GDN_Q = 1552, C_GDN_K = 2064, C_GDN_V = 2576, C_GDN_G = 3088, C_GDN_B = 3600, C_GDN_A = 3604,
              C_POOL = 3608, C_FOX_Q = 4120, C_FOX_K = 4632, C_FOX_V = 5144, C_FOX_F = 5656;
constexpr float EPS = 1e-6f;
constexpr float LOG2E = 1.4426950408889634f;
constexpr size_t MiB = 1u << 20;
constexpr size_t WS_MOD = 1 * MiB, WS_FCUM = 2 * MiB, WS_GLADEC = 3 * MiB, WS_GDNDEC = 4 * MiB, WS_PWT = 5 * MiB;
constexpr size_t WS_WIN = 8 * MiB, WS_WOUT = 31 * MiB, WS_WGU = 39 * MiB, WS_WDN = 83 * MiB;
constexpr size_t WS_H = 105 * MiB, WS_ACT = 169 * MiB, WS_PROJ = 345 * MiB, WS_Y = 529 * MiB, WS_GDN = 593 * MiB, WS_GLA = 665 * MiB, WS_VT = 705 * MiB, WS_END = 721 * MiB;
constexpr size_t WS_SIDE = WS_VT;
constexpr size_t WS_GU = WS_PROJ;
static_assert(WS_GU + (size_t)M * 2 * DFF * 2 <= WS_VT, "GU overlay");
constexpr size_t GDN_ITEM = 73728, GLA_ITEM = 40960;
constexpr int LDS_BYTES = 147456;

typedef unsigned short bf16;
typedef float f32x4 __attribute__((ext_vector_type(4)));
typedef float f32x2 __attribute__((ext_vector_type(2)));
typedef short bf16x8 __attribute__((ext_vector_type(8)));
typedef unsigned u32x4v __attribute__((ext_vector_type(4)));
typedef unsigned u32x2v __attribute__((ext_vector_type(2)));

__device__ __forceinline__ unsigned f2bf(float f) { unsigned u = __builtin_bit_cast(unsigned, f); return (u + 0x7fffu + ((u >> 16) & 1u)) >> 16; }
__device__ __forceinline__ unsigned pk2(float lo, float hi) { unsigned r; asm("v_cvt_pk_bf16_f32 %0, %1, %2" : "=v"(r) : "v"(lo), "v"(hi)); return r; }
__device__ __forceinline__ bf16 bf1(float x) { return (bf16)pk2(x, x); }
__device__ __forceinline__ float bflo(unsigned w) { return __builtin_bit_cast(float, w << 16); }
__device__ __forceinline__ float bfhi(unsigned w) { return __builtin_bit_cast(float, w & 0xffff0000u); }
__device__ __forceinline__ float bf2f(bf16 b) { return __builtin_bit_cast(float, (unsigned)b << 16); }
#define DPPF(x, ctrl, rmask, bound) __builtin_bit_cast(float, __builtin_amdgcn_update_dpp(0, __builtin_bit_cast(int, (x)), (ctrl), (rmask), 0xf, (bound)))
__device__ __forceinline__ float readlane_f(float v, int l) { return __builtin_bit_cast(float, __builtin_amdgcn_readlane(__builtin_bit_cast(int, v), l)); }
__device__ __forceinline__ float wave_sum(float v) {
    v += DPPF(v, 0x128, 0xf, false); v += DPPF(v, 0x124, 0xf, false); v += DPPF(v, 0x122, 0xf, false); v += DPPF(v, 0x121, 0xf, false);
    return (readlane_f(v, 0) + readlane_f(v, 16)) + (readlane_f(v, 32) + readlane_f(v, 48));
}
__device__ __forceinline__ float wave_iscan(float x, int lane) {
    (void)lane;
    x += DPPF(x, 0x111, 0xf, true); x += DPPF(x, 0x112, 0xf, true); x += DPPF(x, 0x114, 0xf, true); x += DPPF(x, 0x118, 0xf, true);
    x += DPPF(x, 0x142, 0xa, false);
    x += DPPF(x, 0x143, 0xc, false);
    return x;
}
__device__ __forceinline__ float sigmoidf_(float x) { return __builtin_amdgcn_rcpf(1.f + __expf(-x)); }
__device__ __forceinline__ float siluf_(float x) { return x * __builtin_amdgcn_rcpf(1.f + __expf(-x)); }
__device__ __forceinline__ float logsigmoidf_(float x) { return fminf(x, 0.f) - __logf(1.f + __expf(-fabsf(x))); }
__device__ __forceinline__ float softplusf_(float x) { return fmaxf(x, 0.f) + __logf(1.f + __expf(-fabsf(x))); }
__device__ __forceinline__ bf16x8 pack8(const f32x4 a, const f32x4 b) {
    u32x4v w; w.x = pk2(a[0], a[1]); w.y = pk2(a[2], a[3]); w.z = pk2(b[0], b[1]); w.w = pk2(b[2], b[3]);
    return __builtin_bit_cast(bf16x8, w);
}
__device__ __forceinline__ bf16x8 afrag_perm(const bf16* rowp, int k0, int fq) {
    const u32x2v lo = *(const u32x2v*)(rowp + k0 + 4 * fq), hi = *(const u32x2v*)(rowp + k0 + 16 + 4 * fq);
    u32x4v w; w.x = lo.x; w.y = lo.y; w.z = hi.x; w.w = hi.y; return __builtin_bit_cast(bf16x8, w);
}
#define LAS3 __attribute__((address_space(3)))
#define LDSBAR() do { asm volatile("s_waitcnt lgkmcnt(0)" ::: "memory"); __builtin_amdgcn_s_barrier(); asm volatile("" ::: "memory"); } while (0)
#define SB() __builtin_amdgcn_sched_barrier(0)
__device__ __forceinline__ float row16_sum(float x) {
    x += __builtin_bit_cast(float, __builtin_amdgcn_update_dpp(0, __builtin_bit_cast(int, x), 0x128, 0xf, 0xf, false));
    x += __builtin_bit_cast(float, __builtin_amdgcn_update_dpp(0, __builtin_bit_cast(int, x), 0x124, 0xf, 0xf, false));
    x += __builtin_bit_cast(float, __builtin_amdgcn_update_dpp(0, __builtin_bit_cast(int, x), 0x122, 0xf, 0xf, false));
    x += __builtin_bit_cast(float, __builtin_amdgcn_update_dpp(0, __builtin_bit_cast(int, x), 0x121, 0xf, 0xf, false));
    return x;
}
__device__ __forceinline__ void lds_put_perm(bf16* rowp, int c0, const u32x4v v) {
    const int blk = c0 & ~31, k = c0 & 31;
    const int plo = (k < 16) ? 2 * k : 2 * k - 28, phi = (k + 4 < 16) ? 2 * (k + 4) : 2 * (k + 4) - 28;
    *(u32x2v*)(rowp + blk + plo) = (u32x2v){v.x, v.y}; *(u32x2v*)(rowp + blk + phi) = (u32x2v){v.z, v.w};
}
__device__ __forceinline__ bf16x8 afrag_lin(const bf16* rowp, int k0, int fq) { return *(const bf16x8*)(rowp + k0 + 8 * fq); }
#define MFMA16(a, b, c) __builtin_amdgcn_mfma_f32_16x16x32_bf16((a), (b), (c), 0, 0, 0)

__device__ __forceinline__ void phase_mod(const float* c, const float* w_mod, const float* b_mod, float* mod, unsigned char* lds) {
    float* sc = (float*)lds;
    float* part = sc + 4 * 2048;
    const int tid = fresh_tid();
    for (int i = tid; i < NB * D; i += 512) sc[i] = siluf_(c[i]);
    __syncthreads();
    for (int chunk = fresh_bid(); chunk < 256; chunk += gridDim.x) {
        const int l = chunk >> 7, col0 = (chunk & 127) * 96;
        if (tid < 384) {
            const int cgi = tid % 24, ks = tid / 24;
            const float* W = w_mod + (size_t)l * D * MODW + col0 + cgi * 4;
            f32x4 a0 = {0.f, 0.f, 0.f, 0.f}, a1 = a0, a2 = a0, a3 = a0;
#pragma unroll 8
            for (int k = ks * 128; k < ks * 128 + 128; ++k) {
                const f32x4 w = *(const f32x4*)(W + (size_t)k * MODW);
                a0 += sc[k] * w; a1 += sc[D + k] * w; a2 += sc[2 * D + k] * w; a3 += sc[3 * D + k] * w;
            }
            float* p = part + (ks * 24 + cgi) * 16;
            *(f32x4*)(p) = a0; *(f32x4*)(p + 4) = a1; *(f32x4*)(p + 8) = a2; *(f32x4*)(p + 12) = a3;
        }
        __syncthreads();
        if (tid < 384) {
            const int cgi = tid >> 4, bj = tid & 15, b = bj >> 2, j = bj & 3;
            float s = 0.f;
#pragma unroll
            for (int ks = 0; ks < 16; ++ks) s += part[(ks * 24 + cgi) * 16 + bj];
            const int col = col0 + cgi * 4 + j;
            mod[(size_t)(l * NB + b) * MODW + col] = s + b_mod[(size_t)l * MODW + col];
        }
        __syncthreads();
    }
}

struct TrDesc { const float* W; bf16* WT; int K, N, nblk, il, r; };
struct LayerW { const float *w_in, *w_out, *w_gate, *w_up, *w_down, *pool_w; };
__device__ __forceinline__ TrDesc tr_resolve(const LayerW& L, unsigned char* wsp, int part, int it) {
    constexpr int I0 = 32 * 184, I1 = 32 * 64, I2 = 32 * 176, I5 = 8;
    TrDesc d; int r = it;
    if (part == 0) {
        if (r < I0) { d.W = L.w_in; d.WT = (bf16*)(wsp + WS_WIN); d.K = D; d.N = INW; d.nblk = 184; d.il = -1; d.r = r; return d; } r -= I0;
        const int g = r / I5; r -= g * I5;
        d.W = L.pool_w + (size_t)g * 128 * 128; d.WT = (bf16*)(wsp + WS_PWT) + (size_t)g * 128 * 128; d.K = 128; d.N = 128; d.nblk = 4; d.il = -1; d.r = r; return d;
    }
    if (r < I1) { d.W = L.w_out; d.WT = (bf16*)(wsp + WS_WOUT); d.K = D; d.N = D; d.nblk = 64; d.il = -1; d.r = r; return d; } r -= I1;
    if (r < I2) { d.W = L.w_gate; d.WT = (bf16*)(wsp + WS_WGU); d.K = D; d.N = DFF; d.nblk = 176; d.il = 0; d.r = r; return d; } r -= I2;
    if (r < I2) { d.W = L.w_up; d.WT = (bf16*)(wsp + WS_WGU); d.K = D; d.N = DFF; d.nblk = 176; d.il = 128; d.r = r; return d; } r -= I2;
    d.W = L.w_down; d.WT = (bf16*)(wsp + WS_WDN); d.K = DFF; d.N = D; d.nblk = 64; d.il = -1; d.r = r; return d;
}
__device__ __forceinline__ void tr_load(const TrDesc& d, int lane, float (&v)[32]) {
    const int kb = d.r / d.nblk, nb = d.r % d.nblk, k0 = 64 * kb, n = 32 * nb + (lane & 31);
    const float* p = d.W + (size_t)(k0 + (lane >> 5)) * d.N + n;
    const bool ok = n < d.N;
#pragma unroll
    for (int i = 0; i < 32; ++i) v[i] = ok ? p[(size_t)(2 * i) * d.N] : 0.f;
}
__device__ __forceinline__ void tr_store(const TrDesc& d, int lane, const float (&v)[32], float* scr) {
    const int kb = d.r / d.nblk, nb = d.r % d.nblk, k0 = 64 * kb, n0 = 32 * nb;
#pragma unroll
    for (int i = 0; i < 32; ++i) scr[(2 * i + (lane >> 5)) * 33 + (lane & 31)] = v[i];
    asm volatile("s_waitcnt lgkmcnt(0)" ::: "memory");
    const int c = lane & 7;
#pragma unroll
    for (int j = 0; j < 4; ++j) { const int nn = (lane >> 3) + 8 * j; const float* s = scr + (8 * c) * 33 + nn;
        u32x4v o; o.x = pk2(s[0 * 33], s[1 * 33]); o.y = pk2(s[2 * 33], s[3 * 33]); o.z = pk2(s[4 * 33], s[5 * 33]); o.w = pk2(s[6 * 33], s[7 * 33]);
        const int row = (d.il < 0) ? (n0 + nn) : (((n0 + nn) >> 7) * 256 + d.il + ((n0 + nn) & 127));
        *(u32x4v*)(d.WT + (size_t)row * d.K + k0 + 8 * c) = o; }
    asm volatile("s_waitcnt lgkmcnt(0)" ::: "memory");
}
__device__ __forceinline__ void phase_transpose(const LayerW& L, unsigned char* wsp, unsigned char* lds, int part, int blk0, int nblk) {
    const int tid_ = fresh_tid(), wave = __builtin_amdgcn_readfirstlane(tid_ >> 6), lane = tid_ & 63;
    float* scr = (float*)lds + wave * (64 * 33);
    const int gw = (fresh_bid() - blk0) * 8 + wave, NGW = nblk * 8;
    constexpr int I0 = 32 * 184, I1 = 32 * 64, I2 = 32 * 176, I4 = 88 * 64, I5 = 8;
    const int NIT = (part == 0) ? I0 + 4 * I5 : I1 + 2 * I2 + I4;
    if (gw < 0 || gw >= NIT) return;
    float va[32], vb[32];
    TrDesc da = tr_resolve(L, wsp, part, gw), db = da;
    tr_load(da, lane, va);
    for (int it = gw; it < NIT; it += 2 * NGW) {
        const bool hb = it + NGW < NIT, ha = it + 2 * NGW < NIT;
        if (hb) { db = tr_resolve(L, wsp, part, it + NGW); tr_load(db, lane, vb); }
        tr_store(da, lane, va, scr);
        if (ha) { da = tr_resolve(L, wsp, part, it + 2 * NGW); tr_load(da, lane, va); }
        if (hb) tr_store(db, lane, vb, scr);
    }
}

__device__ __forceinline__ void phase_norm(const float* x, const float* nw, const float* modl, int shi, int sci, bf16* Hp) {
    const int tid_ = fresh_tid(), wave = __builtin_amdgcn_readfirstlane(tid_ >> 6), lane = tid_ & 63;
    const int gw = fresh_bid() * 8 + wave, NGW = gridDim.x * 8;
#define NORM_LOAD(V, m_) do { const f32x4* xr_ = (const f32x4*)(x + (size_t)(m_) * D) + lane; _Pragma("unroll") for (int j = 0; j < 8; ++j) V[j] = xr_[64 * j]; } while (0)
#define NORM_DO(V, m_) do { float ss = 0.f; \
        _Pragma("unroll") for (int j = 0; j < 8; ++j) ss += (V[j].x * V[j].x + V[j].y * V[j].y) + (V[j].z * V[j].z + V[j].w * V[j].w); \
        const float r = rsqrtf(wave_sum(ss) * (1.f / D) + EPS); \
        const float* mb = modl + (size_t)((m_) / T) * MODW; \
        f32x4 sc_[8], sh_[8]; \
        _Pragma("unroll") for (int j = 0; j < 8; ++j) { const int col = 4 * lane + 256 * j; sc_[j] = *(const f32x4*)(mb + sci * D + col); sh_[j] = *(const f32x4*)(mb + shi * D + col); } \
        SB(); \
        _Pragma("unroll") for (int j = 0; j < 8; ++j) { const int col = 4 * lane + 256 * j; \
            const f32x4 y = V[j] * r * wv[j] * (1.f + sc_[j]) + sh_[j]; \
            u32x2v o; o.x = pk2(y.x, y.y); o.y = pk2(y.z, y.w); \
            *(u32x2v*)(Hp + (size_t)(m_) * D + col) = o; } } while (0)
    if (gw >= M) return;
    f32x4 va[8], vb[8], wv[8];
#pragma unroll
    for (int j = 0; j < 8; ++j) wv[j] = *(const f32x4*)(nw + 4 * lane + 256 * j);
    NORM_LOAD(va, gw);
    for (int m = gw; m < M; m += 2 * NGW) {
        const bool hb = m + NGW < M, ha = m + 2 * NGW < M;
        if (hb) NORM_LOAD(vb, m + NGW);
        NORM_DO(va, m);
        if (ha) NORM_LOAD(va, m + 2 * NGW);
        if (hb) NORM_DO(vb, m + NGW);
    }
#undef NORM_DO
}
__device__ __forceinline__ void phase_final_norm(float* x, const float* nw) {
    const int tid_ = fresh_tid(), wave = __builtin_amdgcn_readfirstlane(tid_ >> 6), lane = tid_ & 63;
    const int gw = fresh_bid() * 8 + wave, NGW = gridDim.x * 8;
#define FNORM_DO(V, m_) do { float ss = 0.f; \
        _Pragma("unroll") for (int j = 0; j < 8; ++j) ss += (V[j].x * V[j].x + V[j].y * V[j].y) + (V[j].z * V[j].z + V[j].w * V[j].w); \
        const float r = rsqrtf(wave_sum(ss) * (1.f / D) + EPS); \
        f32x4* xo_ = (f32x4*)(x + (size_t)(m_) * D) + lane; \
        _Pragma("unroll") for (int j = 0; j < 8; ++j) xo_[64 * j] = V[j] * r * wv[j]; } while (0)
    if (gw >= M) return;
    f32x4 va[8], vb[8], wv[8];
#pragma unroll
    for (int j = 0; j < 8; ++j) wv[j] = *(const f32x4*)(nw + 4 * lane + 256 * j);
    NORM_LOAD(va, gw);
    for (int m = gw; m < M; m += 2 * NGW) {
        const bool hb = m + NGW < M, ha = m + 2 * NGW < M;
        if (hb) NORM_LOAD(vb, m + NGW);
        FNORM_DO(va, m);
        if (ha) NORM_LOAD(va, m + 2 * NGW);
        if (hb) FNORM_DO(vb, m + NGW);
    }
#undef FNORM_DO
#undef NORM_LOAD
}

__device__ __forceinline__ void gdn_prep_item(int item, const bf16* PROJ, const float* conv_w, const float* a_log, const float* dt_bias,
                                              unsigned char* scr_base, float* gdn_dec, unsigned char* lds) {
    const int tid = fresh_tid(), wave = __builtin_amdgcn_readfirstlane(tid >> 6), lane = tid & 63, fr = lane & 15, fq = lane >> 4;
    const int bh = item >> 6, n = item & 63, b = bh >> 2, h = bh & 3, t0 = n * 64;
    const size_t row0 = (size_t)b * T + t0;
    bf16* Kb = (bf16*)lds;
    bf16* Qb = Kb + 64 * 144;
    float* RHS = (float*)(Qb + 64 * 144);
    float* Lm = RHS + 64 * 260;
    float* bs = Lm + 64 * 68;
    float* gc = bs + 64;
    unsigned char* scr = scr_base + (size_t)item * GDN_ITEM;
    bf16* gQG = (bf16*)scr; bf16* gW = (bf16*)(scr + 16384); bf16* gK2T = (bf16*)(scr + 32768); bf16* gUT = (bf16*)(scr + 49152); bf16* gATT = (bf16*)(scr + 65536);
    if (wave == 0) {
        const bf16* pr = PROJ + (row0 + lane) * INP;
        const float a_in = bf2f(pr[C_GDN_A + h]), b_in = bf2f(pr[C_GDN_B + h]);
        const float g = -__expf(a_log[h]) * softplusf_(a_in + dt_bias[h]);
        gc[lane] = wave_iscan(g, lane); bs[lane] = sigmoidf_(b_in);
    }
    unsigned xr[3][11];
#pragma unroll
    for (int p = 0; p < 3; ++p)
#pragma unroll
        for (int i = 0; i < 11; ++i) { const int tt = t0 + 8 * wave + i - 3;
            xr[p][i] = (tt >= 0) ? *(const unsigned*)(PROJ + ((size_t)b * T + tt) * INP + C_GDN_Q + p * 512 + h * 128 + 2 * lane) : 0u; }
    LDSBAR();
#pragma unroll
    for (int p = 0; p < 3; ++p) {
        f32x2 cw[4];
#pragma unroll
        for (int j = 0; j < 4; ++j) cw[j] = *(const f32x2*)(conv_w + j * 1536 + p * 512 + h * 128 + 2 * lane);
#pragma unroll
        for (int i = 0; i < 8; ++i) {
            float y0 = 0.f, y1 = 0.f;
#pragma unroll
            for (int j = 0; j < 4; ++j) { y0 += cw[j].x * bflo(xr[p][i + j]); y1 += cw[j].y * bfhi(xr[p][i + j]); }
            y0 = siluf_(y0); y1 = siluf_(y1);
            const int t = 8 * wave + i;
            if (p == 0) { const float sc = rsqrtf(wave_sum(y0 * y0 + y1 * y1) + EPS) * 0.08838834764831845f;
                *(unsigned*)(Qb + t * 144 + 2 * lane) = pk2(y0 * sc, y1 * sc); }
            else if (p == 1) { const float sc = rsqrtf(wave_sum(y0 * y0 + y1 * y1) + EPS); y0 *= sc; y1 *= sc;
                *(unsigned*)(Kb + t * 144 + 2 * lane) = pk2(y0, y1);
                const float f = bs[t] * __expf(gc[t]);
                *(f32x2*)(RHS + t * 260 + 128 + 2 * lane) = (f32x2){y0 * f, y1 * f}; }
            else { const float f = bs[t]; *(f32x2*)(RHS + t * 260 + 2 * lane) = (f32x2){y0 * f, y1 * f}; }
        }
    }
    LDSBAR();
#pragma unroll
    for (int r = 0; r < 4; ++r) {
        const int tl = wave + 8 * r, isqk = tl >> 4, it = (tl & 15) >> 2, jt = tl & 3;
        f32x4 acc = {0.f, 0.f, 0.f, 0.f};
        if (jt <= it) {
            if (isqk) {
#pragma unroll
                for (int ks = 0; ks < 4; ++ks) acc = MFMA16(*(const bf16x8*)(Kb + (16 * jt + fr) * 144 + 32 * ks + 8 * fq), *(const bf16x8*)(Qb + (16 * it + fr) * 144 + 32 * ks + 8 * fq), acc);
            } else {
#pragma unroll
                for (int ks = 0; ks < 4; ++ks) acc = MFMA16(*(const bf16x8*)(Kb + (16 * it + fr) * 144 + 32 * ks + 8 * fq), *(const bf16x8*)(Kb + (16 * jt + fr) * 144 + 32 * ks + 8 * fq), acc);
            }
        }
        if (isqk) {
            const int i = 16 * it + fr; float o[4];
#pragma unroll
            for (int jj = 0; jj < 4; ++jj) { const int j = 16 * jt + 4 * fq + jj; o[jj] = (j <= i) ? acc[jj] * __expf(fminf(gc[i] - gc[j], 0.f)) : 0.f; }
            u32x2v w; w.x = pk2(o[0], o[1]); w.y = pk2(o[2], o[3]);
            *(u32x2v*)(gATT + i * 64 + 16 * jt + 4 * fq) = w;
        } else {
            const int j = 16 * jt + fr;
#pragma unroll
            for (int jj = 0; jj < 4; ++jj) { const int i = 16 * it + 4 * fq + jj; Lm[i * 68 + j] = (j < i) ? bs[i] * acc[jj] * __expf(fminf(gc[i] - gc[j], 0.f)) : 0.f; }
        }
    }
    LDSBAR();
    if (tid < 256) {
        const int c = tid;
        LAS3 const float* Lb = (LAS3 const float*)Lm; asm volatile("" : "+v"(Lb));
        LAS3 const float* Rb = (LAS3 const float*)RHS + c; asm volatile("" : "+v"(Rb));
        float x[64];
        f32x4 buf[2][16]; float rb[2];
        rb[0] = Rb[0];
#pragma unroll
        for (int i = 0; i < 64; ++i) {
            if (i + 1 < 64) {
                rb[(i + 1) & 1] = Rb[(i + 1) * 260];
#pragma unroll
                for (int j4 = 0; j4 < (i + 4) / 4; ++j4) buf[(i + 1) & 1][j4] = *(LAS3 const f32x4*)(Lb + (i + 1) * 68 + 4 * j4);
            }
            __builtin_amdgcn_sched_barrier(0);
            float s0 = rb[i & 1], s1 = 0.f, s2 = 0.f, s3 = 0.f;
#pragma unroll
            for (int j4 = 0; j4 < (i + 3) / 4; ++j4) {
                const f32x4 l4 = buf[i & 1][j4];
                s0 -= l4.x * x[4 * j4];
                if (4 * j4 + 1 < i) s1 -= l4.y * x[4 * j4 + 1];
                if (4 * j4 + 2 < i) s2 -= l4.z * x[4 * j4 + 2];
                if (4 * j4 + 3 < i) s3 -= l4.w * x[4 * j4 + 3];
            }
            x[i] = (s0 + s1) + (s2 + s3);
            __builtin_amdgcn_sched_barrier(0);
        }
        if (c < 128) {
#pragma unroll
            for (int q = 0; q < 8; ++q) { u32x4v w; w.x = pk2(x[8 * q], x[8 * q + 1]); w.y = pk2(x[8 * q + 2], x[8 * q + 3]); w.z = pk2(x[8 * q + 4], x[8 * q + 5]); w.w = pk2(x[8 * q + 6], x[8 * q + 7]);
                *(u32x4v*)(gUT + c * 64 + 8 * q) = w; }
        } else {
#pragma unroll
            for (int i = 0; i < 64; ++i) gW[i * 128 + (c - 128)] = bf1(x[i]);
        }
    } else {
        const int tt = tid - 256;
        {
            const int i = tt >> 2, d0 = (tt & 3) * 32; const float e = __expf(gc[i]);
#pragma unroll
            for (int q = 0; q < 4; ++q) { const u32x4v v = *(const u32x4v*)(Qb + i * 144 + d0 + 8 * q); u32x4v w;
                w.x = pk2(bflo(v.x) * e, bfhi(v.x) * e); w.y = pk2(bflo(v.y) * e, bfhi(v.y) * e); w.z = pk2(bflo(v.z) * e, bfhi(v.z) * e); w.w = pk2(bflo(v.w) * e, bfhi(v.w) * e);
                *(u32x4v*)(gQG + i * 128 + d0 + 8 * q) = w; }
        }
        {
            const int d = tt & 127, j0 = (tt >> 7) * 32; const float gl = gc[63];
#pragma unroll
            for (int q = 0; q < 4; ++q) { float v[8];
#pragma unroll
                for (int e = 0; e < 8; ++e) { const int j = j0 + 8 * q + e; v[e] = bf2f(Kb[j * 144 + d]) * __expf(gl - gc[j]); }
                u32x4v w; w.x = pk2(v[0], v[1]); w.y = pk2(v[2], v[3]); w.z = pk2(v[4], v[5]); w.w = pk2(v[6], v[7]);
                *(u32x4v*)(gK2T + d * 64 + j0 + 8 * q) = w; }
        }
        if (tt == 0) gdn_dec[item] = __expf(gc[63]);
    }
    LDSBAR();
}

__device__ __forceinline__ void gla_prep_item(int item, const bf16* PROJ, const float* w_lr, const float* b_lr, unsigned char* scr_base, float* gla_dec, unsigned char* lds) {
    const int tid = fresh_tid(), wave = __builtin_amdgcn_readfirstlane(tid >> 6), lane = tid & 63, fr = lane & 15, fq = lane >> 4;
    const int bh = item >> 6, n = item & 63, b = bh >> 2, h = bh & 3, t0 = n * 64;
    const size_t row0 = (size_t)b * T + t0;
    bf16* QGs = (bf16*)lds;
    bf16* KGs = QGs + 64 * 80;
    bf16* Vs = KGs + 64 * 80;
    unsigned char* scr = scr_base + (size_t)item * GLA_ITEM;
    bf16* gQG = (bf16*)scr; bf16* gK2T = (bf16*)(scr + 8192); bf16* gUT = (bf16*)(scr + 16384); bf16* gATT = (bf16*)(scr + 32768);
    {
        const int r = tid >> 3, sg = tid & 7;
        const bf16* src = PROJ + (row0 + r) * INP + C_GLA_V + h * 128 + 16 * sg;
        const u32x4v v0 = *(const u32x4v*)src, v1 = *(const u32x4v*)(src + 8);
        *(u32x4v*)(Vs + r * 136 + 16 * sg) = v0; *(u32x4v*)(Vs + r * 136 + 16 * sg + 8) = v1;
    }
    {
        const bf16* pr = PROJ + (row0 + lane) * INP;
        const u32x4v g0 = *(const u32x4v*)(pr + C_GLA_LR), g1 = *(const u32x4v*)(pr + C_GLA_LR + 8);
        float glr[16];
        glr[0] = bflo(g0.x); glr[1] = bfhi(g0.x); glr[2] = bflo(g0.y); glr[3] = bfhi(g0.y); glr[4] = bflo(g0.z); glr[5] = bfhi(g0.z); glr[6] = bflo(g0.w); glr[7] = bfhi(g0.w);
        glr[8] = bflo(g1.x); glr[9] = bfhi(g1.x); glr[10] = bflo(g1.y); glr[11] = bfhi(g1.y); glr[12] = bflo(g1.z); glr[13] = bfhi(g1.z); glr[14] = bflo(g1.w); glr[15] = bfhi(g1.w);
        const u32x4v qv = *(const u32x4v*)(pr + C_GLA_Q + h * 64 + 8 * wave), kv = *(const u32x4v*)(pr + C_GLA_K + h * 64 + 8 * wave);
        float q[8], k[8];
        q[0] = bflo(qv.x); q[1] = bfhi(qv.x); q[2] = bflo(qv.y); q[3] = bfhi(qv.y); q[4] = bflo(qv.z); q[5] = bfhi(qv.z); q[6] = bflo(qv.w); q[7] = bfhi(qv.w);
        k[0] = bflo(kv.x); k[1] = bfhi(kv.x); k[2] = bflo(kv.y); k[3] = bfhi(kv.y); k[4] = bflo(kv.z); k[5] = bfhi(kv.z); k[6] = bflo(kv.w); k[7] = bfhi(kv.w);
        float qg[8], kg[8], k2[8];
        const int dc0 = h * 64 + 8 * wave;
        const float wlo = w_lr[(lane >> 3) * 256 + dc0 + (lane & 7)], whi = w_lr[((lane >> 3) + 8) * 256 + dc0 + (lane & 7)], blv = b_lr[dc0 + (lane & 7)];
#pragma unroll
        for (int i = 0; i < 8; ++i) {
            float z = readlane_f(blv, i);
#pragma unroll
            for (int r = 0; r < 16; ++r) z += glr[r] * readlane_f(r < 8 ? wlo : whi, (r & 7) * 8 + i);
            const float bc = wave_iscan(logsigmoidf_(z) * (1.f / 16.f), lane);
            const float bl = readlane_f(bc, 63);
            qg[i] = q[i] * 0.125f * __expf(bc); kg[i] = k[i] * __expf(-bc); k2[i] = k[i] * __expf(bl - bc);
            gK2T[(8 * wave + i) * 64 + lane] = bf1(k2[i]);
            if (lane == 63) gla_dec[(size_t)item * 64 + 8 * wave + i] = __expf(bl);
        }
        u32x4v w; w.x = pk2(qg[0], qg[1]); w.y = pk2(qg[2], qg[3]); w.z = pk2(qg[4], qg[5]); w.w = pk2(qg[6], qg[7]);
        *(u32x4v*)(QGs + lane * 80 + 8 * wave) = w; *(u32x4v*)(gQG + lane * 64 + 8 * wave) = w;
        w.x = pk2(kg[0], kg[1]); w.y = pk2(kg[2], kg[3]); w.z = pk2(kg[4], kg[5]); w.w = pk2(kg[6], kg[7]);
        *(u32x4v*)(KGs + lane * 80 + 8 * wave) = w;
    }
    LDSBAR();
    {
        const int v = tid >> 2, ts = (tid & 3) * 16; float x[16];
#pragma unroll
        for (int e = 0; e < 16; ++e) x[e] = bf2f(Vs[(ts + e) * 136 + v]);
        u32x4v w; w.x = pk2(x[0], x[1]); w.y = pk2(x[2], x[3]); w.z = pk2(x[4], x[5]); w.w = pk2(x[6], x[7]);
        *(u32x4v*)(gUT + v * 64 + ts) = w;
        w.x = pk2(x[8], x[9]); w.y = pk2(x[10], x[11]); w.z = pk2(x[12], x[13]); w.w = pk2(x[14], x[15]);
        *(u32x4v*)(gUT + v * 64 + ts + 8) = w;
    }
#pragma unroll
    for (int r = 0; r < 2; ++r) {
        const int tl = wave + 8 * r, it = tl >> 2, jt = tl & 3;
        f32x4 acc = {0.f, 0.f, 0.f, 0.f};
        if (jt <= it) {
#pragma unroll
            for (int ks = 0; ks < 2; ++ks) acc = MFMA16(*(const bf16x8*)(KGs + (16 * jt + fr) * 80 + 32 * ks + 8 * fq), *(const bf16x8*)(QGs + (16 * it + fr) * 80 + 32 * ks + 8 * fq), acc);
        }
        const int i = 16 * it + fr; float o[4];
#pragma unroll
        for (int jj = 0; jj < 4; ++jj) { const int j = 16 * jt + 4 * fq + jj; o[jj] = (j <= i) ? acc[jj] : 0.f; }
        u32x2v w; w.x = pk2(o[0], o[1]); w.y = pk2(o[2], o[3]);
        *(u32x2v*)(gATT + i * 64 + 16 * jt + 4 * fq) = w;
    }
    LDSBAR();
}

__device__ __forceinline__ void pool_item(int item, const bf16* PROJ, const bf16* PWT, const float* pscale, bf16* Y, unsigned char* lds) {
    const int tid = fresh_tid(), wave = __builtin_amdgcn_readfirstlane(tid >> 6), lane = tid & 63, fr = lane & 15, fq = lane >> 4;
    const int g = item & 3, tile = item >> 2, b = tile >> 6, t0 = (tile & 63) * 64, win = 2 << g;
    float* Us = (float*)lds;
    bf16* As = (bf16*)(Us + 79 * 128);
    bf16* Bs = As + 64 * 144;
    {
        u32x4v ur[3], pr[4];
#pragma unroll
        for (int i = 0; i < 3; ++i) { const int p = tid + 512 * i, r = p >> 4, sg = p & 15, tt = t0 + r - 15;
            ur[i] = (u32x4v){0u, 0u, 0u, 0u};
            if (p < 79 * 16 && tt >= 0) ur[i] = *(const u32x4v*)(PROJ + ((size_t)b * T + tt) * INP + C_POOL + g * 128 + 8 * sg); }
#pragma unroll
        for (int i = 0; i < 4; ++i) { const int p = tid + 512 * i, r = p >> 4, sg = p & 15;
            pr[i] = *(const u32x4v*)(PWT + (size_t)g * 128 * 128 + r * 128 + 8 * sg); }
#pragma unroll
        for (int i = 0; i < 3; ++i) { const int p = tid + 512 * i, r = p >> 4, sg = p & 15;
            if (p < 79 * 16) { float* d = Us + r * 128 + 8 * sg; const u32x4v v = ur[i];
                *(f32x4*)d = (f32x4){bflo(v.x), bfhi(v.x), bflo(v.y), bfhi(v.y)}; *(f32x4*)(d + 4) = (f32x4){bflo(v.z), bfhi(v.z), bflo(v.w), bfhi(v.w)}; } }
#pragma unroll
        for (int i = 0; i < 4; ++i) { const int p = tid + 512 * i, r = p >> 4, sg = p & 15; *(u32x4v*)(Bs + r * 144 + 8 * sg) = pr[i]; }
    }
    LDSBAR();
    {
        const int c = tid & 127, tg = tid >> 7;
        float s = 0.f;
        for (int j = 1; j < win; ++j) s += Us[(15 + 16 * tg - j) * 128 + c];
#pragma unroll 4
        for (int e = 0; e < 16; ++e) { const int r = 15 + 16 * tg + e; const float u = Us[r * 128 + c]; s += u;
            const int cnt = min(t0 + 16 * tg + e + 1, win);
            As[(16 * tg + e) * 144 + c] = bf1(s * __builtin_amdgcn_rcpf((float)cnt) - u);
            s -= Us[(r - win + 1) * 128 + c]; }
    }
    LDSBAR();
    {
        f32x4 acc[4];
#pragma unroll
        for (int mt = 0; mt < 4; ++mt) acc[mt] = (f32x4){0.f, 0.f, 0.f, 0.f};
#pragma unroll
        for (int ks = 0; ks < 4; ++ks) { const bf16x8 bw = *(const bf16x8*)(Bs + (16 * wave + fr) * 144 + 32 * ks + 8 * fq);
#pragma unroll
            for (int mt = 0; mt < 4; ++mt) acc[mt] = MFMA16(bw, *(const bf16x8*)(As + (16 * mt + fr) * 144 + 32 * ks + 8 * fq), acc[mt]); }
        const f32x4 sc = *(const f32x4*)(pscale + g * 128 + 16 * wave + 4 * fq);
#pragma unroll
        for (int mt = 0; mt < 4; ++mt) { const f32x4 o = acc[mt] * sc; u32x2v w; w.x = pk2(o.x, o.y); w.y = pk2(o.z, o.w);
            *(u32x2v*)(Y + ((size_t)b * T + t0 + 16 * mt + fr) * D + 1024 + g * 128 + 16 * wave + 4 * fq) = w; }
    }
    LDSBAR();
}

__device__ __forceinline__ void vt_item(int item, const bf16* PROJ, bf16* VT, unsigned char* lds) {
    const int tid = fresh_tid();
    const int bh = item >> 6, n = item & 63, b = bh >> 2, h = bh & 3, t0 = n * 64;
    bf16* Vs = (bf16*)lds;
    {
        const int r = tid >> 3, sg = tid & 7;
        const bf16* src = PROJ + ((size_t)b * T + t0 + r) * INP + C_FOX_V + h * 128 + 16 * sg;
        const u32x4v v0 = *(const u32x4v*)src, v1 = *(const u32x4v*)(src + 8);
        *(u32x4v*)(Vs + r * 136 + 16 * sg) = v0; *(u32x4v*)(Vs + r * 136 + 16 * sg + 8) = v1;
    }
    LDSBAR();
    {
        const int v = tid >> 2, ts = (tid & 3) * 16; float x[16];
#pragma unroll
        for (int e = 0; e < 16; ++e) x[e] = bf2f(Vs[(ts + e) * 136 + v]);
        bf16* dst = VT + ((size_t)bh * 128 + v) * T + t0 + ts;
        u32x4v w; w.x = pk2(x[0], x[1]); w.y = pk2(x[2], x[3]); w.z = pk2(x[4], x[5]); w.w = pk2(x[6], x[7]);
        *(u32x4v*)dst = w;
        w.x = pk2(x[8], x[9]); w.y = pk2(x[10], x[11]); w.z = pk2(x[12], x[13]); w.w = pk2(x[14], x[15]);
        *(u32x4v*)(dst + 8) = w;
    }
    LDSBAR();
}
__device__ __forceinline__ void fcum_item(int b, const bf16* PROJ, const float* f_bias, float* FCUM, unsigned char* lds) {
    const int tid = fresh_tid(), wave = __builtin_amdgcn_readfirstlane(tid >> 6), lane = tid & 63;
    float* wt = (float*)lds;
    const float bb[4] = {f_bias[0], f_bias[1], f_bias[2], f_bias[3]};
    const bf16* base = PROJ + ((size_t)b * T + 8 * tid) * INP + C_FOX_F;
    u32x2v v[8];
#pragma unroll
    for (int e = 0; e < 8; ++e) v[e] = *(const u32x2v*)(base + (size_t)e * INP);
    float ls[8][4]; float run[4] = {0.f, 0.f, 0.f, 0.f};
#pragma unroll
    for (int e = 0; e < 8; ++e) {
        run[0] += logsigmoidf_(bflo(v[e].x) + bb[0]); run[1] += logsigmoidf_(bfhi(v[e].x) + bb[1]); run[2] += logsigmoidf_(bflo(v[e].y) + bb[2]); run[3] += logsigmoidf_(bfhi(v[e].y) + bb[3]);
        ls[e][0] = run[0]; ls[e][1] = run[1]; ls[e][2] = run[2]; ls[e][3] = run[3];
    }
    float off[4];
#pragma unroll
    for (int h = 0; h < 4; ++h) { const float inc = wave_iscan(run[h], lane); off[h] = inc - run[h]; if (lane == 63) wt[wave * 4 + h] = inc; }
    LDSBAR();
#pragma unroll
    for (int h = 0; h < 4; ++h) { float o = off[h];
        for (int w = 0; w < wave; ++w) o += wt[w * 4 + h];
        float* dst = FCUM + ((size_t)b * 4 + h) * T + 8 * tid;
        *(f32x4*)dst = (f32x4){o + ls[0][h], o + ls[1][h], o + ls[2][h], o + ls[3][h]};
        *(f32x4*)(dst + 4) = (f32x4){o + ls[4][h], o + ls[5][h], o + ls[6][h], o + ls[7][h]}; }
    LDSBAR();
}

template <int DK, bool DELTA>
__device__ __forceinline__ void scan_bh(int bh, const unsigned char* scr_base, size_t item_bytes, const float* dec, const bf16* PROJ, int gcol,
                                        const float* norm_w, bf16* Y, int ycol, unsigned char* lds) {
    const int tid = fresh_tid(), wave = __builtin_amdgcn_readfirstlane(tid >> 6), lane = tid & 63, fr = lane & 15, fq = lane >> 4;
    const int b = bh >> 2;
    constexpr int PQ = DK + 16;
    constexpr int NQ = DK / 64;
    constexpr size_t O_QG = 0, O_W = DELTA ? 16384 : 0, O_K2T = DELTA ? 32768 : 8192, O_UT = DELTA ? 49152 : 16384, O_ATT = DELTA ? 65536 : 32768;
    bf16* QGt = (bf16*)lds;
    bf16* Wt = QGt + 64 * PQ;
    bf16* K2Tt = Wt + 64 * PQ;
    bf16* ATTt = K2Tt + DK * 80;
    bf16* UTt = ATTt + 64 * 80;
    bf16* Gt = UTt + 128 * 80;
    float* DECt = (float*)(Gt + 64 * 136);
    float* PART = DECt + DK;
    float* RINV = PART + 512;
    f32x4 S[DK / 16];
#pragma unroll
    for (int kb = 0; kb < DK / 16; ++kb) S[kb] = (f32x4){0.f, 0.f, 0.f, 0.f};
    u32x4v rq[NQ], rw[NQ], rk[NQ], ra, ru[2]; float rdec = 0.f;
#define SCAN_ISSUE(n_) do { const unsigned char* it_ = scr_base + (size_t)(bh * 64 + (n_)) * item_bytes; \
        _Pragma("unroll") for (int i = 0; i < NQ; ++i) { rq[i] = *(const u32x4v*)(it_ + O_QG + (size_t)(tid + 512 * i) * 16); if (DELTA) rw[i] = *(const u32x4v*)(it_ + O_W + (size_t)(tid + 512 * i) * 16); \
            rk[i] = *(const u32x4v*)(it_ + O_K2T + (size_t)(tid + 512 * i) * 16); } \
        ra = *(const u32x4v*)(it_ + O_ATT + (size_t)tid * 16); \
        ru[0] = *(const u32x4v*)(it_ + O_UT + (size_t)tid * 16); ru[1] = *(const u32x4v*)(it_ + O_UT + (size_t)(tid + 512) * 16); \
        if (tid < DK) rdec = DELTA ? dec[bh * 64 + (n_)] : dec[(size_t)(bh * 64 + (n_)) * 64 + tid]; } while (0)
    SCAN_ISSUE(0);
    for (int n = 0; n < 64; ++n) {
        LDSBAR();
#pragma unroll
        for (int i = 0; i < NQ; ++i) { const int p = tid + 512 * i;
            { const int r = p / (DK / 8), cp = p % (DK / 8); lds_put_perm(QGt + r * PQ, 8 * cp, rq[i]); if (DELTA) lds_put_perm(Wt + r * PQ, 8 * cp, rw[i]); }
            { const int r = p >> 3, cp = p & 7; lds_put_perm(K2Tt + r * 80, 8 * cp, rk[i]); } }
        { const int r = tid >> 3, cp = tid & 7; lds_put_perm(ATTt + r * 80, 8 * cp, ra); }
#pragma unroll
        for (int i = 0; i < 2; ++i) { const int p = tid + 512 * i; const int r = p >> 3, cp = p & 7; *(u32x4v*)(UTt + r * 80 + 8 * cp) = ru[i]; }
        if (tid < DK) DECt[tid] = rdec;
        LDSBAR();
        if (n + 1 < 64) SCAN_ISSUE(n + 1);
        const size_t row0 = (size_t)b * T + n * 64;
        bf16x8 Sf[DK / 32];
#pragma unroll
        for (int ks = 0; ks < DK / 32; ++ks) Sf[ks] = pack8(S[2 * ks], S[2 * ks + 1]);
        f32x4 vn[4], o[4];
        bf16x8 f0[8], f1[8];
        u32x2v uu[4];
#pragma unroll
        for (int mt = 0; mt < 4; ++mt) { uu[mt] = *(const u32x2v*)(UTt + (16 * wave + fr) * 80 + 16 * mt + 4 * fq); o[mt] = (f32x4){0.f, 0.f, 0.f, 0.f}; }
        if (DELTA) {
            f32x4 P[4];
#pragma unroll
            for (int mt = 0; mt < 4; ++mt) P[mt] = (f32x4){0.f, 0.f, 0.f, 0.f};
#pragma unroll
            for (int q = 0; q < 8; ++q) f0[q] = afrag_lin(Wt + (16 * (q & 3) + fr) * PQ, 32 * (q >> 2), fq);
            SB();
#pragma unroll
            for (int q = 0; q < 8; ++q) f1[q] = afrag_lin(Wt + (16 * (q & 3) + fr) * PQ, 32 * (2 + (q >> 2)), fq);
            SB();
#pragma unroll
            for (int q = 0; q < 8; ++q) P[q & 3] = MFMA16(f0[q], Sf[q >> 2], P[q & 3]);
            SB();
#pragma unroll
            for (int q = 0; q < 8; ++q) f0[q] = afrag_lin(QGt + (16 * (q & 3) + fr) * PQ, 32 * (q >> 2), fq);
            SB();
#pragma unroll
            for (int q = 0; q < 8; ++q) P[q & 3] = MFMA16(f1[q], Sf[2 + (q >> 2)], P[q & 3]);
            SB();
#pragma unroll
            for (int q = 0; q < 8; ++q) f1[q] = afrag_lin(QGt + (16 * (q & 3) + fr) * PQ, 32 * (2 + (q >> 2)), fq);
            SB();
#pragma unroll
            for (int q = 0; q < 8; ++q) o[q & 3] = MFMA16(f0[q], Sf[q >> 2], o[q & 3]);
            SB();
#pragma unroll
            for (int q = 0; q < 8; ++q) f0[q] = afrag_lin(ATTt + (16 * (q & 3) + fr) * 80, 32 * (q >> 2), fq);
            SB();
#pragma unroll
            for (int q = 0; q < 8; ++q) o[q & 3] = MFMA16(f1[q], Sf[2 + (q >> 2)], o[q & 3]);
#pragma unroll
            for (int mt = 0; mt < 4; ++mt) vn[mt] = (f32x4){bflo(uu[mt].x), bfhi(uu[mt].x), bflo(uu[mt].y), bfhi(uu[mt].y)} - P[mt];
        } else {
#pragma unroll
            for (int q = 0; q < 8; ++q) f1[q] = afrag_lin(QGt + (16 * (q & 3) + fr) * PQ, 32 * (q >> 2), fq);
            SB();
#pragma unroll
            for (int q = 0; q < 8; ++q) f0[q] = afrag_lin(ATTt + (16 * (q & 3) + fr) * 80, 32 * (q >> 2), fq);
            SB();
#pragma unroll
            for (int q = 0; q < 8; ++q) o[q & 3] = MFMA16(f1[q], Sf[q >> 2], o[q & 3]);
#pragma unroll
            for (int mt = 0; mt < 4; ++mt) vn[mt] = (f32x4){bflo(uu[mt].x), bfhi(uu[mt].x), bflo(uu[mt].y), bfhi(uu[mt].y)};
        }
        bf16x8 Vf[2];
        Vf[0] = pack8(vn[0], vn[1]); Vf[1] = pack8(vn[2], vn[3]);
        SB();
        constexpr int NKB = DK / 16, KG = (NKB * 2) / 8;
#pragma unroll
        for (int q = 0; q < 8; ++q) { const int t = q, kb = t % NKB, k2 = t / NKB; f1[q] = afrag_lin(K2Tt + (16 * kb + fr) * 80, 32 * k2, fq); }
        SB();
#pragma unroll
        for (int q = 0; q < 8; ++q) o[q & 3] = MFMA16(f0[q], Vf[q >> 2], o[q & 3]);
#pragma unroll
        for (int kb = 0; kb < NKB; ++kb) S[kb] = S[kb] * *(const f32x4*)(DECt + 16 * kb + 4 * fq);
        SB();
        if (KG == 2) {
#pragma unroll
            for (int q = 0; q < 8; ++q) { const int t = 8 + q, kb = t % NKB, k2 = t / NKB; f0[q] = afrag_lin(K2Tt + (16 * kb + fr) * 80, 32 * k2, fq); }
            SB();
        }
#pragma unroll
        for (int q = 0; q < 8; ++q) { const int t = q, kb = t % NKB, k2 = t / NKB; S[kb] = MFMA16(f1[q], Vf[k2], S[kb]); }
        if (KG == 2) {
            SB();
#pragma unroll
            for (int q = 0; q < 8; ++q) { const int t = 8 + q, kb = t % NKB, k2 = t / NKB; S[kb] = MFMA16(f0[q], Vf[k2], S[kb]); }
        }
#pragma unroll
        for (int mt = 0; mt < 4; ++mt)
#pragma unroll
            for (int j = 0; j < 4; ++j) Y[(row0 + 16 * mt + 4 * fq + j) * D + ycol + 16 * wave + fr] = bf1(o[mt][j]);
    }
#undef SCAN_ISSUE
    __syncthreads();
}

__device__ __forceinline__ void phase_mixnorm(const bf16* PROJ, const float* gla_norm, const float* gdn_norm, bf16* Y) {
    const int tid_ = fresh_tid(), wave = __builtin_amdgcn_readfirstlane(tid_ >> 6), lane = tid_ & 63;
    const int gw = fresh_bid() * 8 + wave, NGW = gridDim.x * 8;
    const int hh = lane >> 3, c16 = (lane & 7) * 16;
    const float* nw = (hh < 4 ? gla_norm : gdn_norm) + c16;
    float nwv[16];
#pragma unroll
    for (int e = 0; e < 16; e += 4) *(f32x4*)(nwv + e) = *(const f32x4*)(nw + e);
    const int gcol = (hh < 4 ? C_GLA_G : C_GDN_G) + (hh & 3) * 128 + c16;
#define MIX_LOAD(m_, Y0, Y1, G0, G1) do { const bf16* yp_ = Y + (size_t)(m_) * D + 16 * lane; const bf16* gp_ = PROJ + (size_t)(m_) * INP + gcol; \
        Y0 = *(const u32x4v*)yp_; Y1 = *(const u32x4v*)(yp_ + 8); G0 = *(const u32x4v*)gp_; G1 = *(const u32x4v*)(gp_ + 8); } while (0)
#define MIX_DO(m_, y0, y1, g0, g1) do { \
        float o[16], g[16]; \
        o[0] = bflo(y0.x); o[1] = bfhi(y0.x); o[2] = bflo(y0.y); o[3] = bfhi(y0.y); o[4] = bflo(y0.z); o[5] = bfhi(y0.z); o[6] = bflo(y0.w); o[7] = bfhi(y0.w); \
        o[8] = bflo(y1.x); o[9] = bfhi(y1.x); o[10] = bflo(y1.y); o[11] = bfhi(y1.y); o[12] = bflo(y1.z); o[13] = bfhi(y1.z); o[14] = bflo(y1.w); o[15] = bfhi(y1.w); \
        g[0] = bflo(g0.x); g[1] = bfhi(g0.x); g[2] = bflo(g0.y); g[3] = bfhi(g0.y); g[4] = bflo(g0.z); g[5] = bfhi(g0.z); g[6] = bflo(g0.w); g[7] = bfhi(g0.w); \
        g[8] = bflo(g1.x); g[9] = bfhi(g1.x); g[10] = bflo(g1.y); g[11] = bfhi(g1.y); g[12] = bflo(g1.z); g[13] = bfhi(g1.z); g[14] = bflo(g1.w); g[15] = bfhi(g1.w); \
        float ss = 0.f; \
        _Pragma("unroll") for (int e = 0; e < 16; ++e) ss += o[e] * o[e]; \
        ss += DPPF(ss, 0xB1, 0xf, false); ss += DPPF(ss, 0x4E, 0xf, false); ss += DPPF(ss, 0x141, 0xf, false);     \
        const float rinv = rsqrtf(ss * (1.f / 128.f) + EPS); \
        float y[16]; \
        _Pragma("unroll") for (int e = 0; e < 16; ++e) y[e] = o[e] * rinv * nwv[e] * siluf_(g[e]); \
        bf16* yp = Y + (size_t)(m_) * D + 16 * lane; \
        u32x4v w; w.x = pk2(y[0], y[1]); w.y = pk2(y[2], y[3]); w.z = pk2(y[4], y[5]); w.w = pk2(y[6], y[7]); \
        *(u32x4v*)yp = w; \
        w.x = pk2(y[8], y[9]); w.y = pk2(y[10], y[11]); w.z = pk2(y[12], y[13]); w.w = pk2(y[14], y[15]); \
        *(u32x4v*)(yp + 8) = w; } while (0)
    if (gw >= M) return;
    u32x4v ay0, ay1, ag0, ag1, by0, by1, bg0, bg1;
    MIX_LOAD(gw, ay0, ay1, ag0, ag1);
    for (int m = gw; m < M; m += 2 * NGW) {
        const bool hb = m + NGW < M, ha = m + 2 * NGW < M;
        if (hb) MIX_LOAD(m + NGW, by0, by1, bg0, bg1);
        MIX_DO(m, ay0, ay1, ag0, ag1);
        if (ha) MIX_LOAD(m + 2 * NGW, ay0, ay1, ag0, ag1);
        if (hb) MIX_DO(m + NGW, by0, by1, bg0, bg1);
    }
#undef MIX_LOAD
#undef MIX_DO
}

__device__ __forceinline__ void fox_item(int idx, const bf16* PROJ, const bf16* VT, const float* FCUM, bf16* Y, unsigned char* lds) {
    const int tid = fresh_tid(), wave = __builtin_amdgcn_readfirstlane(tid >> 6), lane = tid & 63, fr = lane & 15, fq = lane >> 4;
    const int qb = 31 - (idx >> 4), bh = idx & 15, b = bh >> 2, h = bh & 3, q0 = qb * 128;
    constexpr int FOXBUF = 64 * 144 * 2 + 128 * 80 * 2 + 256;
    const int qrow = q0 + 16 * wave + fr;
    bf16x8 Qf[4];
    {
        const bf16* qp = PROJ + ((size_t)b * T + qrow) * INP + C_FOX_Q + h * 128 + 8 * fq;
        const float sc = 0.08838834764831845f * LOG2E;
#pragma unroll
        for (int ks = 0; ks < 4; ++ks) { const u32x4v v = *(const u32x4v*)(qp + 32 * ks); u32x4v w;
            w.x = pk2(bflo(v.x) * sc, bfhi(v.x) * sc); w.y = pk2(bflo(v.y) * sc, bfhi(v.y) * sc); w.z = pk2(bflo(v.z) * sc, bfhi(v.z) * sc); w.w = pk2(bflo(v.w) * sc, bfhi(v.w) * sc);
            Qf[ks] = __builtin_bit_cast(bf16x8, w); }
    }
    const float* Fb = FCUM + (size_t)bh * T;
    const float Fref = Fb[q0];
    const int ntile = (q0 + 128) / 64;
    f32x4 O[8];
#pragma unroll
    for (int dt = 0; dt < 8; ++dt) O[dt] = (f32x4){0.f, 0.f, 0.f, 0.f};
    float mrun = -INFINITY, lsum = 0.f;
    u32x4v rkA[2], rvA[2], rkB[2], rvB[2]; float rfA = 0.f, rfB = 0.f;
#define FOX_ISSUE(kt_, rk, rv, rf) do { const int k0_ = (ntile - 1 - (kt_)) * 64;     \
        _Pragma("unroll") for (int i = 0; i < 2; ++i) { const int p_ = tid + 512 * i; \
            rk[i] = *(const u32x4v*)(PROJ + ((size_t)b * T + k0_ + (p_ >> 4)) * INP + C_FOX_K + h * 128 + 8 * (p_ & 15)); \
            rv[i] = *(const u32x4v*)(VT + ((size_t)bh * 128 + (p_ >> 3)) * T + k0_ + 8 * (p_ & 7)); } \
        if (tid < 64) rf = (Fref - Fb[k0_ + tid]) * LOG2E; } while (0)
#define FOX_PUT(buf_, rk, rv, rf) do { bf16* Kw_ = (bf16*)(lds + (buf_) * FOXBUF); bf16* Vw_ = Kw_ + 64 * 144; float* Fw_ = (float*)(Vw_ + 128 * 80); \
        _Pragma("unroll") for (int i = 0; i < 2; ++i) { const int p_ = tid + 512 * i; \
            *(u32x4v*)(Kw_ + (p_ >> 4) * 144 + 8 * (p_ & 15)) = rk[i]; lds_put_perm(Vw_ + (p_ >> 3) * 80, 8 * (p_ & 7), rv[i]); } \
        if (tid < 64) Fw_[tid] = rf; } while (0)
#define FOX_STEP(kt_, rk, rv, rf) do { \
        if ((kt_) + 1 < ntile) FOX_PUT(((kt_) + 1) & 1, rk, rv, rf); \
        if ((kt_) + 3 < ntile) FOX_ISSUE((kt_) + 3, rk, rv, rf); \
        const bf16* Kt = (const bf16*)(lds + ((kt_) & 1) * FOXBUF); const bf16* VTt = Kt + 64 * 144; const float* Ft = (const float*)(VTt + 128 * 80); \
        const int k0 = (ntile - 1 - (kt_)) * 64; \
        if (k0 <= q0 + 16 * wave + 15) { \
            f32x4 s[4]; bf16x8 fa[8], fb[8]; \
            _Pragma("unroll") for (int q = 0; q < 8; ++q) fa[q] = *(const bf16x8*)(Kt + (16 * (q & 3) + fr) * 144 + 32 * (q >> 2) + 8 * fq); \
            SB(); \
            _Pragma("unroll") for (int q = 0; q < 8; ++q) fb[q] = *(const bf16x8*)(Kt + (16 * (q & 3) + fr) * 144 + 32 * (2 + (q >> 2)) + 8 * fq); \
            _Pragma("unroll") for (int t4 = 0; t4 < 4; ++t4) s[t4] = *(const f32x4*)(Ft + 16 * t4 + 4 * fq); \
            SB(); \
            _Pragma("unroll") for (int q = 0; q < 8; ++q) s[q & 3] = MFMA16(fa[q], Qf[q >> 2], s[q & 3]); \
            SB(); \
            _Pragma("unroll") for (int q = 0; q < 8; ++q) fa[q] = afrag_lin(VTt + (16 * q + fr) * 80, 0, fq); \
            SB(); \
            _Pragma("unroll") for (int q = 0; q < 8; ++q) s[q & 3] = MFMA16(fb[q], Qf[2 + (q >> 2)], s[q & 3]); \
            SB(); \
            _Pragma("unroll") for (int q = 0; q < 8; ++q) fb[q] = afrag_lin(VTt + (16 * q + fr) * 80, 32, fq); \
            SB(); \
            if (k0 + 63 > q0 + 16 * wave) { \
                _Pragma("unroll") for (int t4 = 0; t4 < 4; ++t4) \
                    _Pragma("unroll") for (int j = 0; j < 4; ++j) if (k0 + 16 * t4 + 4 * fq + j > qrow) s[t4][j] = -INFINITY; \
            } \
            float mx = -INFINITY; \
            _Pragma("unroll") for (int t4 = 0; t4 < 4; ++t4) mx = fmaxf(fmaxf(mx, fmaxf(s[t4][0], s[t4][1])), fmaxf(s[t4][2], s[t4][3])); \
            mx = fmaxf(mx, __shfl_xor(mx, 16)); mx = fmaxf(mx, __shfl_xor(mx, 32)); \
            const float mnew = fmaxf(mrun, mx); \
            const float alpha = __builtin_amdgcn_exp2f(mrun - mnew); \
            mrun = mnew; \
            float ps = 0.f; \
            _Pragma("unroll") for (int t4 = 0; t4 < 4; ++t4) \
                _Pragma("unroll") for (int j = 0; j < 4; ++j) { const float p = __builtin_amdgcn_exp2f(s[t4][j] - mnew); s[t4][j] = p; ps += p; } \
            lsum = lsum * alpha + ps; \
              \
            if (__builtin_amdgcn_ballot_w64(ps != 0.f) != 0ull) { \
                bf16x8 Pf[2]; \
                Pf[0] = pack8(s[0], s[1]); Pf[1] = pack8(s[2], s[3]); \
                if (__builtin_amdgcn_ballot_w64(alpha != 1.f) != 0ull) {     \
                    _Pragma("unroll") for (int dt = 0; dt < 8; ++dt) O[dt] = O[dt] * alpha; } \
                _Pragma("unroll") for (int dt = 0; dt < 8; ++dt) O[dt] = MFMA16(fa[dt], Pf[0], O[dt]); \
                _Pragma("unroll") for (int dt = 0; dt < 8; ++dt) O[dt] = MFMA16(fb[dt], Pf[1], O[dt]); \
            } \
        } \
        LDSBAR(); } while (0)
    FOX_ISSUE(0, rkA, rvA, rfA);
    FOX_ISSUE(1, rkB, rvB, rfB);
    FOX_PUT(0, rkA, rvA, rfA);
    if (2 < ntile) FOX_ISSUE(2, rkA, rvA, rfA);
    LDSBAR();
    for (int kt = 0; kt < ntile; kt += 2) {
        FOX_STEP(kt, rkB, rvB, rfB);
        FOX_STEP(kt + 1, rkA, rvA, rfA);
    }
#undef FOX_ISSUE
#undef FOX_STEP
#undef FOX_PUT
    lsum += __shfl_xor(lsum, 16); lsum += __shfl_xor(lsum, 32);
    const float inv = 1.f / lsum;
    bf16* yp = Y + ((size_t)b * T + qrow) * D + 1536 + h * 128 + 4 * fq;
#pragma unroll
    for (int dt = 0; dt < 8; ++dt) { const f32x4 o = O[dt] * inv; u32x2v w; w.x = pk2(o.x, o.y); w.y = pk2(o.z, o.w); *(u32x2v*)(yp + 16 * dt) = w; }
    __syncthreads();
}

__device__ __forceinline__ void phase_act(const bf16* GU, const float* cw, const float* cb, bf16* ACT) {
    const size_t gt = (size_t)fresh_bid() * 512 + fresh_tid(), GT = (size_t)gridDim.x * 512;
    constexpr int NCG = DFF / 8, RUN = 32;
    for (size_t idx = gt; idx < (size_t)NCG * (M / RUN); idx += GT) {
        const int cgp = (int)(idx % NCG), run = (int)(idx / NCG), r0 = run * RUN, c0 = cgp * 8;
        float w0[8], w1[8], w2[8], bb[8];
#pragma unroll
        for (int e = 0; e < 8; e += 4) { *(f32x4*)(w0 + e) = *(const f32x4*)(cw + c0 + e); *(f32x4*)(w1 + e) = *(const f32x4*)(cw + DFF + c0 + e);
            *(f32x4*)(w2 + e) = *(const f32x4*)(cw + 2 * DFF + c0 + e); *(f32x4*)(bb + e) = *(const f32x4*)(cb + c0 + e); }
        u32x4v g2 = {0u, 0u, 0u, 0u}, g1 = g2;
        if ((r0 % T) != 0) { g2 = *(const u32x4v*)(GU + (size_t)(r0 - 2) * (2 * DFF) + c0); g1 = *(const u32x4v*)(GU + (size_t)(r0 - 1) * (2 * DFF) + c0); }
#pragma unroll 4
        for (int r = r0; r < r0 + RUN; ++r) {
            const u32x4v g = *(const u32x4v*)(GU + (size_t)r * (2 * DFF) + c0), u = *(const u32x4v*)(GU + (size_t)r * (2 * DFF) + DFF + c0);
            u32x4v o;
#define ACT2(k, fld) { const float a0 = w0[2 * k] * bflo(g2.fld) + w1[2 * k] * bflo(g1.fld) + w2[2 * k] * bflo(g.fld) + bb[2 * k]; \
                       const float a1 = w0[2 * k + 1] * bfhi(g2.fld) + w1[2 * k + 1] * bfhi(g1.fld) + w2[2 * k + 1] * bfhi(g.fld) + bb[2 * k + 1]; \
                       o.fld = pk2(siluf_(a0) * bflo(u.fld), siluf_(a1) * bfhi(u.fld)); }
            ACT2(0, x) ACT2(1, y) ACT2(2, z) ACT2(3, w)
#undef ACT2
            *(u32x4v*)(ACT + (size_t)r * DFF + c0) = o;
            g2 = g1; g1 = g;
        }
    }
}

__device__ __forceinline__ void phase_actfix(const float* GLAST, const float* GFIRST, const float* UFIRST, const float* cw, const float* cb, bf16* ACTp) {
    const int gt = fresh_bid() * 512 + fresh_tid(), GT = gridDim.x * 512;
    constexpr int NCG = DFF / 8;
    for (int idx = gt; idx < NCG * 2 * (M / 256); idx += GT) {
        const int cgp = idx % NCG, ri = idx / NCG, i = ri & 1, pm = ri >> 1, c0 = cgp * 8;
        const bool first = (pm % (T / 256)) == 0;
        float g[8], u[8], g1[8], g2[8];
#pragma unroll
        for (int e = 0; e < 8; e += 4) {
            *(f32x4*)(g + e) = *(const f32x4*)(GFIRST + (size_t)(pm * 2 + i) * DFF + c0 + e);
            *(f32x4*)(u + e) = *(const f32x4*)(UFIRST + (size_t)(pm * 2 + i) * DFF + c0 + e);
            const f32x4 z = {0.f, 0.f, 0.f, 0.f};
            const f32x4 l1 = first ? z : *(const f32x4*)(GLAST + (size_t)((pm - 1) * 2 + 1) * DFF + c0 + e);
            const f32x4 l0 = first ? z : *(const f32x4*)(GLAST + (size_t)((pm - 1) * 2 + 0) * DFF + c0 + e);
            const f32x4 f0 = *(const f32x4*)(GFIRST + (size_t)(pm * 2 + 0) * DFF + c0 + e);
            *(f32x4*)(g1 + e) = (i == 1) ? f0 : l1;
            *(f32x4*)(g2 + e) = (i == 1) ? l1 : l0;
        }
        float o[8];
#pragma unroll
        for (int e = 0; e < 8; ++e) { const float a = cw[c0 + e] * g2[e] + cw[DFF + c0 + e] * g1[e] + cw[2 * DFF + c0 + e] * g[e] + cb[c0 + e]; o[e] = siluf_(a) * u[e]; }
        u32x4v w; w.x = pk2(o[0], o[1]); w.y = pk2(o[2], o[3]); w.z = pk2(o[4], o[5]); w.w = pk2(o[6], o[7]);
        *(u32x4v*)(ACTp + (size_t)(pm * 256 + i) * DFF + c0) = w;
    }
}

__device__ __forceinline__ void actfix_tile(int pm, const float* GLAST, const float* GFIRST, const float* UFIRST, const float* cw, const float* cb, bf16* ACTp) {
    const int tid = fresh_tid();
    constexpr int NCG = DFF / 8;
    const bool first = (pm % (T / 256)) == 0;
    for (int idx = tid; idx < 2 * NCG; idx += 512) {
        const int cgp = idx % NCG, i = idx / NCG, c0 = cgp * 8;
        unsigned pk[4];
#pragma unroll
        for (int h2 = 0; h2 < 2; ++h2) {
            const int c = c0 + 4 * h2;
            const f32x4 z = {0.f, 0.f, 0.f, 0.f};
            const f32x4 g = *(const f32x4*)(GFIRST + (size_t)(pm * 2 + i) * DFF + c), u = *(const f32x4*)(UFIRST + (size_t)(pm * 2 + i) * DFF + c);
            const f32x4 l1 = first ? z : *(const f32x4*)(GLAST + (size_t)((pm - 1) * 2 + 1) * DFF + c);
            const f32x4 l0 = first ? z : *(const f32x4*)(GLAST + (size_t)((pm - 1) * 2 + 0) * DFF + c);
            const f32x4 f0 = *(const f32x4*)(GFIRST + (size_t)(pm * 2 + 0) * DFF + c);
            const f32x4 g1 = (i == 1) ? f0 : l1, g2 = (i == 1) ? l1 : l0;
            const f32x4 w0 = *(const f32x4*)(cw + c), w1 = *(const f32x4*)(cw + DFF + c), w2 = *(const f32x4*)(cw + 2 * DFF + c), bb = *(const f32x4*)(cb + c);
            const f32x4 a = w0 * g2 + w1 * g1 + w2 * g + bb;
            const f32x4 o = {siluf_(a.x) * u.x, siluf_(a.y) * u.y, siluf_(a.z) * u.z, siluf_(a.w) * u.w};
            pk[2 * h2] = pk2(o.x, o.y); pk[2 * h2 + 1] = pk2(o.z, o.w);
        }
        u32x4v w; w.x = pk[0]; w.y = pk[1]; w.z = pk[2]; w.w = pk[3];
        *(u32x4v*)(ACTp + (size_t)(pm * 256 + i) * DFF + c0) = w;
    }
}

#ifndef GEMM_ALIGN
#define GEMM_ALIGN true
#endif
#ifndef GEMM_SP2
#define GEMM_SP2 true
#endif
#ifndef WGM_IN
#define WGM_IN 4
#endif
#ifndef WGM_OUT
#define WGM_OUT 4
#endif
#ifndef WGM_GU
#define WGM_GU 4
#endif
#ifndef WGM_DN
#define WGM_DN 4
#endif
#ifndef CREP
#define CREP 1
#endif
#ifndef CLO
#define CLO 0
#define CHI 0
#endif
#ifndef SREP
#define SREP 1
#endif
#ifndef FREP
#define FREP 1
#endif
struct Args { const float* in[24]; float* out; unsigned char* ws; };
enum { I_X = 0, I_C, I_WMOD, I_BMOD, I_NMIX, I_NFFN, I_WIN, I_GLAWLR, I_GLABLR, I_GLANORM, I_GDNCONV, I_GDNALOG, I_GDNDT, I_GDNNORM,
       I_POOLW, I_POOLSC, I_FOXB, I_WOUT, I_WGATE, I_WUP, I_FCW, I_FCB, I_WDOWN, I_NFINAL };

typedef const Args __attribute__((address_space(4)))* KArgsP;
__device__ __forceinline__ KArgsP fresh_args() { KArgsP p = (KArgsP)__builtin_amdgcn_kernarg_segment_ptr(); asm volatile("" : "+s"(p)); return p; }
#define KA fresh_args()
#define ws (KA->ws)
#define MOD ((float*)(ws + WS_MOD))
#define FCUM ((float*)(ws + WS_FCUM))
#define GLADEC ((float*)(ws + WS_GLADEC))
#define GDNDEC ((float*)(ws + WS_GDNDEC))
#define PWT ((bf16*)(ws + WS_PWT))
#define H ((bf16*)(ws + WS_H))
#define ACT ((bf16*)(ws + WS_ACT))
#define PROJ ((bf16*)(ws + WS_PROJ))
#define Y ((bf16*)(ws + WS_Y))
#define GU ((bf16*)(ws + WS_GU))
#define VT ((bf16*)(ws + WS_VT))
__global__ void __launch_bounds__(512, 2) mk_fwd(Args a) {
    extern __shared__ __attribute__((aligned(16))) unsigned char lds[];
#ifdef TEST_NOSYNC
    struct { __device__ void sync() const { __syncthreads(); } } grid;
#else
    cg::grid_group grid = cg::this_grid();
#endif
    const int G = gridDim.x;
#define bx fresh_bid()
    {
        volatile LAS unsigned* bst = (volatile LAS unsigned*)((LAS unsigned char*)lds + (LDS_BYTES - 64));
        if (threadIdx.x < 2) bst[threadIdx.x] = 0u;
        __syncthreads();
        (void)xcd_barrier_post((unsigned*)ws, bst);
    }
#define GSYNC() do { XcdBarrier b_; b_.bar = (unsigned*)ws; b_.x = xb_xcc_id(); b_.st = (volatile LAS unsigned*)((LAS unsigned char*)lds + (LDS_BYTES - 64)); xcd_barrier(b_); } while (0)
    PG8_LAS unsigned char* gl = (PG8_LAS unsigned char*)lds;

#ifndef NO_MOD
    phase_mod(KA->in[I_C], KA->in[I_WMOD], KA->in[I_BMOD], MOD, lds);
#endif
    if (KA->out == nullptr) grid.sync();
    GSYNC();
#ifdef TEST_NOLOOP
    for (int l = 0; l < 1; ++l) {
#else
#pragma unroll
    for (int l = 0; l < NL; ++l) {
#endif
        const float* modl = MOD + (size_t)l * NB * MODW;
        const float* xin = (l == 0) ? KA->in[I_X] : KA->out;
        {
            LayerW L{KA->in[I_WIN] + (size_t)l * D * INW, KA->in[I_WOUT] + (size_t)l * D * D, KA->in[I_WGATE] + (size_t)l * D * DFF, KA->in[I_WUP] + (size_t)l * D * DFF,
                     KA->in[I_WDOWN] + (size_t)l * DFF * D, KA->in[I_POOLW] + (size_t)l * 4 * 128 * 128};
#ifndef NO_TR
            phase_transpose(L, ws, lds, 0, 0, G);
#endif
            phase_norm(xin, KA->in[I_NMIX] + (size_t)l * D, modl, 0, 1, H);
        }
        GSYNC();
#ifdef DUP_A
        {
            LayerW L{KA->in[I_WIN] + (size_t)l * D * INW, KA->in[I_WOUT] + (size_t)l * D * D, KA->in[I_WGATE] + (size_t)l * D * DFF, KA->in[I_WUP] + (size_t)l * D * DFF,
                     KA->in[I_WDOWN] + (size_t)l * DFF * D, KA->in[I_POOLW] + (size_t)l * 4 * 128 * 128};
#ifndef NO_TR
            phase_transpose(L, ws, lds, 0, 0, G);
#endif
            phase_norm(xin, KA->in[I_NMIX] + (size_t)l * D, modl, 0, 1, H);
        }
        GSYNC();
#endif
        {
            pg8::Gemm g{H, (const bf16*)(ws + WS_WIN), M, INP, D}; pg8::StaticOrder S; S.init(M, INP, G, bx, WGM_IN);
            pg8::EpiStoreBf16 E{PROJ, INP};
#ifndef NO_GEMM0
            pg8::gemm_phase<pg8::EpiStoreBf16, pg8::StaticOrder, GEMM_ALIGN, GEMM_SP2>(gl, g, S, E);
#endif
        }
        GSYNC();
#ifdef DUP_B
        {
            pg8::Gemm g{H, (const bf16*)(ws + WS_WIN), M, INP, D}; pg8::StaticOrder S; S.init(M, INP, G, bx, WGM_IN);
            pg8::EpiStoreBf16 E{PROJ, INP};
#ifndef NO_GEMM0
            pg8::gemm_phase<pg8::EpiStoreBf16, pg8::StaticOrder, GEMM_ALIGN, GEMM_SP2>(gl, g, S, E);
#endif
        }
        GSYNC();
#endif
        {
            const float* conv_w = KA->in[I_GDNCONV] + (size_t)l * 4 * 1536;
            for (int rep_ = 0; rep_ < CREP; ++rep_)
            for (int it = bx; it < 4100; it += G) {
                if (rep_ > 0 && !(it >= CLO && it < CHI)) continue;
#ifndef NO_GDNP
                if (it < 1024) gdn_prep_item(it, PROJ, conv_w, KA->in[I_GDNALOG] + l * 4, KA->in[I_GDNDT] + l * 4, ws + WS_GDN, GDNDEC, lds);
                else
#endif
#ifndef NO_GLAP
                if (it < 2048) gla_prep_item(it - 1024, PROJ, KA->in[I_GLAWLR] + (size_t)l * 16 * 256, KA->in[I_GLABLR] + (size_t)l * 256, ws + WS_GLA, GLADEC, lds);
                else
#endif
#ifndef NO_POOL
                if (it < 3072) pool_item(it - 2048, PROJ, PWT, KA->in[I_POOLSC] + (size_t)l * 512, Y, lds);
                else
#endif
                if (it < 4096) vt_item(it - 3072, PROJ, VT, lds);
                else fcum_item(it - 4096, PROJ, KA->in[I_FOXB] + l * 4, FCUM, lds);
            }
        }
        GSYNC();
#ifdef DUP_C
        {
            const float* conv_w = KA->in[I_GDNCONV] + (size_t)l * 4 * 1536;
            for (int rep_ = 0; rep_ < CREP; ++rep_)
            for (int it = bx; it < 4100; it += G) {
                if (rep_ > 0 && !(it >= CLO && it < CHI)) continue;
#ifndef NO_GDNP
                if (it < 1024) gdn_prep_item(it, PROJ, conv_w, KA->in[I_GDNALOG] + l * 4, KA->in[I_GDNDT] + l * 4, ws + WS_GDN, GDNDEC, lds);
                else
#endif
#ifndef NO_GLAP
                if (it < 2048) gla_prep_item(it - 1024, PROJ, KA->in[I_GLAWLR] + (size_t)l * 16 * 256, KA->in[I_GLABLR] + (size_t)l * 256, ws + WS_GLA, GLADEC, lds);
                else
#endif
#ifndef NO_POOL
                if (it < 3072) pool_item(it - 2048, PROJ, PWT, KA->in[I_POOLSC] + (size_t)l * 512, Y, lds);
                else
#endif
                if (it < 4096) vt_item(it - 3072, PROJ, VT, lds);
                else fcum_item(it - 4096, PROJ, KA->in[I_FOXB] + l * 4, FCUM, lds);
            }
        }
        GSYNC();
#endif
        {
            for (int rep_ = 0; rep_ < SREP; ++rep_)
            for (int s = bx; s < 32; s += G) {
#ifndef NO_SCAN
                if (s < 16) scan_bh<128, true>(s, ws + WS_GDN, GDN_ITEM, GDNDEC, PROJ, C_GDN_G + (s & 3) * 128, KA->in[I_GDNNORM] + (size_t)l * 128, Y, 512 + (s & 3) * 128, lds);
                else scan_bh<64, false>(s - 16, ws + WS_GLA, GLA_ITEM, GLADEC, PROJ, C_GLA_G + (s & 3) * 128, KA->in[I_GLANORM] + (size_t)l * 128, Y, (s & 3) * 128, lds);
#endif
            }
            const int NA = (G > 32) ? G - 32 : G, ab = (G > 32) ? bx - 32 : bx;
            for (int rep_ = 0; rep_ < FREP; ++rep_)
            if (ab >= 0 && NA == 224) {
                const int fbh = ab & 15, slot = ab >> 4;
                const int n_it = (slot < 13) ? 2 : 6;
                for (int k = 0; k < n_it; ++k) {
                    const int qbk = (slot < 13) ? ((k == 0) ? 31 - slot : 5 + slot) : ((k == 0) ? 18 : 5 - k);
                    fox_item((31 - qbk) * 16 + fbh, PROJ, VT, FCUM, Y, lds);
                }
            } else
            if (ab >= 0) for (int r = 0;; ++r) { const int idx = r * NA + ((r & 1) ? NA - 1 - ab : ab); if (r * NA >= 512) break;
#ifndef NO_FOX
 if (idx < 512) fox_item(idx, PROJ, VT, FCUM, Y, lds);
#endif
 }
            {
                LayerW L{KA->in[I_WIN] + (size_t)l * D * INW, KA->in[I_WOUT] + (size_t)l * D * D, KA->in[I_WGATE] + (size_t)l * D * DFF, KA->in[I_WUP] + (size_t)l * D * DFF,
                         KA->in[I_WDOWN] + (size_t)l * DFF * D, KA->in[I_POOLW] + (size_t)l * 4 * 128 * 128};
                if (G > 32) phase_transpose(L, ws, lds, 1, 32, G - 32); else phase_transpose(L, ws, lds, 1, 0, G);
            }
        }
        GSYNC();
#ifdef DUP_D
        {
            for (int rep_ = 0; rep_ < SREP; ++rep_)
            for (int s = bx; s < 32; s += G) {
#ifndef NO_SCAN
                if (s < 16) scan_bh<128, true>(s, ws + WS_GDN, GDN_ITEM, GDNDEC, PROJ, C_GDN_G + (s & 3) * 128, KA->in[I_GDNNORM] + (size_t)l * 128, Y, 512 + (s & 3) * 128, lds);
                else scan_bh<64, false>(s - 16, ws + WS_GLA, GLA_ITEM, GLADEC, PROJ, C_GLA_G + (s & 3) * 128, KA->in[I_GLANORM] + (size_t)l * 128, Y, (s & 3) * 128, lds);
#endif
            }
            const int NA = (G > 32) ? G - 32 : G, ab = (G > 32) ? bx - 32 : bx;
            for (int rep_ = 0; rep_ < FREP; ++rep_)
            if (ab >= 0 && NA == 224) {
                const int fbh = ab & 15, slot = ab >> 4;
                const int n_it = (slot < 13) ? 2 : 6;
                for (int k = 0; k < n_it; ++k) {
                    const int qbk = (slot < 13) ? ((k == 0) ? 31 - slot : 5 + slot) : ((k == 0) ? 18 : 5 - k);
                    fox_item((31 - qbk) * 16 + fbh, PROJ, VT, FCUM, Y, lds);
                }
            } else
            if (ab >= 0) for (int r = 0;; ++r) { const int idx = r * NA + ((r & 1) ? NA - 1 - ab : ab); if (r * NA >= 512) break;
#ifndef NO_FOX
 if (idx < 512) fox_item(idx, PROJ, VT, FCUM, Y, lds);
#endif
 }
            {
                LayerW L{KA->in[I_WIN] + (size_t)l * D * INW, KA->in[I_WOUT] + (size_t)l * D * D, KA->in[I_WGATE] + (size_t)l * D * DFF, KA->in[I_WUP] + (size_t)l * D * DFF,
                         KA->in[I_WDOWN] + (size_t)l * DFF * D, KA->in[I_POOLW] + (size_t)l * 4 * 128 * 128};
                if (G > 32) phase_transpose(L, ws, lds, 1, 32, G - 32); else phase_transpose(L, ws, lds, 1, 0, G);
            }
        }
        GSYNC();
#endif
        phase_mixnorm(PROJ, KA->in[I_GLANORM] + (size_t)l * 128, KA->in[I_GDNNORM] + (size_t)l * 128, Y);
        GSYNC();
        {
            pg8::Gemm g{Y, (const bf16*)(ws + WS_WOUT), M, D, D}; pg8::StaticOrder S; S.init(M, D, G, bx, WGM_OUT);
            pg8::EpiResid E{xin, KA->out, modl + 2 * D, D, MODW, T};
#ifndef NO_GEMM1
            pg8::gemm_phase<pg8::EpiResid, pg8::StaticOrder, GEMM_ALIGN, GEMM_SP2>(gl, g, S, E);
#endif
        }
        GSYNC();
#ifdef DUP_E
        if (l == 0) {
        {
            pg8::Gemm g{Y, (const bf16*)(ws + WS_WOUT), M, D, D}; pg8::StaticOrder S; S.init(M, D, G, bx, WGM_OUT);
            pg8::EpiResid E{xin, KA->out, modl + 2 * D, D, MODW, T};
#ifndef NO_GEMM1
            pg8::gemm_phase<pg8::EpiResid, pg8::StaticOrder, GEMM_ALIGN, GEMM_SP2>(gl, g, S, E);
#endif
        }
        GSYNC();
        }
#endif
        phase_norm(KA->out, KA->in[I_NFFN] + (size_t)l * D, modl, 3, 4, H);
        GSYNC();
#ifdef DUP_F
        phase_norm(KA->out, KA->in[I_NFFN] + (size_t)l * D, modl, 3, 4, H);
        GSYNC();
#endif
        {
            pg8::Gemm g{H, (const bf16*)(ws + WS_WGU), M, 2 * DFF, D}; pg8::StaticOrder S; S.init(M, 2 * DFF, G, bx, WGM_GU);
            pg8::EpiGateUp E{ACT, KA->in[I_FCW] + (size_t)l * 3 * DFF, KA->in[I_FCB] + (size_t)l * DFF, (float*)(ws + WS_SIDE), (float*)(ws + WS_SIDE) + (size_t)128 * DFF, (float*)(ws + WS_SIDE) + (size_t)256 * DFF,
                              (PG8_LAS float*)(gl + 131072), DFF};
            pg8::gemm_phase<pg8::EpiGateUp, pg8::StaticOrder, GEMM_ALIGN, GEMM_SP2>(gl, g, S, E);
        }
        GSYNC();
        if (G == 256) {
            const int c_ = bx;
#pragma unroll
            for (int i_ = 0; i_ < (M / 256) * (D / 256) / 256; ++i_) {
                constexpr int nM_ = M / 256, nN_ = D / 256, nwg_ = nM_ * nN_, q_ = nwg_ / 8;
                const int L_ = i_ * 256 + c_, wg_ = (L_ % 8) * q_ + L_ / 8;
                const int nig_ = WGM_DN * nN_, fm_ = (wg_ / nig_) * WGM_DN, gsz_ = (nM_ - fm_) < WGM_DN ? (nM_ - fm_) : WGM_DN;
                const int pm_ = fm_ + ((wg_ % nig_) % gsz_);
                actfix_tile(pm_, (const float*)(ws + WS_SIDE), (const float*)(ws + WS_SIDE) + (size_t)128 * DFF, (const float*)(ws + WS_SIDE) + (size_t)256 * DFF,
                            KA->in[I_FCW] + (size_t)l * 3 * DFF, KA->in[I_FCB] + (size_t)l * DFF, ACT); }
            asm volatile("s_waitcnt vmcnt(0)" ::: "memory"); __syncthreads();
        } else {
            phase_actfix((const float*)(ws + WS_SIDE), (const float*)(ws + WS_SIDE) + (size_t)128 * DFF, (const float*)(ws + WS_SIDE) + (size_t)256 * DFF,
                         KA->in[I_FCW] + (size_t)l * 3 * DFF, KA->in[I_FCB] + (size_t)l * DFF, ACT);
            GSYNC();
        }
        {
            pg8::Gemm g{ACT, (const bf16*)(ws + WS_WDN), M, D, DFF}; pg8::StaticOrder S; S.init(M, D, G, bx, WGM_DN);
            pg8::EpiResid E{KA->out, KA->out, modl + 5 * D, D, MODW, T};
#ifndef NO_GEMM3
            pg8::gemm_phase<pg8::EpiResid, pg8::StaticOrder, GEMM_ALIGN, GEMM_SP2>(gl, g, S, E);
#endif
        }
        GSYNC();
    }
#ifdef XSYNC
    for (int i_ = 0; i_ < XSYNC; ++i_) GSYNC();
#endif
    phase_final_norm(KA->out, KA->in[I_NFINAL]);
}

#undef KA
#undef ws
#undef MOD
#undef FCUM
#undef GLADEC
#undef GDNDEC
#undef PWT
#undef H
#undef ACT
#undef PROJ
#undef Y
#undef GU
#undef VT
#undef bx
extern "C" void kernel_launch(void* const* d_in, const int* in_sizes, int n_in, void* d_out, int out_size, void* d_ws, size_t ws_size, hipStream_t stream) {
    static int grid = 0;
    if (grid == 0) {
        int dev = 0, cus = 0, per_cu = 0;
        (void)hipGetDevice(&dev);
        (void)hipDeviceGetAttribute(&cus, hipDeviceAttributeMultiprocessorCount, dev);
        (void)hipFuncSetAttribute((const void*)mk_fwd, hipFuncAttributeMaxDynamicSharedMemorySize, LDS_BYTES);
        (void)hipOccupancyMaxActiveBlocksPerMultiprocessor(&per_cu, (const void*)mk_fwd, 512, LDS_BYTES);
        if (per_cu < 1) fprintf(stderr, "kernel_launch: occupancy query reports %d blocks per CU\n", per_cu);
        if (n_in != 24 || out_size != M * D || ws_size < WS_END) { fprintf(stderr, "kernel_launch: unexpected shapes (n_in %d out %d ws %zu)\n", n_in, out_size, ws_size); grid = -1; return; }
        grid = cus > 0 ? cus : 256;
    }
    if (grid < 0) return;
    if (hipMemsetAsync(d_ws, 0, 65536, stream) != hipSuccess) { fprintf(stderr, "kernel_launch: memset of the barrier words failed\n"); return; }
    Args a{};
    for (int i = 0; i < 24; ++i) a.in[i] = (const float*)d_in[i];
    a.out = (float*)d_out; a.ws = (unsigned char*)d_ws;
    void* args[] = {&a};
    hipError_t e = hipLaunchCooperativeKernel((const void*)mk_fwd, dim3(grid), dim3(512), args, LDS_BYTES, stream);
    if (e != hipSuccess) fprintf(stderr, "kernel_launch: cooperative launch failed: %s (grid %d)\n", hipGetErrorString(e), grid);
}
```
